# Optimizing an MI355X kernel written in HIP

```python
import jax
import jax.numpy as jnp
from jax import lax
import numpy as np

D_MODEL = 2048
BATCH = 2
SEQ = 4096
DEPTH = 2

F32 = jnp.float32
GRID_W = 64
CTX_LEN = 256
RMS_EPS = 1e-6
N_MOD = 6

HEAD_DIM = 128
N_HEADS = 8
N_KV_HEADS = 2
GQA_GROUP = N_HEADS // N_KV_HEADS
Q_BLOCK = 128
ROPE_THETA = 10000.0
ROPE_AXIS_DIM = HEAD_DIM // 2
ATTN_W = N_HEADS * HEAD_DIM
KV_W = N_KV_HEADS * HEAD_DIM
POOL_WINDOWS = (2, 4, 8, 16)
N_POOL_GROUPS = len(POOL_WINDOWS)
POOL_W = D_MODEL // 2
POOL_GROUP = POOL_W // N_POOL_GROUPS
AB_IN = ATTN_W + 2 * KV_W + POOL_W
AB_MIX = ATTN_W + POOL_W
RWKV_HEAD = 64
RWKV_HEADS = D_MODEL // RWKV_HEAD
DECAY_LORA = 96
AAA_LORA = 96
GATE_LORA = 256
GN_EPS = 64e-5
N_DIR = 2
N_SHIFT = 6
N_EXPERTS = 32
TOP_K = 4
D_EXPERT = D_MODEL // 2
SWIGLU_LIMIT = 7.0
SWIGLU_ALPHA = 1.702
EXPERT_BLOCK = 128

N_EVEN = (DEPTH + 1) // 2
N_ODD = DEPTH // 2

kernel_name = 'hybrid_attn_pool_rwkv7_moe_dit'


def rms_norm(x, g):
    xf = x.astype(F32)
    y = xf * lax.rsqrt(jnp.mean(jnp.square(xf), axis=-1, keepdims=True) + RMS_EPS)
    return (y * g.astype(F32)).astype(x.dtype)


def modulate(h, shift, scale):
    return h * (1.0 + scale) + shift


def grid_angles(n_tok):
    rows = n_tok // GRID_W
    row_idx = jnp.repeat(jnp.arange(rows), GRID_W).astype(F32)
    col_idx = jnp.tile(jnp.arange(GRID_W), rows).astype(F32)
    inv = ROPE_THETA ** (-jnp.arange(0, ROPE_AXIS_DIM, 2, dtype=F32) / ROPE_AXIS_DIM)
    return row_idx[:, None] * inv[None, :], col_idx[:, None] * inv[None, :]


def rope_axis(x, ang):
    x1, x2 = jnp.split(x.astype(F32), 2, axis=-1)
    cos = jnp.cos(ang)[None, :, None, :]
    sin = jnp.sin(ang)[None, :, None, :]
    return jnp.concatenate([x1 * cos - x2 * sin, x2 * cos + x1 * sin], axis=-1)


def rope_2d(x, ang_row, ang_col):
    xr, xc = jnp.split(x, 2, axis=-1)
    return jnp.concatenate([rope_axis(xr, ang_row), rope_axis(xc, ang_col)], axis=-1).astype(x.dtype)


def gqa_attend(q, k, v):
    bn, lq = q.shape[:2]
    qg = q.reshape(bn, lq, N_KV_HEADS, GQA_GROUP, HEAD_DIM).astype(F32)
    s = jnp.einsum('bqkgd,bskd->bkgqs', qg, k.astype(F32)) * (HEAD_DIM ** -0.5)
    p = jax.nn.softmax(s, axis=-1)
    o = jnp.einsum('bkgqs,bskd->bqkgd', p, v.astype(F32))
    return o.reshape(bn, lq, ATTN_W).astype(v.dtype)


def blocked_gqa_attend(q, k, v):
    bn, lq = q.shape[:2]
    nb = lq // Q_BLOCK
    qb = q.reshape(bn, nb, Q_BLOCK, N_HEADS, HEAD_DIM).transpose(1, 0, 2, 3, 4)
    ob = lax.map(lambda qi: gqa_attend(qi, k, v), qb)
    return ob.transpose(1, 0, 2, 3).reshape(bn, lq, ATTN_W)


def multiscale_pool(u, pool_w, pool_scale):
    bn, n, _ = u.shape
    ug = u.astype(F32).reshape(bn, n, N_POOL_GROUPS, POOL_GROUP)
    csum = jnp.pad(jnp.cumsum(ug, axis=1), ((0, 0), (1, 0), (0, 0), (0, 0)))
    t = jnp.arange(n)
    outs = []
    for gi, w in enumerate(POOL_WINDOWS):
        lo = jnp.clip(t - w // 2, 0, n)
        hi = jnp.clip(t + w // 2, 0, n)
        cg = csum[:, :, gi]
        win_sum = jnp.take(cg, hi, axis=1) - jnp.take(cg, lo, axis=1)
        cnt = (hi - lo).astype(F32)[None, :, None]
        outs.append(win_sum / cnt - ug[:, :, gi])
    m = jnp.stack(outs, axis=2)
    y = jnp.einsum('blgc,gcd->blgd', m, pool_w.astype(F32)) * pool_scale.astype(F32).reshape(N_POOL_GROUPS, POOL_GROUP)
    return y.reshape(bn, n, POOL_W).astype(u.dtype)


def attn_pool_mixer(h_lat, h_ctx, ang_row, ang_col, w_in, q_gain, k_gain, pool_w, pool_scale, w_out, ctx_out):
    bn, n, _ = h_lat.shape
    n_ctx = h_ctx.shape[1]
    u = h_lat @ w_in
    q, k, v, pin = jnp.split(u, [ATTN_W, ATTN_W + KV_W, ATTN_W + 2 * KV_W], axis=-1)
    q = rope_2d(rms_norm(q.reshape(bn, n, N_HEADS, HEAD_DIM), q_gain), ang_row, ang_col)
    k = rope_2d(rms_norm(k.reshape(bn, n, N_KV_HEADS, HEAD_DIM), k_gain), ang_row, ang_col)
    v = v.reshape(bn, n, N_KV_HEADS, HEAD_DIM)
    k_c, v_c = jnp.split(h_ctx @ w_in[:, ATTN_W:ATTN_W + 2 * KV_W], 2, axis=-1)
    k_c = rms_norm(k_c.reshape(bn, n_ctx, N_KV_HEADS, HEAD_DIM), k_gain)
    v_c = v_c.reshape(bn, n_ctx, N_KV_HEADS, HEAD_DIM)
    o = blocked_gqa_attend(q, jnp.concatenate([k, k_c], axis=1), jnp.concatenate([v, v_c], axis=1))
    y_lat = jnp.concatenate([o, multiscale_pool(pin, pool_w, pool_scale)], axis=-1) @ w_out
    y_ctx = None
    if ctx_out:
        q_c = rms_norm((h_ctx @ w_in[:, :ATTN_W]).reshape(bn, n_ctx, N_HEADS, HEAD_DIM), q_gain)
        pin_c = h_ctx @ w_in[:, ATTN_W + 2 * KV_W:]
        o_c = gqa_attend(q_c, k_c, v_c)
        y_ctx = jnp.concatenate([o_c, multiscale_pool(pin_c, pool_w, pool_scale)], axis=-1) @ w_out
    return y_lat, y_ctx


def centred_shift(x):
    zero = jnp.zeros_like(x[:, :1])
    prev = jnp.concatenate([zero, x[:, :-1]], axis=1)
    nxt = jnp.concatenate([x[:, 1:], zero], axis=1)
    return 0.5 * (prev + nxt) - x


def to_scan(x):
    bn, n, _ = x.shape
    return x.astype(F32).reshape(bn, n, RWKV_HEADS, RWKV_HEAD).transpose(1, 0, 2, 3)


def rwkv_prep(h, mix, wk, wv, w0, w1, w2, a0, a1, a2, k_k, k_a):
    xx = centred_shift(h)
    xr, xw, xk, xv, xa, xg = (h + xx * mix[j] for j in range(N_SHIFT))
    k = xk @ wk
    v = to_scan(xv @ wv)
    kk = to_scan(k * k_k)
    kk = kk * lax.rsqrt(jnp.maximum(jnp.sum(jnp.square(kk), axis=-1, keepdims=True), 1e-24))
    neg_kk = -kk
    terms = []
    for d in range(N_DIR):
        w_log = -jax.nn.softplus(-(w0[d] + jnp.tanh(xw @ w1[d]) @ w2[d]).astype(F32)) - 0.5
        a = jax.nn.sigmoid((a0[d] + (xa @ a1[d]) @ a2[d]).astype(F32))
        k_d = k.astype(F32) * (1.0 + (a - 1.0) * k_a.astype(F32))
        terms.append((to_scan(jnp.exp(-jnp.exp(w_log))), to_scan(k_d), v, neg_kk, kk * to_scan(a)))
    return xr, xg, terms


def _rwkv_state_update(s, w_t, k_t, v_t, a_t, b_t):
    sa = jnp.einsum('bhvk,bhk->bhv', s, a_t)
    return s * w_t[:, :, None, :] + sa[..., None] * b_t[:, :, None, :] + v_t[..., None] * k_t[:, :, None, :]


def rwkv_scan(s0, r, terms, reverse):
    def step(s, inp):
        r_t, w_t, k_t, v_t, a_t, b_t = inp
        s = _rwkv_state_update(s, w_t, k_t, v_t, a_t, b_t)
        return s, jnp.einsum('bhvk,bhk->bhv', s, r_t)
    return lax.scan(step, s0, (r,) + tuple(terms), reverse=reverse)


def rwkv_state_scan(s0, terms, reverse):
    def step(s, inp):
        return _rwkv_state_update(s, *inp), None
    s, _ = lax.scan(step, s0, tuple(terms), reverse=reverse)
    return s


def rwkv_readout(y, r, terms, xg, g1, g2, r_k, ln_w, ln_b, wo, dtype):
    n, bn = y.shape[:2]
    mu = jnp.mean(y, axis=-1, keepdims=True)
    var = jnp.mean(jnp.square(y - mu), axis=-1, keepdims=True)
    yn = (y - mu) * lax.rsqrt(var + GN_EPS)
    yn = yn * ln_w.astype(F32).reshape(RWKV_HEADS, RWKV_HEAD) + ln_b.astype(F32).reshape(RWKV_HEADS, RWKV_HEAD)
    rk = r * r_k.astype(F32)
    bonus = (jnp.sum(rk * terms[0][1], axis=-1, keepdims=True) + jnp.sum(rk * terms[1][1], axis=-1, keepdims=True)) * terms[0][2]
    o = (yn + bonus).transpose(1, 0, 2, 3).reshape(bn, n, D_MODEL)
    g = jax.nn.sigmoid(xg @ g1) @ g2
    return (o * g.astype(F32)).astype(dtype) @ wo


def rwkv_mixer(h_lat, h_ctx, mix, wr, wk, wv, wo, w0, w1, w2, a0, a1, a2, g1, g2, k_k, k_a, r_k, ln_w, ln_b, ctx_out):
    tok = (mix, wk, wv, w0, w1, w2, a0, a1, a2, k_k, k_a)
    xr_l, xg_l, terms_l = rwkv_prep(h_lat, *tok)
    xr_c, xg_c, terms_c = rwkv_prep(h_ctx, *tok)
    s0 = jnp.zeros((h_lat.shape[0], RWKV_HEADS, RWKV_HEAD, RWKV_HEAD), F32)
    r_l = to_scan(xr_l @ wr)
    r_c = to_scan(xr_c @ wr) if ctx_out else None
    ys_l, ys_c = [], []
    for d in range(N_DIR):
        rev = d == 1
        if ctx_out:
            s_c, y_c = rwkv_scan(s0, r_c, terms_c[d], rev)
            ys_c.append(y_c)
        else:
            s_c = rwkv_state_scan(s0, terms_c[d], rev)
        _, y_l = rwkv_scan(s_c, r_l, terms_l[d], rev)
        ys_l.append(y_l)
    head = (g1, g2, r_k, ln_w, ln_b, wo, h_lat.dtype)
    out_l = rwkv_readout(ys_l[0] + ys_l[1], r_l, terms_l, xg_l, *head)
    out_c = rwkv_readout(ys_c[0] + ys_c[1], r_c, terms_c, xg_c, *head) if ctx_out else None
    return out_l, out_c


def moe_ffn(h, router_w, router_b, w_gate, b_gate, w_up, b_up, w_down, b_down):
    n_tok, d = h.shape
    logits = h.astype(F32) @ router_w.astype(F32) + router_b.astype(F32)
    top_val, top_idx = lax.top_k(logits, TOP_K)
    gates = jax.nn.softmax(top_val, axis=-1)
    n_asg = n_tok * TOP_K
    flat_e = top_idx.reshape(-1)
    flat_tok = jnp.repeat(jnp.arange(n_tok), TOP_K)
    order = jnp.argsort(flat_e)
    sorted_e = flat_e[order]
    counts = jnp.bincount(flat_e, length=N_EXPERTS)
    padded = (counts + EXPERT_BLOCK - 1) // EXPERT_BLOCK * EXPERT_BLOCK
    padded_end = jnp.cumsum(padded)
    start = jnp.cumsum(counts) - counts
    dest = (padded_end - padded)[sorted_e] + jnp.arange(n_asg) - start[sorted_e]
    n_blocks = -(-(n_asg + N_EXPERTS * (EXPERT_BLOCK - 1)) // EXPERT_BLOCK)
    n_slots = n_blocks * EXPERT_BLOCK
    slot_tok = jnp.full((n_slots,), n_tok, jnp.int32).at[dest].set(flat_tok[order])
    slot_gate = jnp.zeros((n_slots,), F32).at[dest].set(gates.reshape(-1)[order])
    block_e = jnp.minimum(jnp.searchsorted(padded_end, jnp.arange(n_blocks) * EXPERT_BLOCK, side='right'), N_EXPERTS - 1)
    h_pad = jnp.concatenate([h, jnp.zeros((1, d), h.dtype)], axis=0)

    def expert_block(args):
        tok_b, gate_b, e = args
        xb = h_pad[tok_b]
        glu = jnp.minimum(xb @ w_gate[e] + b_gate[e], SWIGLU_LIMIT)
        lin = jnp.clip(xb @ w_up[e] + b_up[e], -SWIGLU_LIMIT, SWIGLU_LIMIT)
        act = glu * jax.nn.sigmoid(SWIGLU_ALPHA * glu) * (lin + 1.0)
        return (act @ w_down[e] + b_down[e]).astype(F32) * gate_b[:, None]

    yb = lax.map(expert_block, (slot_tok.reshape(n_blocks, EXPERT_BLOCK), slot_gate.reshape(n_blocks, EXPERT_BLOCK), block_e))
    out = jnp.zeros((n_tok + 1, d), F32).at[slot_tok].add(yb.reshape(n_slots, d))
    return out[:n_tok].astype(h.dtype)


def setup_inputs(seed: int = 0) -> dict:
    key = jax.random.key(seed)
    keys = iter(jax.random.split(key, 64))
    D = D_MODEL

    def nrm(shape, scale=1.0):
        return scale * jax.random.normal(next(keys), shape, F32)

    def gain(shape):
        return 1.0 + nrm(shape, 0.1)

    return {
        'x': nrm((BATCH, SEQ, D)),
        'c': nrm((BATCH, D)),
        'ctx': nrm((BATCH, CTX_LEN, D)),
        'c_ctx': nrm((D,)),
        'w_mod': nrm((DEPTH, D, N_MOD * D), 0.5 * D ** -0.5),
        'b_mod': nrm((DEPTH, N_MOD * D), 0.02),
        'norm_g': gain((DEPTH, 4, D)),
        'ab_w_in': nrm((N_EVEN, D, AB_IN), D ** -0.5),
        'ab_q_gain': gain((N_EVEN, HEAD_DIM)),
        'ab_k_gain': gain((N_EVEN, HEAD_DIM)),
        'pool_w': nrm((N_EVEN, N_POOL_GROUPS, POOL_GROUP, POOL_GROUP), POOL_GROUP ** -0.5),
        'pool_scale': gain((N_EVEN, POOL_W)),
        'ab_w_out': nrm((N_EVEN, AB_MIX, D), AB_MIX ** -0.5),
        'rw_mix': jax.random.uniform(next(keys), (N_ODD, N_SHIFT, D), F32),
        'rw_wr': nrm((N_ODD, D, D), D ** -0.5),
        'rw_wk': nrm((N_ODD, D, D), D ** -0.5),
        'rw_wv': nrm((N_ODD, D, D), D ** -0.5),
        'rw_wo': nrm((N_ODD, D, D), D ** -0.5),
        'rw_w0': jnp.linspace(-6.0, -1.0, D, dtype=F32) + nrm((N_ODD, N_DIR, D), 0.1),
        'rw_w1': nrm((N_ODD, N_DIR, D, DECAY_LORA), D ** -0.5),
        'rw_w2': nrm((N_ODD, N_DIR, DECAY_LORA, D), 0.5 * DECAY_LORA ** -0.5),
        'rw_a0': nrm((N_ODD, N_DIR, D), 0.1),
        'rw_a1': nrm((N_ODD, N_DIR, D, AAA_LORA), D ** -0.5),
        'rw_a2': nrm((N_ODD, N_DIR, AAA_LORA, D), 0.5 * AAA_LORA ** -0.5),
        'rw_g1': nrm((N_ODD, D, GATE_LORA), D ** -0.5),
        'rw_g2': nrm((N_ODD, GATE_LORA, D), GATE_LORA ** -0.5),
        'rw_k_k': 0.85 + nrm((N_ODD, D), 0.05),
        'rw_k_a': 1.0 + nrm((N_ODD, D), 0.05),
        'rw_r_k': nrm((N_ODD, RWKV_HEADS, RWKV_HEAD), 0.1),
        'rw_ln_w': gain((N_ODD, D)),
        'rw_ln_b': nrm((N_ODD, D), 0.02),
        'router_w': nrm((DEPTH, D, N_EXPERTS), D ** -0.5),
        'router_b': nrm((DEPTH, N_EXPERTS), 0.01),
        'moe_w_gate': nrm((DEPTH, N_EXPERTS, D, D_EXPERT), D ** -0.5),
        'moe_b_gate': nrm((DEPTH, N_EXPERTS, D_EXPERT), 0.01),
        'moe_w_up': nrm((DEPTH, N_EXPERTS, D, D_EXPERT), D ** -0.5),
        'moe_b_up': nrm((DEPTH, N_EXPERTS, D_EXPERT), 0.01),
        'moe_w_down': nrm((DEPTH, N_EXPERTS, D_EXPERT, D), D_EXPERT ** -0.5),
        'moe_b_down': nrm((DEPTH, N_EXPERTS, D), 0.01),
    }


def reference(x, c, ctx, c_ctx, w_mod, b_mod, norm_g,
              ab_w_in, ab_q_gain, ab_k_gain, pool_w, pool_scale, ab_w_out,
              rw_mix, rw_wr, rw_wk, rw_wv, rw_wo, rw_w0, rw_w1, rw_w2, rw_a0, rw_a1, rw_a2,
              rw_g1, rw_g2, rw_k_k, rw_k_a, rw_r_k, rw_ln_w, rw_ln_b,
              router_w, router_b, moe_w_gate, moe_b_gate, moe_w_up, moe_b_up, moe_w_down, moe_b_down):
    bn, n, d = x.shape
    n_ctx = ctx.shape[1]
    ang_row, ang_col = grid_angles(n)
    s_lat = jax.nn.silu(c.astype(F32))
    s_ctx = jax.nn.silu(c_ctx.astype(F32))
    x_lat, x_ctx = x, ctx
    for i in range(DEPTH):
        last = i == DEPTH - 1
        j = i // 2
        m_lat = jnp.split((s_lat @ w_mod[i] + b_mod[i]).astype(x.dtype)[:, None, :], N_MOD, axis=-1)
        m_ctx = jnp.split((s_ctx @ w_mod[i] + b_mod[i]).astype(x.dtype), N_MOD, axis=-1)
        g_pre_m, g_post_m, g_pre_f, g_post_f = norm_g[i]
        h_lat = modulate(rms_norm(x_lat, g_pre_m), m_lat[0], m_lat[1])
        h_ctx = modulate(rms_norm(x_ctx, g_pre_m), m_ctx[0], m_ctx[1])
        if i % 2 == 0:
            y_lat, y_ctx = attn_pool_mixer(h_lat, h_ctx, ang_row, ang_col, ab_w_in[j], ab_q_gain[j], ab_k_gain[j],
                                           pool_w[j], pool_scale[j], ab_w_out[j], not last)
        else:
            y_lat, y_ctx = rwkv_mixer(h_lat, h_ctx, rw_mix[j], rw_wr[j], rw_wk[j], rw_wv[j], rw_wo[j],
                                      rw_w0[j], rw_w1[j], rw_w2[j], rw_a0[j], rw_a1[j], rw_a2[j],
                                      rw_g1[j], rw_g2[j], rw_k_k[j], rw_k_a[j], rw_r_k[j], rw_ln_w[j], rw_ln_b[j], not last)
        x_lat = x_lat + m_lat[2] * rms_norm(y_lat, g_post_m)
        f_lat = modulate(rms_norm(x_lat, g_pre_f), m_lat[3], m_lat[4])
        moe_p = (router_w[i], router_b[i], moe_w_gate[i], moe_b_gate[i], moe_w_up[i], moe_b_up[i],
                 moe_w_down[i], moe_b_down[i])
        if last:
            ff = rms_norm(moe_ffn(f_lat.reshape(bn * n, d), *moe_p), g_post_f)
            x_lat = x_lat + m_lat[5] * ff.reshape(bn, n, d)
        else:
            x_ctx = x_ctx + m_ctx[2] * rms_norm(y_ctx, g_post_m)
            f_ctx = modulate(rms_norm(x_ctx, g_pre_f), m_ctx[3], m_ctx[4])
            tokens = jnp.concatenate([f_lat.reshape(bn * n, d), f_ctx.reshape(bn * n_ctx, d)], axis=0)
            ff = rms_norm(moe_ffn(tokens, *moe_p), g_post_f)
            x_lat = x_lat + m_lat[5] * ff[:bn * n].reshape(bn, n, d)
            x_ctx = x_ctx + m_ctx[5] * ff[bn * n:].reshape(bn, n_ctx, d)
    return x_lat
```

```cpp
#include <hip/hip_runtime.h>
#include <cstdio>
#include <cstdint>

namespace {
constexpr int D = 2048, NB = 2, SEQ = 4096, CTXL = 256;
constexpr int NLAT = NB * SEQ, NCTX = NB * CTXL, NTOK = NLAT + NCTX;
constexpr int KVLEN = SEQ + CTXL;
constexpr int NHEAD = 8, NKVH = 2, HD = 128, ATTN_W = 1024, KV_W = 256, POOL_W = 1024, AB_IN = 2560;
constexpr int NEXP = 32, TOPK = 4, DEXP = 1024;
constexpr int RH = 32, RN = 64;
constexpr int LORA = 96, GLORA = 256;
constexpr int NSLOT = NTOK * TOPK + NEXP * 256;
constexpr int LISTCAP = NTOK;
constexpr int NPHASE = 21;

constexpr size_t al256(size_t x) { return (x + 255) / 256 * 256; }
constexpr size_t WS_CTL = 0, CTL_BYTES = 1u << 20;
constexpr int CW_BAR = 4096;
constexpr int CW_CNT = 16384;
constexpr size_t WS_MOD = CTL_BYTES;
constexpr size_t WS_ROPE = WS_MOD + al256((size_t)2 * 3 * 6 * D * 4);
constexpr size_t WS_SELE = WS_ROPE + al256(2 * 64 * 32 * 4);
constexpr size_t WS_SELP = WS_SELE + al256((size_t)NTOK * 4 * 4);
constexpr size_t WS_LIST = WS_SELP + al256((size_t)NTOK * 4 * 4);
constexpr size_t WS_LISTG = WS_LIST + al256((size_t)NEXP * LISTCAP * 4);
constexpr size_t WS_X = WS_LISTG + al256((size_t)NEXP * LISTCAP * 4);
constexpr size_t WS_Y = WS_X + (size_t)NTOK * D * 4;
constexpr size_t WS_F = WS_Y + (size_t)NTOK * D * 4;
constexpr size_t WS_GT = WS_F + (size_t)NTOK * D * 2;
constexpr size_t WS_ACT = WS_GT + (size_t)NSLOT * DEXP * 4;
constexpr size_t WS_YE = WS_ACT + (size_t)NSLOT * DEXP * 2;
constexpr size_t WS_L = WS_YE + (size_t)NSLOT * D * 2;
constexpr size_t WS_H = WS_L;
constexpr size_t WS_U = WS_H + (size_t)NTOK * D * 2;
constexpr size_t WS_Q = WS_U + (size_t)NTOK * AB_IN * 2;
constexpr size_t WS_K = WS_Q + (size_t)NTOK * ATTN_W * 2;
constexpr size_t WS_V = WS_K + (size_t)NB * KVLEN * KV_W * 2;
constexpr size_t WS_MP = WS_V + (size_t)NB * KVLEN * KV_W * 2;
constexpr size_t WS_CAT = WS_MP + (size_t)NTOK * POOL_W * 2;
constexpr size_t WS_L0END = WS_CAT + (size_t)NTOK * D * 2;
constexpr size_t WS_H1 = WS_L;
constexpr size_t WS_XS = WS_H1 + (size_t)NTOK * D * 4;
constexpr size_t WS_R = WS_XS + (size_t)6 * NTOK * D * 2;
constexpr size_t WS_KK = WS_R + (size_t)NTOK * D * 4;
constexpr size_t WS_VV = WS_KK + (size_t)NTOK * D * 4;
constexpr size_t WS_LW = WS_VV + (size_t)NTOK * D * 4;
constexpr size_t WS_LA = WS_LW + (size_t)NTOK * 256 * 2;
constexpr size_t WS_LG = WS_LA + (size_t)NTOK * 256 * 2;
constexpr size_t WS_DEC = WS_LG + (size_t)NTOK * 256 * 2;
constexpr size_t WS_AS = WS_DEC + (size_t)2 * NTOK * D * 4;
constexpr size_t WS_G = WS_AS + (size_t)2 * NTOK * D * 4;
constexpr size_t WS_YS = WS_G + (size_t)NLAT * D * 4;
constexpr size_t WS_O = WS_YS + (size_t)2 * NLAT * D * 4;
constexpr size_t WS_L1END = WS_O + (size_t)NLAT * D * 2;
constexpr size_t WS_END = WS_L1END > WS_L0END ? WS_L1END : WS_L0END;

constexpr int LDS_BYTES = 147456;

typedef unsigned short bf16;
typedef float f32x4 __attribute__((ext_vector_type(4)));
typedef unsigned u32x2 __attribute__((ext_vector_type(2)));
typedef unsigned u32x4 __attribute__((ext_vector_type(4)));
#define LAS __attribute__((address_space(3)))

__device__ __forceinline__ float bf2f(unsigned v) { return __uint_as_float(v << 16); }
__device__ __forceinline__ unsigned f2bf(float f) { unsigned u = __float_as_uint(f); return (u + 0x7fffu + ((u >> 16) & 1u)) >> 16; }
__device__ __forceinline__ unsigned pk2(float lo, float hi) { return f2bf(lo) | (f2bf(hi) << 16); }
__device__ __forceinline__ float wsum(float v) {
#pragma unroll
    for (int o = 32; o >= 1; o >>= 1) v += __shfl_xor(v, o);
    return v;
}
__device__ __forceinline__ float wmax(float v) {
#pragma unroll
    for (int o = 32; o >= 1; o >>= 1) v = fmaxf(v, __shfl_xor(v, o));
    return v;
}
__device__ __forceinline__ float sigmoidf_(float x) { return 1.0f / (1.0f + __expf(-x)); }

#define XB_TMO      128
#define XB_XCNT(j)  (256  + 64 * (j))
#define XB_XSUB(j)  (1280 + 64 * (j))
#define XB_XGEN(j)  (2304 + 64 * (j))
#define XB_TOP      3328
#define XB_TOPGEN   3392
#define XCD_BAR_WORDS 3456
#define XB_SPIN_CAP (1u << 18)
__device__ __forceinline__ unsigned xb_ld(unsigned* p)              { return __hip_atomic_load(p, __ATOMIC_RELAXED, __HIP_MEMORY_SCOPE_AGENT); }
__device__ __forceinline__ unsigned xb_add(unsigned* p, unsigned v) { return __hip_atomic_fetch_add(p, v, __ATOMIC_RELAXED, __HIP_MEMORY_SCOPE_AGENT); }
__device__ __forceinline__ unsigned xb_xcc_id() { return (unsigned)__builtin_amdgcn_s_getreg((3 << 11) | 20) & 0xFu; }
#define XB_SPIN(cond, bar) do { unsigned _sp = 0; while (cond) { __builtin_amdgcn_s_sleep(1); \
    if ((++_sp & 255u) == 0u) { if (xb_ld(&(bar)[XB_TMO])) break; if (_sp > XB_SPIN_CAP) { atomicAdd(&(bar)[XB_TMO], 1u); break; } } } } while (0)
struct XcdBarrier { unsigned* bar; unsigned x; volatile LAS unsigned* st; };
__device__ __forceinline__ XcdBarrier xcd_barrier_post(unsigned* bar, volatile LAS unsigned* st) {
    XcdBarrier b; b.bar = bar; b.x = xb_xcc_id(); b.st = st;
    if (threadIdx.x == 0) (void)xb_add(&bar[XB_XCNT(b.x)], 1u);
    return b;
}
__device__ __forceinline__ void xcd_barrier_complete(unsigned* bar, unsigned x, unsigned& nloc, unsigned& nx) {
    const unsigned G = gridDim.x * gridDim.y * gridDim.z;
    unsigned sum, cnt, mine, sp = 0u;
    for (;;) {
        sum = 0u; cnt = 0u; mine = 0u;
#pragma unroll
        for (unsigned j = 0; j < 16; ++j) { const unsigned c = xb_ld(&bar[XB_XCNT(j)]); sum += c; cnt += (c > 0u) ? 1u : 0u; mine = (j == x) ? c : mine; }
        if (sum == G) break;
        __builtin_amdgcn_s_sleep(1);
        if ((++sp & 255u) == 0u) { if (xb_ld(&bar[XB_TMO])) break; if (sp > XB_SPIN_CAP) { atomicAdd(&bar[XB_TMO], 1u); break; } }
    }
    nloc = mine > 0u ? mine : 1u; nx = cnt > 0u ? cnt : 1u;
}
__device__ __forceinline__ void xcd_barrier(const XcdBarrier& b) {
    asm volatile("s_waitcnt vmcnt(0)" ::: "memory");
    __syncthreads();
    if (threadIdx.x == 0) {
        unsigned* bar = b.bar;
        __builtin_amdgcn_s_waitcnt(0);
        unsigned nloc = b.st[0], nx = b.st[1];
        if (nloc == 0u) { xcd_barrier_complete(bar, b.x, nloc, nx); b.st[0] = nloc; b.st[1] = nx; }
        const unsigned old = xb_add(&bar[XB_XSUB(b.x)], 1u);
        const unsigned gen = old / nloc;
        if (old + 1u == (gen + 1u) * nloc) {
            __builtin_amdgcn_fence(__ATOMIC_RELEASE, "agent");
            asm volatile("s_waitcnt vmcnt(0)" ::: "memory");
            const unsigned og = xb_add(&bar[XB_TOP], 1u);
            const unsigned tg = og / nx;
            if (og + 1u == (tg + 1u) * nx) xb_add(&bar[XB_TOPGEN], 1u);
            else XB_SPIN(xb_ld(&bar[XB_TOPGEN]) == tg, bar);
            __builtin_amdgcn_fence(__ATOMIC_ACQUIRE, "agent");
            xb_add(&bar[XB_XGEN(b.x)], 1u);
            asm volatile("s_waitcnt vmcnt(0)" ::: "memory");
        } else {
            XB_SPIN(xb_ld(&bar[XB_XGEN(b.x)]) == gen, bar);
            __builtin_amdgcn_fence(__ATOMIC_ACQUIRE, "agent");
            asm volatile("s_waitcnt vmcnt(0)" ::: "memory");
        }
    }
    __syncthreads();
}

struct Args { const float* in[39]; float* out; unsigned char* ws; int ph_lo, ph_hi; };
enum { I_X = 0, I_C, I_CTX, I_CCTX, I_WMOD, I_BMOD, I_NORMG, I_WIN, I_QGAIN, I_KGAIN, I_POOLW, I_POOLS, I_WOUT, I_MIX, I_WR, I_WK, I_WV, I_WO,
       I_W0, I_W1, I_W2, I_A0, I_A1, I_A2, I_G1, I_G2, I_KK, I_KA, I_RK, I_LNW, I_LNB, I_ROUTW, I_ROUTB, I_WGATE, I_BGATE, I_WUP, I_BUP, I_WDOWN, I_BDOWN };

struct Ctx {
    const Args* a; unsigned char* ws; LAS unsigned char* lds; int tid, lane, wave, gw, ngw, bid, G;
};
__device__ __forceinline__ const float* modp(const Ctx& c, int layer, int who, int part) { return (const float*)(c.ws + WS_MOD) + ((size_t)(layer * 3 + who) * 6 + part) * D; }
struct RowInfo { int b, t, n, who, seq0; };
__device__ __forceinline__ RowInfo rowinfo(int row) {
    RowInfo r;
    if (row < NLAT) { r.b = row / SEQ; r.t = row % SEQ; r.n = SEQ; r.who = r.b; r.seq0 = r.b * SEQ; }
    else { const int rc = row - NLAT; r.b = rc / CTXL; r.t = rc % CTXL; r.n = CTXL; r.who = 2; r.seq0 = NLAT + r.b * CTXL; }
    return r;
}

struct GemmS { const bf16* A; int lda; const int* gather; int M; const float* B; int ldb; int N; int K; };
template <class Epi>
__device__ __forceinline__ void sgemm_unit(const Ctx& c, const GemmS& g, int m0, int n0, const Epi& epi) {
    LAS float* As = (LAS float*)c.lds;
    LAS float* Bs = As + 16 * 132;
    const int tid = c.tid, ty = tid >> 5, tx = tid & 31;
    float acc[8][4];
#pragma unroll
    for (int i = 0; i < 8; ++i)
#pragma unroll
        for (int j = 0; j < 4; ++j) acc[i][j] = 0.f;
    const int ar = tid >> 2, akq = (tid & 3) * 4;
    const int arow_l = m0 + ar;
    long arow = -1;
    if (arow_l < g.M) arow = g.gather ? (long)g.gather[arow_l] : (long)arow_l;
    const int bk = tid >> 5, bn = (tid & 31) * 4;
    const bool bok = (n0 + bn) < g.N;
    for (int k0 = 0; k0 < g.K; k0 += 16) {
        u32x2 av = (u32x2){0u, 0u};
        if (arow >= 0) av = *(const u32x2*)(g.A + arow * g.lda + k0 + akq);
        f32x4 bv = (f32x4){0.f, 0.f, 0.f, 0.f};
        if (bok) bv = *(const f32x4*)(g.B + (size_t)(k0 + bk) * g.ldb + n0 + bn);
        __syncthreads();
        As[(akq + 0) * 132 + ar] = bf2f(av.x & 0xffffu); As[(akq + 1) * 132 + ar] = bf2f(av.x >> 16);
        As[(akq + 2) * 132 + ar] = bf2f(av.y & 0xffffu); As[(akq + 3) * 132 + ar] = bf2f(av.y >> 16);
        *(LAS f32x4*)(Bs + bk * 128 + bn) = bv;
        __syncthreads();
#pragma unroll
        for (int k = 0; k < 16; ++k) {
            const f32x4 a0 = *(const LAS f32x4*)(As + k * 132 + ty * 8), a1 = *(const LAS f32x4*)(As + k * 132 + ty * 8 + 4);
            const f32x4 b = *(const LAS f32x4*)(Bs + k * 128 + tx * 4);
            const float a[8] = {a0.x, a0.y, a0.z, a0.w, a1.x, a1.y, a1.z, a1.w};
#pragma unroll
            for (int i = 0; i < 8; ++i) { acc[i][0] += a[i] * b.x; acc[i][1] += a[i] * b.y; acc[i][2] += a[i] * b.z; acc[i][3] += a[i] * b.w; }
        }
    }
#pragma unroll
    for (int i = 0; i < 8; ++i) {
        const int r = m0 + ty * 8 + i;
        if (r < g.M) {
#pragma unroll
            for (int j = 0; j < 4; ++j) { const int cc = n0 + tx * 4 + j; if (cc < g.N) epi(r, cc, acc[i][j]); }
        }
    }
}
template <class Epi>
__device__ __forceinline__ void sgemm_all(const Ctx& c, const GemmS& g, const Epi& epi, int u0, int ustride) {
    const int nM = (g.M + 127) / 128, nN = (g.N + 127) / 128;
    for (int u = u0; u < nM * nN; u += ustride) sgemm_unit(c, g, (u / nN) * 128, (u % nN) * 128, epi);
}

struct EpiStoreBf16 { bf16* C; int ldc; __device__ __forceinline__ void operator()(int r, int cc, float v) const { C[(size_t)r * ldc + cc] = (bf16)f2bf(v); } };
struct EpiStoreF32 { float* C; int ldc; __device__ __forceinline__ void operator()(int r, int cc, float v) const { C[(size_t)r * ldc + cc] = v; } };
struct EpiPool { bf16* C; const float* scale; __device__ __forceinline__ void operator()(int r, int cc, float v) const { C[(size_t)r * D + cc] = (bf16)f2bf(v * scale[cc]); } };
struct EpiTanhBf16 { bf16* C; int ldc; __device__ __forceinline__ void operator()(int r, int cc, float v) const { C[(size_t)r * ldc + cc] = (bf16)f2bf(tanhf(v)); } };
struct EpiSigBf16 { bf16* C; int ldc; __device__ __forceinline__ void operator()(int r, int cc, float v) const { C[(size_t)r * ldc + cc] = (bf16)f2bf(sigmoidf_(v)); } };
struct EpiDecay { float* C; const float* w0; __device__ __forceinline__ void operator()(int r, int cc, float v) const {
    const float z = -(w0[cc] + v);
    const float sp = (z > 20.f) ? z : log1pf(__expf(z));
    C[(size_t)r * D + cc] = __expf(-__expf(-sp - 0.5f)); } };
struct EpiSigBias { float* C; const float* a0; __device__ __forceinline__ void operator()(int r, int cc, float v) const { C[(size_t)r * D + cc] = sigmoidf_(a0[cc] + v); } };
struct EpiGateTmp { float* GT; const float* bias; int slot0; __device__ __forceinline__ void operator()(int r, int cc, float v) const { GT[(size_t)(slot0 + r) * DEXP + cc] = v + bias[cc]; } };
struct EpiUpAct { const float* GT; bf16* ACT; const float* bias; int slot0; __device__ __forceinline__ void operator()(int r, int cc, float v) const {
    const float glu = fminf(GT[(size_t)(slot0 + r) * DEXP + cc], 7.0f);
    const float lin = fminf(fmaxf(v + bias[cc], -7.0f), 7.0f);
    ACT[(size_t)(slot0 + r) * DEXP + cc] = (bf16)f2bf(glu * sigmoidf_(1.702f * glu) * (lin + 1.0f)); } };
struct EpiDown { bf16* YE; const float* bias; const float* gate; int slot0; __device__ __forceinline__ void operator()(int r, int cc, float v) const {
    YE[(size_t)(slot0 + r) * D + cc] = (bf16)f2bf((v + bias[cc]) * gate[r]); } };

__device__ __forceinline__ void ph_mod(const Ctx& c) {
    const Args& a = *c.a;
    LAS float* s = (LAS float*)c.lds;
    LAS float* red = s + 3 * D;
    for (int i = c.tid; i < 3 * D; i += 512) { const int who = i / D, k = i % D; const float v = who < 2 ? a.in[I_C][who * D + k] : a.in[I_CCTX][k]; s[i] = v / (1.0f + __expf(-v)); }
    __syncthreads();
    const int kq = c.tid >> 5, cl = c.tid & 31;
    for (int u = c.bid; u < 2 * (6 * D / 32); u += c.G) {
        const int layer = u / (6 * D / 32), col = (u % (6 * D / 32)) * 32 + cl;
        const float* w = a.in[I_WMOD] + (size_t)layer * D * 6 * D + col;
        float a0 = 0.f, a1 = 0.f, a2 = 0.f;
#pragma unroll 8
        for (int k = kq * 128; k < kq * 128 + 128; ++k) { const float wv = w[(size_t)k * 6 * D]; a0 += s[k] * wv; a1 += s[D + k] * wv; a2 += s[2 * D + k] * wv; }
        red[(kq * 3 + 0) * 32 + cl] = a0; red[(kq * 3 + 1) * 32 + cl] = a1; red[(kq * 3 + 2) * 32 + cl] = a2;
        __syncthreads();
        if (c.tid < 96) { const int who = c.tid / 32, cc = c.tid % 32; float t = 0.f;
            for (int q = 0; q < 16; ++q) t += red[(q * 3 + who) * 32 + cc];
            const int colg = (u % (6 * D / 32)) * 32 + cc;
            ((float*)(c.ws + WS_MOD))[((size_t)(layer * 3 + who) * 6) * D + colg] = t + a.in[I_BMOD][layer * 6 * D + colg]; }
        __syncthreads();
    }
    if (c.bid == 0 && c.tid < 32) {
        const int d = c.tid; double inv = 1.0; for (int i = 0; i < d; ++i) inv *= 0.7498942093324559;
        double sn = 0.0, cs = 0.0, term = 1.0;
        for (int n = 0; n < 24; ++n) { if ((n & 1) == 0) cs += ((n & 2) ? -term : term); else sn += ((n & 2) ? -term : term); term *= inv / (double)(n + 1); }
        double cp = 1.0, sp = 0.0; float* ct = (float*)(c.ws + WS_ROPE); float* st = ct + 64 * 32;
        for (int p = 0; p < 64; ++p) { ct[p * 32 + d] = (float)cp; st[p * 32 + d] = (float)sp; const double nc = cp * cs - sp * sn, ns = sp * cs + cp * sn; cp = nc; sp = ns; }
    }
}

__device__ __forceinline__ void ph_prenorm0(const Ctx& c) {
    const Args& a = *c.a; bf16* H = (bf16*)(c.ws + WS_H);
    const float* g = a.in[I_NORMG];
    for (int row = c.gw; row < NTOK; row += c.ngw) {
        const RowInfo ri = rowinfo(row);
        const float* xr = row < NLAT ? a.in[I_X] + (size_t)row * D : a.in[I_CTX] + (size_t)(row - NLAT) * D;
        const float* sh = modp(c, 0, ri.who, 0); const float* sc = modp(c, 0, ri.who, 1);
        f32x4 v[8]; float ss = 0.f;
#pragma unroll
        for (int j = 0; j < 8; ++j) { v[j] = ((const f32x4*)xr)[j * 64 + c.lane]; ss += v[j].x * v[j].x + v[j].y * v[j].y + v[j].z * v[j].z + v[j].w * v[j].w; }
        const float rstd = rsqrtf(wsum(ss) * (1.0f / D) + 1e-6f);
#pragma unroll
        for (int j = 0; j < 8; ++j) { const int idx = j * 256 + c.lane * 4;
            const f32x4 gg = *(const f32x4*)(g + idx), s4 = *(const f32x4*)(sh + idx), c4 = *(const f32x4*)(sc + idx);
            const f32x4 h = v[j] * rstd * gg * (c4 + 1.0f) + s4;
            u32x2 o; o.x = pk2(h.x, h.y); o.y = pk2(h.z, h.w); *(u32x2*)(H + (size_t)row * D + idx) = o; }
    }
}

__device__ __forceinline__ void ph_prep0(const Ctx& c) {
    const Args& a = *c.a;
    const bf16* U = (const bf16*)(c.ws + WS_U); bf16* Q = (bf16*)(c.ws + WS_Q); bf16* Kb = (bf16*)(c.ws + WS_K); bf16* Vb = (bf16*)(c.ws + WS_V); bf16* MP = (bf16*)(c.ws + WS_MP);
    const float* ct = (const float*)(c.ws + WS_ROPE); const float* st = ct + 64 * 32;
    const int lane = c.lane;
    for (int row = c.gw; row < NTOK; row += c.ngw) {
        const RowInfo ri = rowinfo(row); const bool lat = row < NLAT;
        const bf16* u = U + (size_t)row * AB_IN;
        const int kvpos = lat ? ri.t : SEQ + ri.t;
        const int prow = ri.t >> 6, pcol = ri.t & 63;
#pragma unroll
        for (int pass = 0; pass < 2; ++pass) {
            const int e0 = (pass ? ATTN_W : 0) + lane * 16;
            const u32x4 r0 = *(const u32x4*)(u + e0), r1 = *(const u32x4*)(u + e0 + 8);
            float x[16];
            x[0] = bf2f(r0.x & 0xffffu); x[1] = bf2f(r0.x >> 16); x[2] = bf2f(r0.y & 0xffffu); x[3] = bf2f(r0.y >> 16);
            x[4] = bf2f(r0.z & 0xffffu); x[5] = bf2f(r0.z >> 16); x[6] = bf2f(r0.w & 0xffffu); x[7] = bf2f(r0.w >> 16);
            x[8] = bf2f(r1.x & 0xffffu); x[9] = bf2f(r1.x >> 16); x[10] = bf2f(r1.y & 0xffffu); x[11] = bf2f(r1.y >> 16);
            x[12] = bf2f(r1.z & 0xffffu); x[13] = bf2f(r1.z >> 16); x[14] = bf2f(r1.w & 0xffffu); x[15] = bf2f(r1.w >> 16);
            float ss = 0.f;
#pragma unroll
            for (int i = 0; i < 16; ++i) ss += x[i] * x[i];
            ss += __shfl_xor(ss, 1); ss += __shfl_xor(ss, 2); ss += __shfl_xor(ss, 4);
            const float rstd = rsqrtf(ss * (1.0f / HD) + 1e-6f);
            const float* gain = (pass ? a.in[I_KGAIN] : a.in[I_QGAIN]) + (lane & 7) * 16;
            const int s = lane & 7, sub = s & 3, pos = (s >> 2) ? pcol : prow;
            float o[16];
#pragma unroll
            for (int i = 0; i < 16; ++i) {
                const float xv = x[i] * rstd * gain[i];
                const float pv = __shfl_xor(xv, 2);
                if (lat) { const int d = (sub & 1) * 16 + i; const float cs = ct[pos * 32 + d], sn = st[pos * 32 + d];
                    o[i] = (sub & 2) ? (xv * cs + pv * sn) : (xv * cs - pv * sn); }
                else o[i] = xv;
            }
            u32x4 w0, w1;
            w0.x = pk2(o[0], o[1]); w0.y = pk2(o[2], o[3]); w0.z = pk2(o[4], o[5]); w0.w = pk2(o[6], o[7]);
            w1.x = pk2(o[8], o[9]); w1.y = pk2(o[10], o[11]); w1.z = pk2(o[12], o[13]); w1.w = pk2(o[14], o[15]);
            if (pass == 0) { bf16* dst = Q + (size_t)row * ATTN_W + lane * 16; *(u32x4*)dst = w0; *(u32x4*)(dst + 8) = w1; }
            else if (lane < 16) { bf16* dst = Kb + ((size_t)ri.b * KVLEN + kvpos) * KV_W + lane * 16; *(u32x4*)dst = w0; *(u32x4*)(dst + 8) = w1; }
        }
        if (lane >= 16 && lane < 32) {
            const bf16* src = u + ATTN_W + KV_W + (lane - 16) * 16; bf16* dst = Vb + ((size_t)ri.b * KVLEN + kvpos) * KV_W + (lane - 16) * 16;
            *(u32x4*)dst = *(const u32x4*)src; *(u32x4*)(dst + 8) = *(const u32x4*)(src + 8);
        }
        {
            const int c0 = lane * 16, gi = lane >> 4, half = 1 << gi;
            const int lo = ri.t - half < 0 ? 0 : ri.t - half, hi = ri.t + half > ri.n ? ri.n : ri.t + half;
            float acc[16];
#pragma unroll
            for (int i = 0; i < 16; ++i) acc[i] = 0.f;
            for (int tt = lo; tt < hi; ++tt) {
                const bf16* p = U + (size_t)(ri.seq0 + tt) * AB_IN + ATTN_W + 2 * KV_W + c0;
                const u32x4 r0 = *(const u32x4*)p, r1 = *(const u32x4*)(p + 8);
                acc[0] += bf2f(r0.x & 0xffffu); acc[1] += bf2f(r0.x >> 16); acc[2] += bf2f(r0.y & 0xffffu); acc[3] += bf2f(r0.y >> 16);
                acc[4] += bf2f(r0.z & 0xffffu); acc[5] += bf2f(r0.z >> 16); acc[6] += bf2f(r0.w & 0xffffu); acc[7] += bf2f(r0.w >> 16);
                acc[8] += bf2f(r1.x & 0xffffu); acc[9] += bf2f(r1.x >> 16); acc[10] += bf2f(r1.y & 0xffffu); acc[11] += bf2f(r1.y >> 16);
                acc[12] += bf2f(r1.z & 0xffffu); acc[13] += bf2f(r1.z >> 16); acc[14] += bf2f(r1.w & 0xffffu); acc[15] += bf2f(r1.w >> 16);
            }
            const float inv = 1.0f / (float)(hi - lo);
            const bf16* p = u + ATTN_W + 2 * KV_W + c0;
            const u32x4 r0 = *(const u32x4*)p, r1 = *(const u32x4*)(p + 8);
            float sv[16];
            sv[0] = bf2f(r0.x & 0xffffu); sv[1] = bf2f(r0.x >> 16); sv[2] = bf2f(r0.y & 0xffffu); sv[3] = bf2f(r0.y >> 16);
            sv[4] = bf2f(r0.z & 0xffffu); sv[5] = bf2f(r0.z >> 16); sv[6] = bf2f(r0.w & 0xffffu); sv[7] = bf2f(r0.w >> 16);
            sv[8] = bf2f(r1.x & 0xffffu); sv[9] = bf2f(r1.x >> 16); sv[10] = bf2f(r1.y & 0xffffu); sv[11] = bf2f(r1.y >> 16);
            sv[12] = bf2f(r1.z & 0xffffu); sv[13] = bf2f(r1.z >> 16); sv[14] = bf2f(r1.w & 0xffffu); sv[15] = bf2f(r1.w >> 16);
            u32x4 w0, w1;
            w0.x = pk2(acc[0] * inv - sv[0], acc[1] * inv - sv[1]); w0.y = pk2(acc[2] * inv - sv[2], acc[3] * inv - sv[3]);
            w0.z = pk2(acc[4] * inv - sv[4], acc[5] * inv - sv[5]); w0.w = pk2(acc[6] * inv - sv[6], acc[7] * inv - sv[7]);
            w1.x = pk2(acc[8] * inv - sv[8], acc[9] * inv - sv[9]); w1.y = pk2(acc[10] * inv - sv[10], acc[11] * inv - sv[11]);
            w1.z = pk2(acc[12] * inv - sv[12], acc[13] * inv - sv[13]); w1.w = pk2(acc[14] * inv - sv[14], acc[15] * inv - sv[15]);
            bf16* dst = MP + (size_t)row * POOL_W + c0; *(u32x4*)dst = w0; *(u32x4*)(dst + 8) = w1;
        }
    }
}

__device__ __forceinline__ void attn_simple_unit(const Ctx& c, const bf16* Qrows  , const bf16* Kh, const bf16* Vh  ,
                                                 int nkeys, bf16* Orows  ) {
    LAS float* Qs = (LAS float*)c.lds;
    LAS float* Ks = Qs + 64 * 132;
    LAS float* Vs = Ks + 64 * 132;
    LAS float* Ps = Vs + 64 * 128;
    const int tid = c.tid, qi = tid >> 3, g8 = tid & 7;
    __syncthreads();
    for (int i = tid; i < 64 * 16; i += 512) { const int r = i >> 4, cc = (i & 15) * 8; const u32x4 v = *(const u32x4*)(Qrows + (size_t)r * ATTN_W + cc);
        LAS float* d = Qs + r * 132 + cc; d[0] = bf2f(v.x & 0xffffu); d[1] = bf2f(v.x >> 16); d[2] = bf2f(v.y & 0xffffu); d[3] = bf2f(v.y >> 16);
        d[4] = bf2f(v.z & 0xffffu); d[5] = bf2f(v.z >> 16); d[6] = bf2f(v.w & 0xffffu); d[7] = bf2f(v.w >> 16); }
    float m = -1e30f, l = 0.f, o[16];
#pragma unroll
    for (int i = 0; i < 16; ++i) o[i] = 0.f;
    const float scale = 0.08838834764831845f;
    for (int k0 = 0; k0 < nkeys; k0 += 64) {
        __syncthreads();
        for (int i = tid; i < 64 * 16; i += 512) { const int r = i >> 4, cc = (i & 15) * 8;
            const u32x4 v = *(const u32x4*)(Kh + (size_t)(k0 + r) * KV_W + cc); const u32x4 w = *(const u32x4*)(Vh + (size_t)(k0 + r) * KV_W + cc);
            LAS float* d = Ks + r * 132 + cc; d[0] = bf2f(v.x & 0xffffu); d[1] = bf2f(v.x >> 16); d[2] = bf2f(v.y & 0xffffu); d[3] = bf2f(v.y >> 16);
            d[4] = bf2f(v.z & 0xffffu); d[5] = bf2f(v.z >> 16); d[6] = bf2f(v.w & 0xffffu); d[7] = bf2f(v.w >> 16);
            LAS float* e = Vs + r * 128 + cc; e[0] = bf2f(w.x & 0xffffu); e[1] = bf2f(w.x >> 16); e[2] = bf2f(w.y & 0xffffu); e[3] = bf2f(w.y >> 16);
            e[4] = bf2f(w.z & 0xffffu); e[5] = bf2f(w.z >> 16); e[6] = bf2f(w.w & 0xffffu); e[7] = bf2f(w.w >> 16); }
        __syncthreads();
        float s[8];
#pragma unroll
        for (int j = 0; j < 8; ++j) s[j] = 0.f;
        for (int d4 = 0; d4 < 128; d4 += 4) {
            const f32x4 q = *(const LAS f32x4*)(Qs + qi * 132 + d4);
#pragma unroll
            for (int j = 0; j < 8; ++j) { const f32x4 kk = *(const LAS f32x4*)(Ks + (g8 * 8 + j) * 132 + d4); s[j] += q.x * kk.x + q.y * kk.y + q.z * kk.z + q.w * kk.w; }
        }
        float mx = -1e30f;
#pragma unroll
        for (int j = 0; j < 8; ++j) { s[j] *= scale; mx = fmaxf(mx, s[j]); }
        mx = fmaxf(mx, __shfl_xor(mx, 1)); mx = fmaxf(mx, __shfl_xor(mx, 2)); mx = fmaxf(mx, __shfl_xor(mx, 4));
        const float mn = fmaxf(m, mx), alpha = __expf(m - mn);
        float ps = 0.f;
#pragma unroll
        for (int j = 0; j < 8; ++j) { const float p = __expf(s[j] - mn); ps += p; Ps[qi * 68 + g8 * 8 + j] = p; }
        ps += __shfl_xor(ps, 1); ps += __shfl_xor(ps, 2); ps += __shfl_xor(ps, 4);
        l = l * alpha + ps; m = mn;
#pragma unroll
        for (int i = 0; i < 16; ++i) o[i] *= alpha;
        __syncthreads();
        for (int j = 0; j < 64; ++j) {
            const float p = Ps[qi * 68 + j];
#pragma unroll
            for (int i4 = 0; i4 < 4; ++i4) { const f32x4 v = *(const LAS f32x4*)(Vs + j * 128 + g8 * 16 + i4 * 4);
                o[i4 * 4 + 0] += p * v.x; o[i4 * 4 + 1] += p * v.y; o[i4 * 4 + 2] += p * v.z; o[i4 * 4 + 3] += p * v.w; }
        }
    }
    const float il = 1.0f / l;
    u32x4 w0, w1;
    w0.x = pk2(o[0] * il, o[1] * il); w0.y = pk2(o[2] * il, o[3] * il); w0.z = pk2(o[4] * il, o[5] * il); w0.w = pk2(o[6] * il, o[7] * il);
    w1.x = pk2(o[8] * il, o[9] * il); w1.y = pk2(o[10] * il, o[11] * il); w1.z = pk2(o[12] * il, o[13] * il); w1.w = pk2(o[14] * il, o[15] * il);
    bf16* dst = Orows + (size_t)qi * D + g8 * 16; *(u32x4*)dst = w0; *(u32x4*)(dst + 8) = w1;
}
__device__ __forceinline__ void ph_attn_pool(const Ctx& c) {
    const Args& a = *c.a;
    const bf16* Q = (const bf16*)(c.ws + WS_Q); const bf16* Kb = (const bf16*)(c.ws + WS_K); const bf16* Vb = (const bf16*)(c.ws + WS_V); bf16* CAT = (bf16*)(c.ws + WS_CAT);
    constexpr int NU_LAT = NB * NHEAD * (SEQ / 64), NU_CTX = NB * NHEAD * (CTXL / 64);
    for (int u = c.bid; u < NU_LAT + NU_CTX; u += c.G) {
        if (u < NU_LAT) { const int qb = u % (SEQ / 64), h = (u / (SEQ / 64)) % NHEAD, b = u / (SEQ / 64 * NHEAD); const int row0 = b * SEQ + qb * 64;
            attn_simple_unit(c, Q + (size_t)row0 * ATTN_W + h * HD, Kb + (size_t)b * KVLEN * KV_W + (h / 4) * HD, Vb + (size_t)b * KVLEN * KV_W + (h / 4) * HD, KVLEN, CAT + (size_t)row0 * D + h * HD); }
        else { const int v = u - NU_LAT; const int qb = v % (CTXL / 64), h = (v / (CTXL / 64)) % NHEAD, b = v / (CTXL / 64 * NHEAD); const int row0 = NLAT + b * CTXL + qb * 64;
            attn_simple_unit(c, Q + (size_t)row0 * ATTN_W + h * HD, Kb + ((size_t)b * KVLEN + SEQ) * KV_W + (h / 4) * HD, Vb + ((size_t)b * KVLEN + SEQ) * KV_W + (h / 4) * HD, CTXL, CAT + (size_t)row0 * D + h * HD); }
    }
    __syncthreads();
    const int nu = (NTOK / 128) * 2;
    for (int u = c.bid; u < 4 * nu; u += c.G) {
        const int gi = u / nu, uu = u % nu;
        GemmS g{(const bf16*)(c.ws + WS_MP) + gi * 256, POOL_W, nullptr, NTOK, a.in[I_POOLW] + (size_t)gi * 256 * 256, 256, 256, 256};
        EpiPool e{CAT + ATTN_W + gi * 256, a.in[I_POOLS] + gi * 256};
        sgemm_unit(c, g, (uu / 2) * 128, (uu % 2) * 128, e);
    }
}

__device__ __forceinline__ void ph_rowA(const Ctx& c, int layer) {
    const Args& a = *c.a;
    const float* Y = (const float*)(c.ws + WS_Y); float* X = (float*)(c.ws + WS_X); bf16* F = (bf16*)(c.ws + WS_F);
    int* SELE = (int*)(c.ws + WS_SELE); int* SELP = (int*)(c.ws + WS_SELP); int* LIST = (int*)(c.ws + WS_LIST); float* LISTG = (float*)(c.ws + WS_LISTG);
    unsigned* CNT = (unsigned*)(c.ws + WS_CTL) + CW_CNT + layer * 64;
    const float* gpost = a.in[I_NORMG] + (size_t)(layer * 4 + 1) * D; const float* gpre = a.in[I_NORMG] + (size_t)(layer * 4 + 2) * D;
    const float* RW = a.in[I_ROUTW] + (size_t)layer * D * NEXP; const float* RB = a.in[I_ROUTB] + layer * NEXP;
    const int nrows = layer == 0 ? NTOK : NLAT; const int lane = c.lane;
    for (int row = c.gw; row < nrows; row += c.ngw) {
        const RowInfo ri = rowinfo(row);
        const float* xr = layer == 0 ? (row < NLAT ? a.in[I_X] + (size_t)row * D : a.in[I_CTX] + (size_t)(row - NLAT) * D) : X + (size_t)row * D;
        const float* m2 = modp(c, layer, ri.who, 2); const float* m3 = modp(c, layer, ri.who, 3); const float* m4 = modp(c, layer, ri.who, 4);
        f32x4 v[8]; float ss = 0.f;
#pragma unroll
        for (int j = 0; j < 8; ++j) { v[j] = ((const f32x4*)(Y + (size_t)row * D))[j * 64 + lane]; ss += v[j].x * v[j].x + v[j].y * v[j].y + v[j].z * v[j].z + v[j].w * v[j].w; }
        float rstd = rsqrtf(wsum(ss) * (1.0f / D) + 1e-6f);
        ss = 0.f;
#pragma unroll
        for (int j = 0; j < 8; ++j) { const int idx = j * 256 + lane * 4;
            const f32x4 x0 = *(const f32x4*)(xr + idx), gg = *(const f32x4*)(gpost + idx), mm = *(const f32x4*)(m2 + idx);
            v[j] = x0 + mm * (v[j] * rstd * gg);
            *(f32x4*)(X + (size_t)row * D + idx) = v[j];
            ss += v[j].x * v[j].x + v[j].y * v[j].y + v[j].z * v[j].z + v[j].w * v[j].w; }
        rstd = rsqrtf(wsum(ss) * (1.0f / D) + 1e-6f);
        LAS float* fl = (LAS float*)(c.lds + c.wave * 8192);
#pragma unroll
        for (int j = 0; j < 8; ++j) { const int idx = j * 256 + lane * 4;
            const f32x4 gg = *(const f32x4*)(gpre + idx), s4 = *(const f32x4*)(m3 + idx), c4 = *(const f32x4*)(m4 + idx);
            const f32x4 f = v[j] * rstd * gg * (c4 + 1.0f) + s4;
            u32x2 o; o.x = pk2(f.x, f.y); o.y = pk2(f.z, f.w); *(u32x2*)(F + (size_t)row * D + idx) = o;
            *(LAS f32x4*)(fl + idx) = f; }
        __builtin_amdgcn_wave_barrier();
        float mine;
        {
            const int e = lane & 31, kh = lane >> 5; const float* wp = RW + (size_t)kh * 1024 * NEXP + e; const LAS float* fp = fl + kh * 1024;
            float a0 = 0.f, a1 = 0.f, a2 = 0.f, a3 = 0.f;
#pragma unroll 2
            for (int k = 0; k < 1024; k += 4) { const f32x4 fv = *(const LAS f32x4*)(fp + k);
                a0 += fv.x * wp[(size_t)(k + 0) * NEXP]; a1 += fv.y * wp[(size_t)(k + 1) * NEXP]; a2 += fv.z * wp[(size_t)(k + 2) * NEXP]; a3 += fv.w * wp[(size_t)(k + 3) * NEXP]; }
            float t = (a0 + a1) + (a2 + a3); t += __shfl_xor(t, 32);
            mine = lane < NEXP ? t + RB[e] : -3.0e38f;
        }
        __builtin_amdgcn_wave_barrier();
        int sel[4]; float sv[4];
#pragma unroll
        for (int r = 0; r < 4; ++r) {
            const float mx = wmax(mine);
            const unsigned long long bal = __ballot(mine == mx && lane < NEXP);
            const int idx = __ffsll((long long)bal) - 1;
            sel[r] = idx; sv[r] = mx; if (lane == idx) mine = -3.0e38f;
        }
        const float e1 = __expf(sv[1] - sv[0]), e2 = __expf(sv[2] - sv[0]), e3 = __expf(sv[3] - sv[0]);
        const float inv = 1.0f / (1.0f + e1 + e2 + e3);
        if (lane < 4) {
            const int e = lane == 0 ? sel[0] : lane == 1 ? sel[1] : lane == 2 ? sel[2] : sel[3];
            const float gt = (lane == 0 ? 1.0f : lane == 1 ? e1 : lane == 2 ? e2 : e3) * inv;
            const unsigned pos = __hip_atomic_fetch_add(CNT + e, 1u, __ATOMIC_RELAXED, __HIP_MEMORY_SCOPE_AGENT);
            LIST[e * LISTCAP + pos] = row; LISTG[e * LISTCAP + pos] = gt;
            SELE[row * 4 + lane] = e; SELP[row * 4 + lane] = (int)pos;
        }
    }
}

__device__ __forceinline__ void moe_tables(const Ctx& c, int layer, LAS int* tb) {
    __syncthreads();
    if (c.tid == 0) { const unsigned* CNT = (const unsigned*)(c.ws + WS_CTL) + CW_CNT + layer * 64; int base = 0, tp = 0;
        for (int e = 0; e < NEXP; ++e) { const int n = (int)__hip_atomic_load(CNT + e, __ATOMIC_RELAXED, __HIP_MEMORY_SCOPE_AGENT); tb[e] = n; tb[32 + e] = base; tb[64 + e] = tp; base += (n + 255) / 256 * 256; tp += (n + 127) / 128; }
        tb[96] = tp; }
    __syncthreads();
}
__device__ __forceinline__ void ph_moe_gu(const Ctx& c, int layer, int which  ) {
    const Args& a = *c.a; LAS int* tb = (LAS int*)(c.lds + 65536);
    moe_tables(c, layer, tb);
    const int ntile = tb[96], nN = DEXP / 128;
    for (int u = c.bid; u < ntile * nN; u += c.G) {
        const int mt = u / nN, nt = u % nN; int e = 0;
        for (int q = 1; q < NEXP; ++q) if (tb[64 + q] <= mt) e = q;
        const int m0 = (mt - tb[64 + e]) * 128;
        const float* W = (which ? a.in[I_WUP] : a.in[I_WGATE]) + ((size_t)layer * NEXP + e) * D * DEXP;
        const float* bias = (which ? a.in[I_BUP] : a.in[I_BGATE]) + ((size_t)layer * NEXP + e) * DEXP;
        GemmS g{(const bf16*)(c.ws + WS_F), D, (const int*)(c.ws + WS_LIST) + e * LISTCAP, tb[e], W, DEXP, DEXP, D};
        if (which == 0) { EpiGateTmp ep{(float*)(c.ws + WS_GT), bias, tb[32 + e]}; sgemm_unit(c, g, m0, nt * 128, ep); }
        else { EpiUpAct ep{(const float*)(c.ws + WS_GT), (bf16*)(c.ws + WS_ACT), bias, tb[32 + e]}; sgemm_unit(c, g, m0, nt * 128, ep); }
    }
}
__device__ __forceinline__ void ph_moe_down(const Ctx& c, int layer) {
    const Args& a = *c.a; LAS int* tb = (LAS int*)(c.lds + 65536);
    moe_tables(c, layer, tb);
    const int ntile = tb[96], nN = D / 128;
    for (int u = c.bid; u < ntile * nN; u += c.G) {
        const int mt = u / nN, nt = u % nN; int e = 0;
        for (int q = 1; q < NEXP; ++q) if (tb[64 + q] <= mt) e = q;
        const int m0 = (mt - tb[64 + e]) * 128;
        GemmS g{(const bf16*)(c.ws + WS_ACT) + (size_t)tb[32 + e] * DEXP, DEXP, nullptr, tb[e], a.in[I_WDOWN] + ((size_t)layer * NEXP + e) * DEXP * D, D, D, DEXP};
        EpiDown ep{(bf16*)(c.ws + WS_YE), a.in[I_BDOWN] + ((size_t)layer * NEXP + e) * D, (const float*)(c.ws + WS_LISTG) + e * LISTCAP, tb[32 + e]};
        sgemm_unit(c, g, m0, nt * 128, ep);
    }
}

__device__ __forceinline__ void ph_rowB(const Ctx& c, int layer) {
    const Args& a = *c.a;
    float* X = (float*)(c.ws + WS_X); const bf16* YE = (const bf16*)(c.ws + WS_YE); float* H1 = (float*)(c.ws + WS_H1);
    const int* SELE = (const int*)(c.ws + WS_SELE); const int* SELP = (const int*)(c.ws + WS_SELP);
    const unsigned* CNT = (const unsigned*)(c.ws + WS_CTL) + CW_CNT + layer * 64;
    const float* gpf = a.in[I_NORMG] + (size_t)(layer * 4 + 3) * D; const float* gpm1 = a.in[I_NORMG] + (size_t)(1 * 4 + 0) * D;
    const int nrows = layer == 0 ? NTOK : NLAT; const int lane = c.lane;
    int mybase;
    { int n = lane < NEXP ? (int)__hip_atomic_load(CNT + (lane & 31), __ATOMIC_RELAXED, __HIP_MEMORY_SCOPE_AGENT) : 0; n = (n + 255) / 256 * 256; int incl = n;
#pragma unroll
      for (int o = 1; o < 32; o <<= 1) { const int t = __shfl_up(incl, o); if ((lane & 31) >= o) incl += t; }
      mybase = incl - n; }
    for (int row = c.gw; row < nrows; row += c.ngw) {
        const RowInfo ri = rowinfo(row);
        f32x4 v[8];
#pragma unroll
        for (int j = 0; j < 8; ++j) v[j] = (f32x4){0.f, 0.f, 0.f, 0.f};
#pragma unroll
        for (int r = 0; r < 4; ++r) {
            const int e = SELE[row * 4 + r], pos = SELP[row * 4 + r];
            const int slot = __shfl(mybase, e) + pos;
            const bf16* yr = YE + (size_t)slot * D;
#pragma unroll
            for (int j = 0; j < 8; ++j) { const u32x2 w = *(const u32x2*)(yr + j * 256 + lane * 4);
                v[j].x += bf2f(w.x & 0xffffu); v[j].y += bf2f(w.x >> 16); v[j].z += bf2f(w.y & 0xffffu); v[j].w += bf2f(w.y >> 16); }
        }
        float ss = 0.f;
#pragma unroll
        for (int j = 0; j < 8; ++j) ss += v[j].x * v[j].x + v[j].y * v[j].y + v[j].z * v[j].z + v[j].w * v[j].w;
        float rstd = rsqrtf(wsum(ss) * (1.0f / D) + 1e-6f);
        const float* m5 = modp(c, layer, ri.who, 5);
        ss = 0.f;
#pragma unroll
        for (int j = 0; j < 8; ++j) { const int idx = j * 256 + lane * 4;
            const f32x4 x0 = *(const f32x4*)(X + (size_t)row * D + idx), gg = *(const f32x4*)(gpf + idx), mm = *(const f32x4*)(m5 + idx);
            v[j] = x0 + mm * (v[j] * rstd * gg);
            ss += v[j].x * v[j].x + v[j].y * v[j].y + v[j].z * v[j].z + v[j].w * v[j].w; }
        if (layer == 1) {
#pragma unroll
            for (int j = 0; j < 8; ++j) *(f32x4*)(a.out + (size_t)row * D + j * 256 + lane * 4) = v[j];
        } else {
            rstd = rsqrtf(wsum(ss) * (1.0f / D) + 1e-6f);
            const float* sh = modp(c, 1, ri.who, 0); const float* sc = modp(c, 1, ri.who, 1);
#pragma unroll
            for (int j = 0; j < 8; ++j) { const int idx = j * 256 + lane * 4;
                *(f32x4*)(X + (size_t)row * D + idx) = v[j];
                const f32x4 gg = *(const f32x4*)(gpm1 + idx), s4 = *(const f32x4*)(sh + idx), c4 = *(const f32x4*)(sc + idx);
                *(f32x4*)(H1 + (size_t)row * D + idx) = v[j] * rstd * gg * (c4 + 1.0f) + s4; }
        }
    }
}

__device__ __forceinline__ void ph_shiftmix(const Ctx& c) {
    const Args& a = *c.a; const float* H1 = (const float*)(c.ws + WS_H1); bf16* XS = (bf16*)(c.ws + WS_XS); const float* mix = a.in[I_MIX];
    const int lane = c.lane;
    for (int row = c.gw; row < NTOK; row += c.ngw) {
        const RowInfo ri = rowinfo(row);
#pragma unroll
        for (int j = 0; j < 8; ++j) { const int idx = j * 256 + lane * 4;
            const f32x4 h = *(const f32x4*)(H1 + (size_t)row * D + idx);
            f32x4 pv = (f32x4){0.f, 0.f, 0.f, 0.f}, nx = pv;
            if (ri.t > 0) pv = *(const f32x4*)(H1 + (size_t)(row - 1) * D + idx);
            if (ri.t < ri.n - 1) nx = *(const f32x4*)(H1 + (size_t)(row + 1) * D + idx);
            const f32x4 xx = (pv + nx) * 0.5f - h;
#pragma unroll
            for (int s = 0; s < 6; ++s) { const f32x4 mm = *(const f32x4*)(mix + s * D + idx); const f32x4 o = h + xx * mm;
                u32x2 w; w.x = pk2(o.x, o.y); w.y = pk2(o.z, o.w); *(u32x2*)(XS + ((size_t)s * NTOK + row) * D + idx) = w; } }
    }
}

__device__ __forceinline__ void ph_rw_gemm1(const Ctx& c) {
    const Args& a = *c.a; const bf16* XS = (const bf16*)(c.ws + WS_XS);
    const bf16 *XR = XS, *XW = XS + (size_t)1 * NTOK * D, *XK = XS + (size_t)2 * NTOK * D, *XV = XS + (size_t)3 * NTOK * D, *XA = XS + (size_t)4 * NTOK * D, *XG = XS + (size_t)5 * NTOK * D;
    { GemmS g{XR, D, nullptr, NLAT, a.in[I_WR], D, D, D}; EpiStoreF32 e{(float*)(c.ws + WS_R), D}; sgemm_all(c, g, e, c.bid, c.G); }
    { GemmS g{XK, D, nullptr, NTOK, a.in[I_WK], D, D, D}; EpiStoreF32 e{(float*)(c.ws + WS_KK), D}; sgemm_all(c, g, e, c.bid, c.G); }
    { GemmS g{XV, D, nullptr, NTOK, a.in[I_WV], D, D, D}; EpiStoreF32 e{(float*)(c.ws + WS_VV), D}; sgemm_all(c, g, e, c.bid, c.G); }
    for (int d = 0; d < 2; ++d) {
        { GemmS g{XW, D, nullptr, NTOK, a.in[I_W1] + (size_t)d * D * LORA, LORA, LORA, D}; EpiTanhBf16 e{(bf16*)(c.ws + WS_LW) + d * 128, 256}; sgemm_all(c, g, e, c.bid, c.G); }
        { GemmS g{XA, D, nullptr, NTOK, a.in[I_A1] + (size_t)d * D * LORA, LORA, LORA, D}; EpiStoreBf16 e{(bf16*)(c.ws + WS_LA) + d * 128, 256}; sgemm_all(c, g, e, c.bid, c.G); }
    }
    { GemmS g{XG, D, nullptr, NLAT, a.in[I_G1], GLORA, GLORA, D}; EpiSigBf16 e{(bf16*)(c.ws + WS_LG), 256}; sgemm_all(c, g, e, c.bid, c.G); }
}
__device__ __forceinline__ void ph_rw_gemm2(const Ctx& c) {
    const Args& a = *c.a;
    for (int d = 0; d < 2; ++d) {
        { GemmS g{(const bf16*)(c.ws + WS_LW) + d * 128, 256, nullptr, NTOK, a.in[I_W2] + (size_t)d * LORA * D, D, D, LORA}; EpiDecay e{(float*)(c.ws + WS_DEC) + (size_t)d * NTOK * D, a.in[I_W0] + d * D}; sgemm_all(c, g, e, c.bid, c.G); }
        { GemmS g{(const bf16*)(c.ws + WS_LA) + d * 128, 256, nullptr, NTOK, a.in[I_A2] + (size_t)d * LORA * D, D, D, LORA}; EpiSigBias e{(float*)(c.ws + WS_AS) + (size_t)d * NTOK * D, a.in[I_A0] + d * D}; sgemm_all(c, g, e, c.bid, c.G); }
    }
    { GemmS g{(const bf16*)(c.ws + WS_LG), 256, nullptr, NLAT, a.in[I_G2], D, D, GLORA}; EpiStoreF32 e{(float*)(c.ws + WS_G), D}; sgemm_all(c, g, e, c.bid, c.G); }
}

__device__ __forceinline__ void ph_scan(const Ctx& c) {
    const Args& a = *c.a;
    const float* R = (const float*)(c.ws + WS_R); const float* K = (const float*)(c.ws + WS_KK); const float* V = (const float*)(c.ws + WS_VV);
    const float* DEC = (const float*)(c.ws + WS_DEC); const float* AS = (const float*)(c.ws + WS_AS); float* YS = (float*)(c.ws + WS_YS);
    const int lane = c.lane;
    for (int ch = c.gw; ch < 2 * NB * RH; ch += c.ngw) {
        const int dir = ch / (NB * RH), b = (ch / RH) % NB, h = ch % RH, col = h * RN + lane;
        const float kkc = a.in[I_KK][col], kac = a.in[I_KA][col];
        const float* dec = DEC + (size_t)dir * NTOK * D; const float* asp = AS + (size_t)dir * NTOK * D;
        float S[RN];
#pragma unroll
        for (int j = 0; j < RN; ++j) S[j] = 0.f;
        const int total = CTXL + SEQ;
#define ROWOF(s) ((s) < CTXL ? (NLAT + b * CTXL + (dir ? (CTXL - 1 - (s)) : (s))) : (b * SEQ + (dir ? (SEQ - 1 - ((s) - CTXL)) : ((s) - CTXL))))
        int row = ROWOF(0);
        float nw = dec[(size_t)row * D + col], nk = K[(size_t)row * D + col], nv = V[(size_t)row * D + col], na = asp[(size_t)row * D + col], nr = (row < NLAT) ? R[(size_t)row * D + col] : 0.f;
        for (int s = 0; s < total; ++s) {
            const float w = nw, k = nk, v = nv, asg = na, r = nr; const int crow = row;
            if (s + 1 < total) { row = ROWOF(s + 1);
                nw = dec[(size_t)row * D + col]; nk = K[(size_t)row * D + col]; nv = V[(size_t)row * D + col]; na = asp[(size_t)row * D + col]; nr = (row < NLAT) ? R[(size_t)row * D + col] : 0.f; }
            const float kr = k * kkc; const float ssq = wsum(kr * kr);
            const float kk = kr * rsqrtf(fmaxf(ssq, 1e-24f));
            const float av = -kk, bv = kk * asg, kd = k * (1.0f + (asg - 1.0f) * kac);
            float sa = 0.f;
#pragma unroll
            for (int j = 0; j < RN; ++j) sa += S[j] * __builtin_bit_cast(float, __builtin_amdgcn_readlane(__builtin_bit_cast(int, av), j));
            float y = 0.f;
#pragma unroll
            for (int j = 0; j < RN; ++j) {
                const float wj = __builtin_bit_cast(float, __builtin_amdgcn_readlane(__builtin_bit_cast(int, w), j));
                const float bj = __builtin_bit_cast(float, __builtin_amdgcn_readlane(__builtin_bit_cast(int, bv), j));
                const float kj = __builtin_bit_cast(float, __builtin_amdgcn_readlane(__builtin_bit_cast(int, kd), j));
                const float rj = __builtin_bit_cast(float, __builtin_amdgcn_readlane(__builtin_bit_cast(int, r), j));
                S[j] = S[j] * wj + sa * bj + v * kj;
                y += S[j] * rj;
            }
            if (crow < NLAT) YS[((size_t)dir * NLAT + crow) * D + col] = y;
        }
    }
}

__device__ __forceinline__ void ph_readout(const Ctx& c) {
    const Args& a = *c.a;
    const float* R = (const float*)(c.ws + WS_R); const float* K = (const float*)(c.ws + WS_KK); const float* V = (const float*)(c.ws + WS_VV);
    const float* AS = (const float*)(c.ws + WS_AS); const float* YS = (const float*)(c.ws + WS_YS); const float* G = (const float*)(c.ws + WS_G); bf16* O = (bf16*)(c.ws + WS_O);
    const int lane = c.lane;
    for (int it = c.gw; it < NLAT * RH; it += c.ngw) {
        const int row = it / RH, h = it % RH, col = h * RN + lane; const size_t o = (size_t)row * D + col;
        const float y = YS[o] + YS[(size_t)NLAT * D + o];
        const float mu = wsum(y) * (1.0f / RN); const float dlt = y - mu; const float var = wsum(dlt * dlt) * (1.0f / RN);
        const float yn = dlt * rsqrtf(var + 64e-5f) * a.in[I_LNW][col] + a.in[I_LNB][col];
        const float r = R[o], k = K[o], v = V[o], a0 = AS[o], a1 = AS[(size_t)NTOK * D + o], ka = a.in[I_KA][col];
        const float rk = r * a.in[I_RK][col];
        const float kd0 = k * (1.0f + (a0 - 1.0f) * ka), kd1 = k * (1.0f + (a1 - 1.0f) * ka);
        const float bonus = wsum(rk * kd0 + rk * kd1) * v;
        O[o] = (bf16)f2bf((yn + bonus) * G[o]);
    }
}

template <int CLO, int CHI>
__device__ __forceinline__ void body(const Args& args) {
    extern __shared__ __attribute__((aligned(16))) unsigned char lds_raw[];
    Ctx c; c.a = &args; c.ws = args.ws; c.lds = (LAS unsigned char*)lds_raw;
    c.tid = threadIdx.x; c.lane = c.tid & 63; c.wave = __builtin_amdgcn_readfirstlane(c.tid >> 6); c.bid = blockIdx.x; c.G = gridDim.x;
    c.gw = c.bid * 8 + c.wave; c.ngw = c.G * 8;
    volatile LAS unsigned* misc = (volatile LAS unsigned*)(c.lds + LDS_BYTES - 64);
    if (c.tid < 16) misc[c.tid] = 0u;
    __syncthreads();
    const int lo = args.ph_lo, hi = args.ph_hi;
    XcdBarrier bar; bar.bar = (unsigned*)(c.ws + WS_CTL) + CW_BAR; bar.x = 0; bar.st = misc;
    if (CHI - CLO > 1) bar = xcd_barrier_post((unsigned*)(c.ws + WS_CTL) + CW_BAR, misc);
#define IN(k) ((k) >= CLO && (k) < CHI && lo <= (k) && (k) < hi)
#define SEAM(k) do { if (IN(k) && IN((k) + 1)) xcd_barrier(bar); } while (0)
    const Args& a = args;
    if (IN(0)) { ph_mod(c); } SEAM(0);
    if (IN(1)) { ph_prenorm0(c); } SEAM(1);
    if (IN(2)) { GemmS g{(const bf16*)(c.ws + WS_H), D, nullptr, NTOK, a.in[I_WIN], AB_IN, AB_IN, D}; EpiStoreBf16 e{(bf16*)(c.ws + WS_U), AB_IN}; sgemm_all(c, g, e, c.bid, c.G); } SEAM(2);
    if (IN(3)) { ph_prep0(c); } SEAM(3);
    if (IN(4)) { ph_attn_pool(c); } SEAM(4);
    if (IN(5)) { GemmS g{(const bf16*)(c.ws + WS_CAT), D, nullptr, NTOK, a.in[I_WOUT], D, D, D}; EpiStoreF32 e{(float*)(c.ws + WS_Y), D}; sgemm_all(c, g, e, c.bid, c.G); } SEAM(5);
    if (IN(6)) { ph_rowA(c, 0); } SEAM(6);
    if (IN(7)) { ph_moe_gu(c, 0, 0); } SEAM(7);
    if (IN(8)) { ph_moe_gu(c, 0, 1); } SEAM(8);
    if (IN(9)) { ph_moe_down(c, 0); } SEAM(9);
    if (IN(10)) { ph_rowB(c, 0); } SEAM(10);
    if (IN(11)) { ph_shiftmix(c); } SEAM(11);
    if (IN(12)) { ph_rw_gemm1(c); } SEAM(12);
    if (IN(13)) { ph_rw_gemm2(c); } SEAM(13);
    if (IN(14)) { ph_scan(c); } SEAM(14);
    if (IN(15)) { ph_readout(c); } SEAM(15);
    if (IN(16)) { GemmS g{(const bf16*)(c.ws + WS_O), D, nullptr, NLAT, a.in[I_WO], D, D, D}; EpiStoreF32 e{(float*)(c.ws + WS_Y), D}; sgemm_all(c, g, e, c.bid, c.G); } SEAM(16);
    if (IN(17)) { ph_rowA(c, 1); } SEAM(17);
    if (IN(18)) { ph_moe_gu(c, 1, 0); } SEAM(18);
    if (IN(19)) { ph_moe_gu(c, 1, 1); } SEAM(19);
    if (IN(20)) { ph_moe_down(c, 1); } SEAM(20);
    if (IN(21)) { ph_rowB(c, 1); }
#undef IN
#undef SEAM
}
constexpr int NPH = 22;
template <int PH> __global__ void __launch_bounds__(512, 2) fwd_one(Args args) { body<PH, PH + 1>(args); }
template <int PH> struct Launcher { static void go(int grid, hipStream_t stream, Args a) {
    a.ph_lo = PH; a.ph_hi = PH + 1;
    static bool attr = false; if (!attr) { (void)hipFuncSetAttribute((const void*)fwd_one<PH>, hipFuncAttributeMaxDynamicSharedMemorySize, LDS_BYTES); attr = true; }
    hipLaunchKernelGGL(fwd_one<PH>, dim3(grid), dim3(512), LDS_BYTES, stream, a);
    Launcher<PH + 1>::go(grid, stream, a); } };
template <> struct Launcher<NPH> { static void go(int, hipStream_t, Args) {} };
}

extern "C" void kernel_launch(void* const* d_in, const int* in_sizes, int n_in, void* d_out, int out_size, void* d_ws, size_t ws_size, hipStream_t stream) {
    static int grid = 0;
    if (grid == 0) {
        if (n_in != 39 || out_size != NLAT * D || ws_size < WS_END) { fprintf(stderr, "kernel_launch: unexpected shapes: n_in %d out %d ws %zu (need %zu)\n", n_in, out_size, ws_size, (size_t)WS_END); grid = -1; return; }
        int dev = 0, cus = 0;
        if (hipGetDevice(&dev) != hipSuccess || hipDeviceGetAttribute(&cus, hipDeviceAttributeMultiprocessorCount, dev) != hipSuccess) { grid = -1; return; }
        grid = cus;
    }
    if (grid < 0) return;
    (void)hipMemsetAsync((char*)d_ws + WS_CTL, 0, CTL_BYTES, stream);
    Args a{};
    for (int i = 0; i < 39; ++i) a.in[i] = (const float*)d_in[i];
    a.out = (float*)d_out; a.ws = (unsigned char*)d_ws;
    Launcher<0>::go(grid, stream, a);
}
```

```cpp
#include <hip/hip_runtime.h>
#include <cstdio>
#include <cstdint>

#ifndef DBG_HI
#define DBG_HI NPH
#endif
#ifndef MOE_FP8
#define MOE_FP8 1
#endif
#ifndef DBG_SCANPROBE
#define DBG_SCANPROBE 0
#endif
#ifndef DBG_DUP
#define DBG_DUP 0
#endif
#define DUPQ(k) ((DBG_DUP >> (k)) & 1)
#ifndef DBG_REP0
#define DBG_REP0 1
#endif
#ifndef DBG_SMALL
#define DBG_SMALL 13568
#endif
#ifndef DBG_W2
#define DBG_W2 0
#endif
#ifndef DBG_MOE
#define DBG_MOE 0
#endif
#ifndef FAST_RKV
#define FAST_RKV 0
#endif
namespace {
constexpr int D = 2048, NB = 2, SEQ = 4096, CTXL = 256;
constexpr int NLAT = NB * SEQ, NCTX = NB * CTXL, NTOK = NLAT + NCTX;
constexpr int KVLEN = SEQ + CTXL;
constexpr int NHEAD = 8, NKVH = 2, HD = 128, ATTN_W = 1024, KV_W = 256, POOL_W = 1024, AB_IN = 2560;
constexpr int NEXP = 32, TOPK = 4, DEXP = 1024;
constexpr int RH = 32, RN = 64;
constexpr int LORA = 96, GLORA = 256;
constexpr int NSLOT = NTOK * TOPK + NEXP * 256;
constexpr int LISTCAP = NTOK;
constexpr int NPHASE = 21;

constexpr size_t al256(size_t x) { return (x + 255) / 256 * 256; }
constexpr size_t WS_CTL = 0, CTL_BYTES = 1u << 20;
constexpr int CW_BAR = 4096;
constexpr int CW_CNT = 16384;
constexpr size_t WS_MOD = CTL_BYTES;
constexpr size_t WS_ROPE = WS_MOD + al256((size_t)2 * 3 * 6 * D * 4);
constexpr size_t WS_SELE = WS_ROPE + al256(2 * 64 * 32 * 4);
constexpr size_t WS_SELP = WS_SELE + al256((size_t)NTOK * 4 * 4);
constexpr size_t WS_LIST = WS_SELP + al256((size_t)NTOK * 4 * 4);
constexpr size_t WS_LISTG = WS_LIST + al256((size_t)NEXP * LISTCAP * 4);
constexpr size_t WS_X = WS_LISTG + al256((size_t)NEXP * LISTCAP * 4);
constexpr size_t WS_Y = WS_X + (size_t)NTOK * D * 4;
constexpr size_t WS_F = WS_Y + (size_t)NTOK * D * 4;
constexpr size_t WS_ACT = WS_F + (size_t)NTOK * D * 2;
constexpr size_t WS_YE = WS_ACT + (size_t)NSLOT * DEXP * 2;
constexpr size_t WB_WIN = WS_YE + (size_t)NSLOT * D * 2;
constexpr size_t WB_WOUT = WB_WIN + (size_t)AB_IN * D * 2;
constexpr size_t WB_WR = WB_WOUT + (size_t)D * D * 2;
constexpr size_t WB_WK = WB_WR + (size_t)D * D * 2;
constexpr size_t WB_WV = WB_WK + (size_t)D * D * 2;
constexpr size_t WB_WO = WB_WV + (size_t)D * D * 2;
constexpr size_t WB_POOL = WB_WO + (size_t)D * D * 2;
constexpr size_t WB_W1 = WB_POOL + (size_t)4 * 256 * 256 * 2;
constexpr size_t WB_A1 = WB_W1 + (size_t)256 * D * 2;
constexpr size_t WB_G1 = WB_A1 + (size_t)256 * D * 2;
constexpr size_t WB_W2 = WB_G1 + (size_t)256 * D * 2;
constexpr size_t WB_A2 = WB_W2 + (size_t)2 * D * 256 * 2;
constexpr size_t WB_G2 = WB_A2 + (size_t)2 * D * 256 * 2;
constexpr size_t WB_GU = WB_G2 + (size_t)D * 256 * 2;
constexpr size_t WB_DN = WB_GU + (size_t)2 * NEXP * 2 * DEXP * D * 2;
constexpr size_t WS_L = WB_DN + (size_t)2 * NEXP * D * DEXP * 2;
constexpr size_t WS_H = WS_L;
constexpr size_t WS_U = WS_H + (size_t)NTOK * D * 2;
constexpr size_t WS_Q = WS_U + (size_t)NTOK * AB_IN * 2;
constexpr size_t WS_K = WS_Q + (size_t)NTOK * ATTN_W * 2;
constexpr size_t WS_V = WS_K + (size_t)NB * KVLEN * KV_W * 2;
constexpr size_t WS_MP = WS_V + (size_t)NB * KVLEN * KV_W * 2;
constexpr size_t WS_CAT = WS_MP + (size_t)NTOK * POOL_W * 2;
constexpr size_t WS_L0END = WS_CAT + (size_t)NTOK * D * 2;
constexpr size_t WS_XS = WS_L;
constexpr size_t WS_DEC = WS_L;
constexpr size_t WS_AS = WS_DEC + (size_t)2 * NTOK * D * 4;
constexpr size_t WS_H1 = WS_AS + (size_t)2 * NTOK * D * 4;
constexpr size_t WS_G = WS_H1;
constexpr size_t WS_R = WS_H1 + (size_t)NTOK * D * 4;
constexpr size_t WS_KK = WS_R + (size_t)NTOK * D * 4;
constexpr size_t WS_VV = WS_KK + (size_t)NTOK * D * 4;
constexpr size_t WS_LW = WS_VV + (size_t)NTOK * D * 4;
constexpr size_t WS_LA = WS_LW + (size_t)NTOK * 256 * 2;
constexpr size_t WS_LG = WS_LA + (size_t)NTOK * 256 * 2;
constexpr size_t WS_YS = WS_LG + (size_t)NTOK * 256 * 2;
constexpr size_t WS_O = WS_YS + (size_t)2 * NLAT * D * 4;
constexpr size_t WS_L1END = WS_O + (size_t)NLAT * D * 2;
constexpr size_t WS_END2 = WS_L1END > WS_L0END ? WS_L1END : WS_L0END;
static_assert((size_t)6 * NTOK * D * 2 <= (size_t)4 * NTOK * D * 4, "XS fits under DEC|AS");
constexpr size_t WB_RT = al256(WS_END2);
constexpr size_t WS_END3 = WB_RT + (size_t)2 * 2 * NEXP * D * 2;
static_assert(WS_END3 <= 2147483648ull, "workspace fits the guaranteed 2 GiB and 32-bit offsets");

constexpr bool MOE8 = (MOE_FP8 != 0);
constexpr float MOE8_SW1 = 64.f, MOE8_SW2 = 32.f, MOE8_SACT = 4.f;
constexpr int LDS_BYTES = 147456;

typedef unsigned short bf16;
typedef float f32x4 __attribute__((ext_vector_type(4)));
typedef unsigned u32x2 __attribute__((ext_vector_type(2)));
typedef unsigned u32x4 __attribute__((ext_vector_type(4)));
#define LAS __attribute__((address_space(3)))
#define GAS __attribute__((address_space(1)))

__device__ __forceinline__ float bf2f(unsigned v) { return __uint_as_float(v << 16); }
__device__ __forceinline__ unsigned f2bf(float f) { unsigned u = __float_as_uint(f); return (u + 0x7fffu + ((u >> 16) & 1u)) >> 16; }
__device__ __forceinline__ unsigned pk2(float lo, float hi) { return f2bf(lo) | (f2bf(hi) << 16); }
__device__ __forceinline__ unsigned pk4_fp8(float a, float b, float cc, float d) {
    int w = __builtin_amdgcn_cvt_pk_fp8_f32(a, b, 0, false); w = __builtin_amdgcn_cvt_pk_fp8_f32(cc, d, w, true); return (unsigned)w; }
__device__ __forceinline__ int lane_now() { int t = threadIdx.x; asm volatile("" : "+v"(t)); return t & 63; }
__device__ __forceinline__ float shx(float v, int mask) { return __builtin_bit_cast(float, __builtin_amdgcn_ds_bpermute((lane_now() ^ mask) << 2, __builtin_bit_cast(int, v))); }
__device__ __forceinline__ int shi(int v, int src) { return __builtin_amdgcn_ds_bpermute(src << 2, v); }
typedef float f32x2 __attribute__((ext_vector_type(2)));
__device__ __forceinline__ float dpp_add(float v, float u) { return v + u; }
template <int CTRL> __device__ __forceinline__ float dpp_mov(float v) { return __builtin_bit_cast(float, __builtin_amdgcn_update_dpp(0, __builtin_bit_cast(int, v), CTRL, 0xF, 0xF, true)); }
__device__ __forceinline__ float sum8(float v) { v += dpp_mov<0xB1>(v); v += dpp_mov<0x4E>(v); v += dpp_mov<0x141>(v); return v; }
__device__ __forceinline__ float sum16(float v) { v = sum8(v); v += dpp_mov<0x140>(v); return v; }
__device__ __forceinline__ float rl_f(float v, int l) { return __builtin_bit_cast(float, __builtin_amdgcn_readlane(__builtin_bit_cast(int, v), l)); }
__device__ __forceinline__ float wsum(float v) { v = sum16(v); return (rl_f(v, 0) + rl_f(v, 16)) + (rl_f(v, 32) + rl_f(v, 48)); }
__device__ __forceinline__ float wmax(float v) {
    v = fmaxf(v, dpp_mov<0xB1>(v)); v = fmaxf(v, dpp_mov<0x4E>(v)); v = fmaxf(v, dpp_mov<0x141>(v)); v = fmaxf(v, dpp_mov<0x140>(v));
    return fmaxf(fmaxf(rl_f(v, 0), rl_f(v, 16)), fmaxf(rl_f(v, 32), rl_f(v, 48))); }
__device__ __forceinline__ float sigmoidf_(float x) { return __builtin_amdgcn_rcpf(1.0f + __expf(-x)); }

#define XB_TMO      128
#define XB_XCNT(j)  (256  + 64 * (j))
#define XB_XSUB(j)  (1280 + 64 * (j))
#define XB_XGEN(j)  (2304 + 64 * (j))
#define XB_TOP      3328
#define XB_TOPGEN   3392
#define XCD_BAR_WORDS 3456
#define XB_SPIN_CAP (1u << 18)
__device__ __forceinline__ unsigned xb_ld(unsigned* p)              { return __hip_atomic_load(p, __ATOMIC_RELAXED, __HIP_MEMORY_SCOPE_AGENT); }
__device__ __forceinline__ unsigned xb_add(unsigned* p, unsigned v) { return __hip_atomic_fetch_add(p, v, __ATOMIC_RELAXED, __HIP_MEMORY_SCOPE_AGENT); }
__device__ __forceinline__ unsigned xb_xcc_id() { return (unsigned)__builtin_amdgcn_s_getreg((3 << 11) | 20) & 0xFu; }
#define XB_SPIN(cond, bar) do { unsigned _sp = 0; while (cond) { __builtin_amdgcn_s_sleep(1); \
    if ((++_sp & 255u) == 0u) { if (xb_ld(&(bar)[XB_TMO])) break; if (_sp > XB_SPIN_CAP) { atomicAdd(&(bar)[XB_TMO], 1u); break; } } } } while (0)
struct XcdBarrier { unsigned* bar; unsigned x; volatile LAS unsigned* st; };
__device__ __forceinline__ XcdBarrier xcd_barrier_post(unsigned* bar, volatile LAS unsigned* st) {
    XcdBarrier b; b.bar = bar; b.x = xb_xcc_id(); b.st = st;
    if (threadIdx.x == 0) (void)xb_add(&bar[XB_XCNT(b.x)], 1u);
    return b;
}
__device__ __forceinline__ void xcd_barrier_complete(unsigned* bar, unsigned x, unsigned& nloc, unsigned& nx) {
    const unsigned G = gridDim.x * gridDim.y * gridDim.z;
    unsigned sum, cnt, mine, sp = 0u;
    for (;;) {
        sum = 0u; cnt = 0u; mine = 0u;
#pragma unroll
        for (unsigned j = 0; j < 16; ++j) { const unsigned c = xb_ld(&bar[XB_XCNT(j)]); sum += c; cnt += (c > 0u) ? 1u : 0u; mine = (j == x) ? c : mine; }
        if (sum == G) break;
        __builtin_amdgcn_s_sleep(1);
        if ((++sp & 255u) == 0u) { if (xb_ld(&bar[XB_TMO])) break; if (sp > XB_SPIN_CAP) { atomicAdd(&bar[XB_TMO], 1u); break; } }
    }
    nloc = mine > 0u ? mine : 1u; nx = cnt > 0u ? cnt : 1u;
}
__device__ __forceinline__ void xcd_barrier(const XcdBarrier& b) {
    asm volatile("s_waitcnt vmcnt(0)" ::: "memory");
    __syncthreads();
    if (threadIdx.x == 0) {
        unsigned* bar = b.bar; asm volatile("" : "+s"(bar));
        __builtin_amdgcn_s_waitcnt(0);
        unsigned nloc = b.st[0], nx = b.st[1];
        if (nloc == 0u) { xcd_barrier_complete(bar, b.x, nloc, nx); b.st[0] = nloc; b.st[1] = nx; }
        const unsigned old = xb_add(&bar[XB_XSUB(b.x)], 1u);
        const unsigned gen = old / nloc;
        if (old + 1u == (gen + 1u) * nloc) {
            __builtin_amdgcn_fence(__ATOMIC_RELEASE, "agent");
            asm volatile("s_waitcnt vmcnt(0)" ::: "memory");
            const unsigned og = xb_add(&bar[XB_TOP], 1u);
            const unsigned tg = og / nx;
            if (og + 1u == (tg + 1u) * nx) xb_add(&bar[XB_TOPGEN], 1u);
            else XB_SPIN(xb_ld(&bar[XB_TOPGEN]) == tg, bar);
            __builtin_amdgcn_fence(__ATOMIC_ACQUIRE, "agent");
            xb_add(&bar[XB_XGEN(b.x)], 1u);
            asm volatile("s_waitcnt vmcnt(0)" ::: "memory");
        } else {
            XB_SPIN(xb_ld(&bar[XB_XGEN(b.x)]) == gen, bar);
            __builtin_amdgcn_fence(__ATOMIC_ACQUIRE, "agent");
            asm volatile("s_waitcnt vmcnt(0)" ::: "memory");
        }
    }
    __syncthreads();
}

struct Args { const float* in[39]; float* out; unsigned char* ws; int ph_lo, ph_hi; };
enum { I_X = 0, I_C, I_CTX, I_CCTX, I_WMOD, I_BMOD, I_NORMG, I_WIN, I_QGAIN, I_KGAIN, I_POOLW, I_POOLS, I_WOUT, I_MIX, I_WR, I_WK, I_WV, I_WO,
       I_W0, I_W1, I_W2, I_A0, I_A1, I_A2, I_G1, I_G2, I_KK, I_KA, I_RK, I_LNW, I_LNB, I_ROUTW, I_ROUTB, I_WGATE, I_BGATE, I_WUP, I_BUP, I_WDOWN, I_BDOWN };

struct Ctx {
    float* out; unsigned char* ws; LAS unsigned char* lds; int tid, lane, wave, gw, ngw, bid, G;
};
#if defined(__HIP_DEVICE_COMPILE__)
#define ASSUME_GLOBAL(p) do { __builtin_assume(!__builtin_amdgcn_is_shared((const void*)(p))); __builtin_assume(!__builtin_amdgcn_is_private((const void*)(p))); } while (0)
#else
#define ASSUME_GLOBAL(p) do { } while (0)
#endif
constexpr int PTAB_OFF = LDS_BYTES - 1024;
__device__ __forceinline__ const float* inp(const Ctx& c, int i) {
    const LAS unsigned* t = (const LAS unsigned*)(c.lds + PTAB_OFF) + 2 * i;
    const unsigned lo = __builtin_amdgcn_readfirstlane(t[0]), hi = __builtin_amdgcn_readfirstlane(t[1]);
    return (const float*)(const GAS float*)(((unsigned long long)hi << 32) | lo);
}
__device__ __forceinline__ const float* modp(const Ctx& c, int layer, int who, int part) { return (const float*)(c.ws + WS_MOD) + ((size_t)(layer * 3 + who) * 6 + part) * D; }
struct RowInfo { int b, t, n, who, seq0; };
__device__ __forceinline__ RowInfo rowinfo(int row) {
    RowInfo r;
    if (row < NLAT) { r.b = row / SEQ; r.t = row % SEQ; r.n = SEQ; r.who = r.b; r.seq0 = r.b * SEQ; }
    else { const int rc = row - NLAT; r.b = rc / CTXL; r.t = rc % CTXL; r.n = CTXL; r.who = 2; r.seq0 = NLAT + r.b * CTXL; }
    return r;
}

struct GemmS { const bf16* A; int lda; const int* gather; int M; const float* B; int ldb; int N; int K; };
template <class Epi>
__device__ __forceinline__ void sgemm_unit(const Ctx& c, const GemmS& g, int m0, int n0, const Epi& epi) {
    LAS float* As = (LAS float*)c.lds;
    LAS float* Bs = As + 16 * 132;
    const int tid = c.tid, ty = tid >> 5, tx = tid & 31;
    float acc[8][4];
#pragma unroll
    for (int i = 0; i < 8; ++i)
#pragma unroll
        for (int j = 0; j < 4; ++j) acc[i][j] = 0.f;
    const int ar = tid >> 2, akq = (tid & 3) * 4;
    const int arow_l = m0 + ar;
    long arow = -1;
    if (arow_l < g.M) arow = g.gather ? (long)g.gather[arow_l] : (long)arow_l;
    const int bk = tid >> 5, bn = (tid & 31) * 4;
    const bool bok = (n0 + bn) < g.N;
    for (int k0 = 0; k0 < g.K; k0 += 16) {
        u32x2 av = (u32x2){0u, 0u};
        if (arow >= 0) av = *(const u32x2*)(g.A + arow * g.lda + k0 + akq);
        f32x4 bv = (f32x4){0.f, 0.f, 0.f, 0.f};
        if (bok) bv = *(const f32x4*)(g.B + (size_t)(k0 + bk) * g.ldb + n0 + bn);
        __syncthreads();
        As[(akq + 0) * 132 + ar] = bf2f(av.x & 0xffffu); As[(akq + 1) * 132 + ar] = bf2f(av.x >> 16);
        As[(akq + 2) * 132 + ar] = bf2f(av.y & 0xffffu); As[(akq + 3) * 132 + ar] = bf2f(av.y >> 16);
        *(LAS f32x4*)(Bs + bk * 128 + bn) = bv;
        __syncthreads();
#pragma unroll
        for (int k = 0; k < 16; ++k) {
            const f32x4 a0 = *(const LAS f32x4*)(As + k * 132 + ty * 8), a1 = *(const LAS f32x4*)(As + k * 132 + ty * 8 + 4);
            const f32x4 b = *(const LAS f32x4*)(Bs + k * 128 + tx * 4);
            const float a[8] = {a0.x, a0.y, a0.z, a0.w, a1.x, a1.y, a1.z, a1.w};
#pragma unroll
            for (int i = 0; i < 8; ++i) { acc[i][0] += a[i] * b.x; acc[i][1] += a[i] * b.y; acc[i][2] += a[i] * b.z; acc[i][3] += a[i] * b.w; }
        }
    }
#pragma unroll
    for (int i = 0; i < 8; ++i) {
        const int r = m0 + ty * 8 + i;
        if (r < g.M) {
#pragma unroll
            for (int j = 0; j < 4; ++j) { const int cc = n0 + tx * 4 + j; if (cc < g.N) epi(r, cc, acc[i][j]); }
        }
    }
}
template <class Epi>
__device__ __forceinline__ void sgemm_all(const Ctx& c, const GemmS& g, const Epi& epi, int u0, int ustride) {
    const int nM = (g.M + 127) / 128, nN = (g.N + 127) / 128;
    for (int u = u0; u < nM * nN; u += ustride) sgemm_unit(c, g, (u / nN) * 128, (u % nN) * 128, epi);
}

struct EpiStoreBf16 { bf16* C; int ldc; __device__ __forceinline__ void operator()(int r, int cc, float v) const { C[(size_t)r * ldc + cc] = (bf16)f2bf(v); } };
struct EpiStoreF32 { float* C; int ldc; __device__ __forceinline__ void operator()(int r, int cc, float v) const { C[(size_t)r * ldc + cc] = v; } };
struct EpiPool { bf16* C; const float* scale; __device__ __forceinline__ void operator()(int r, int cc, float v) const { C[(size_t)r * D + cc] = (bf16)f2bf(v * scale[cc]); } };
struct EpiTanhBf16 { bf16* C; int ldc; __device__ __forceinline__ void operator()(int r, int cc, float v) const { C[(size_t)r * ldc + cc] = (bf16)f2bf(tanhf(v)); } };
struct EpiSigBf16 { bf16* C; int ldc; __device__ __forceinline__ void operator()(int r, int cc, float v) const { C[(size_t)r * ldc + cc] = (bf16)f2bf(sigmoidf_(v)); } };
struct EpiDecay { float* C; const float* w0; __device__ __forceinline__ void operator()(int r, int cc, float v) const {
    const float z = -(w0[cc] + v);
    const float sp = (z > 20.f) ? z : log1pf(__expf(z));
    C[(size_t)r * D + cc] = __expf(-__expf(-sp - 0.5f)); } };
struct EpiSigBias { float* C; const float* a0; __device__ __forceinline__ void operator()(int r, int cc, float v) const { C[(size_t)r * D + cc] = sigmoidf_(a0[cc] + v); } };
struct EpiGateTmp { float* GT; const float* bias; int slot0; __device__ __forceinline__ void operator()(int r, int cc, float v) const { GT[(size_t)(slot0 + r) * DEXP + cc] = v + bias[cc]; } };
struct EpiUpAct { const float* GT; bf16* ACT; const float* bias; int slot0; __device__ __forceinline__ void operator()(int r, int cc, float v) const {
    const float glu = fminf(GT[(size_t)(slot0 + r) * DEXP + cc], 7.0f);
    const float lin = fminf(fmaxf(v + bias[cc], -7.0f), 7.0f);
    ACT[(size_t)(slot0 + r) * DEXP + cc] = (bf16)f2bf(glu * sigmoidf_(1.702f * glu) * (lin + 1.0f)); } };
struct EpiDown { bf16* YE; const float* bias; const float* gate; int slot0; __device__ __forceinline__ void operator()(int r, int cc, float v) const {
    YE[(size_t)(slot0 + r) * D + cc] = (bf16)f2bf((v + bias[cc]) * gate[r]); } };


namespace pg8 {
#define PG8_LAS __attribute__((address_space(3)))
typedef short bf16x8 __attribute__((ext_vector_type(8)));
constexpr int BM = 256, BK = 64, HALF = 128, HTB = HALF * BK * 2, STAGE_BYTES = 8 * HTB, NXCD = 8, WGM = 8;
__host__ __device__ __forceinline__ int lds_byte(int r, int c) { const int st = (r >> 4) * 2 + (c >> 5), rr = r & 15, cc = c & 31, ob = rr * 64 + cc * 2; return st * 1024 + (ob ^ (((ob >> 9) & 1) << 5)); }
__host__ __device__ __forceinline__ void stage_rc(int b, int& R, int& C) { const int st = b / 1024, sb = b % 1024, swz = sb ^ (((sb >> 9) & 1) << 5); R = (st >> 1) * 16 + swz / 64; C = (st & 1) * 32 + (swz % 64) / 2; }
__host__ __device__ __forceinline__ int perm32(int rho) { const int n = rho >> 4, i = rho & 15; return 8 * (i >> 2) + 4 * n + (i & 3); }
__device__ __forceinline__ unsigned cvt_pk_bf16(float lo, float hi) { unsigned r; asm volatile("v_cvt_pk_bf16_f32 %0, %1, %2" : "=v"(r) : "v"(lo), "v"(hi)); return r; }

struct UnitD {
    unsigned A;
    unsigned B;
    unsigned gather;
    int lda2, ldb2;
    int nt;
    int row0, col0;
    int nvalid;
    int aux, aux2;
};
__device__ __forceinline__ bool static_tile(int nM, int nN, int G, int c, int i, int& pm, int& pn) {
    const int nwg = nM * nN; const long L = (long)i * G + c; if (L >= nwg) return false;
    int wgid = (int)L; { const int q = nwg / NXCD, r = nwg % NXCD, xcd = wgid % NXCD, off = wgid / NXCD; wgid = (xcd < r ? xcd * (q + 1) : r * (q + 1) + (xcd - r) * q) + off; }
    const int nig = WGM * nN, gid = wgid / nig, fm = gid * WGM, gsz = (nM - fm) < WGM ? (nM - fm) : WGM;
    pm = fm + ((wgid % nig) % gsz); pn = (wgid % nig) / gsz; return true;
}
typedef int v8i32 __attribute__((ext_vector_type(8)));
template <bool F8, bool GATHER, class Epi, class Sched>
__device__ __forceinline__ void gemm_phase_t(PG8_LAS unsigned char* lds, const char* wsb, const Sched& S, const Epi& E) {
    int tid = threadIdx.x; asm volatile("" : "+v"(tid));
    const int wid = __builtin_amdgcn_readfirstlane(tid >> 6), lane = tid & 63, wr = wid >> 2, wc = wid & 3, fr = lane & 15, fq = lane >> 4;
#define PG8_RC(tv) int R0, C0, R1, C1; stage_rc((tv) * 16, R0, C0); stage_rc((tv) * 16 + 8192, R1, C1); const int Rb0 = (R0 & ~31) + perm32(R0 & 31), Rb1 = (R1 & ~31) + perm32(R1 & 31)
    const unsigned kstep = (unsigned)(BK * 2);
    const unsigned ldsw = (unsigned)wid * 1024u;
    const int aoff = F8 ? lds_byte(wr * 64 + fr, fq * 16) : lds_byte(wr * 64 + fr, fq * 8), boff = F8 ? lds_byte(wc * 32 + fr, fq * 16) : lds_byte(wc * 32 + fr, fq * 8);
#define PG8_SA(b, h) (((b) * 2 + (h)) * HTB)
#define PG8_SB(b, h) ((4 + (b) * 2 + (h)) * HTB)
#define PG8_STAGE(bufoff, gbase, v0, v1) do { \
        __builtin_amdgcn_global_load_lds((const unsigned*)(wsb + (size_t)(unsigned)((gbase) + (v0))), (PG8_LAS unsigned*)(lds + (bufoff) + ldsw), 16, 0, 0); \
        __builtin_amdgcn_global_load_lds((const unsigned*)(wsb + (size_t)(unsigned)((gbase) + (v1))), (PG8_LAS unsigned*)(lds + (bufoff) + ldsw + 8192), 16, 0, 0); } while (0)
#define PG8_LD8(addr_) ({ const u32x4 l_ = *(const PG8_LAS u32x4*)(addr_), h_ = *(const PG8_LAS u32x4*)((addr_) + 16); (v8i32){(int)l_.x, (int)l_.y, (int)l_.z, (int)l_.w, (int)h_.x, (int)h_.y, (int)h_.z, (int)h_.w}; })
#define PG8_LDA(dst, b, h) do { if constexpr (F8) { _Pragma("unroll") for (int m = 0; m < 4; ++m) dst##8[m] = PG8_LD8(lds + PG8_SA(b, h) + aoff + m * 2048); } \
        else { _Pragma("unroll") for (int m = 0; m < 4; ++m) _Pragma("unroll") for (int k = 0; k < 2; ++k) dst[m][k] = *(const PG8_LAS bf16x8*)(lds + PG8_SA(b, h) + aoff + m * 2048 + k * 1024); } } while (0)
#define PG8_LDB(dst, b, h) do { if constexpr (F8) { _Pragma("unroll") for (int n = 0; n < 2; ++n) dst##8[n] = PG8_LD8(lds + PG8_SB(b, h) + boff + n * 2048); } \
        else { _Pragma("unroll") for (int n = 0; n < 2; ++n) _Pragma("unroll") for (int k = 0; k < 2; ++k) dst[n][k] = *(const PG8_LAS bf16x8*)(lds + PG8_SB(b, h) + boff + n * 2048 + k * 1024); } } while (0)
#define PG8_MMA(ai, bj, At, Bt) do { __builtin_amdgcn_s_setprio(1); _Pragma("unroll") for (int m = 0; m < 4; ++m) _Pragma("unroll") for (int n = 0; n < 2; ++n) { \
        if constexpr (F8) { acc[ai][bj][m][n] = __builtin_amdgcn_mfma_scale_f32_16x16x128_f8f6f4(Bt##8[n], At##8[m], acc[ai][bj][m][n], 0, 0, 0, 0x7f7f7f7f, 0, 0x7f7f7f7f); } \
        else { _Pragma("unroll") for (int k = 0; k < 2; ++k) acc[ai][bj][m][n] = __builtin_amdgcn_mfma_f32_16x16x32_bf16(Bt[n][k], At[m][k], acc[ai][bj][m][n], 0, 0, 0); } } \
        __builtin_amdgcn_s_setprio(0); } while (0)
#define PG8_WAIT_V(n) asm volatile("s_waitcnt vmcnt(" #n ")" ::: "memory")
#define PG8_WAIT_L(n) asm volatile("s_waitcnt lgkmcnt(" #n ")" ::: "memory")
#define PG8_BAR __builtin_amdgcn_s_barrier()
#define PG8_SCHED __builtin_amdgcn_sched_barrier(0)
#define PG8_RFL(x) x = __builtin_amdgcn_readfirstlane(x)
#define PG8_OPAQUE(u) do { PG8_RFL((u).A); PG8_RFL((u).B); PG8_RFL((u).gather); PG8_RFL((u).lda2); PG8_RFL((u).ldb2); PG8_RFL((u).nt); PG8_RFL((u).row0); PG8_RFL((u).col0); PG8_RFL((u).nvalid); PG8_RFL((u).aux); PG8_RFL((u).aux2); \
        asm volatile("" : "+s"((u).A), "+s"((u).B), "+s"((u).gather), "+s"((u).lda2), "+s"((u).ldb2), "+s"((u).nt)); \
        asm volatile("" : "+s"((u).row0), "+s"((u).col0), "+s"((u).nvalid), "+s"((u).aux), "+s"((u).aux2)); } while (0)
#define PG8_SETV(u, vA00, vA01, vA10, vA11, vB0, vB1) do { \
        int r00 = R0, r01 = R1, r10 = R0 + HALF, r11 = R1 + HALF; \
        if (GATHER && (u).gather) { const int* gp_ = (const int*)(wsb + (u).gather); r00 = gp_[r00]; r01 = gp_[r01]; r10 = gp_[r10]; r11 = gp_[r11]; \
            r00 = (unsigned)r00 < (unsigned)NTOK ? r00 : 0; r01 = (unsigned)r01 < (unsigned)NTOK ? r01 : 0; r10 = (unsigned)r10 < (unsigned)NTOK ? r10 : 0; r11 = (unsigned)r11 < (unsigned)NTOK ? r11 : 0; } \
        vA00 = (unsigned)(r00 * (u).lda2 + C0 * 2); vA01 = (unsigned)(r01 * (u).lda2 + C1 * 2); vA10 = (unsigned)(r10 * (u).lda2 + C0 * 2); vA11 = (unsigned)(r11 * (u).lda2 + C1 * 2); \
        vB0 = (unsigned)(Rb0 * (u).ldb2 + C0 * 2); vB1 = (unsigned)(Rb1 * (u).ldb2 + C1 * 2); } while (0)
    UnitD cur, nxt; int ui = 0;
    if (!S.next(0, cur)) return;
    PG8_OPAQUE(cur);
    f32x4 acc[2][2][4][2];
#pragma unroll
    for (int a = 0; a < 2; ++a)
#pragma unroll
        for (int b = 0; b < 2; ++b)
#pragma unroll
            for (int m = 0; m < 4; ++m)
#pragma unroll
                for (int n = 0; n < 2; ++n) acc[a][b][m][n] = (f32x4){0.f, 0.f, 0.f, 0.f};
    bf16x8 At[F8 ? 1 : 4][2], B0[F8 ? 1 : 2][2], B1[F8 ? 1 : 2][2];
    v8i32 At8[F8 ? 4 : 1], B08[F8 ? 2 : 1], B18[F8 ? 2 : 1];
    (void)At; (void)B0; (void)B1; (void)At8; (void)B08; (void)B18;
    unsigned vA00, vA01, vA10, vA11, vB0, vB1;
    { PG8_RC(tid); PG8_SETV(cur, vA00, vA01, vA10, vA11, vB0, vB1); }
    unsigned cA = cur.A, cB = cur.B, chB = (unsigned)HALF * cur.ldb2;
    PG8_STAGE(PG8_SB(0, 0), cB, vB0, vB1); PG8_STAGE(PG8_SB(0, 1), cB + chB, vB0, vB1); PG8_STAGE(PG8_SA(0, 0), cA, vA00, vA01); PG8_STAGE(PG8_SA(0, 1), cA, vA10, vA11);
    if (wr == 1) PG8_BAR;
    PG8_WAIT_V(2); PG8_BAR;
    PG8_STAGE(PG8_SB(1, 0), cB + kstep, vB0, vB1); PG8_STAGE(PG8_SA(1, 0), cA + kstep, vA00, vA01); PG8_STAGE(PG8_SB(1, 1), cB + chB + kstep, vB0, vB1);
    PG8_WAIT_V(6); PG8_BAR;
    for (;;) {
        bool has_next = S.next(ui + 1, nxt);
        if (!has_next) { nxt = cur; }
        PG8_OPAQUE(nxt);
        { int hn = __builtin_amdgcn_readfirstlane(has_next ? 1 : 0); asm volatile("" : "+s"(hn)); has_next = hn != 0; }
        const int nt = cur.nt;
        const unsigned nAp = has_next ? nxt.A : cA, nBp = has_next ? nxt.B : cB, nhB = has_next ? (unsigned)HALF * nxt.ldb2 : chB;
        for (int t = 0; t < nt; t += 2) {
            const bool last = (t == nt - 2);
            const unsigned a1 = cA + (unsigned)(t + 1) * kstep;
            const unsigned a2 = last ? nAp : cA + (unsigned)(t + 2) * kstep, b2 = last ? nBp : cB + (unsigned)(t + 2) * kstep, hb2 = last ? nhB : chB;
            const unsigned a3 = a2 + kstep, b3 = b2 + kstep;
            int g00 = 0, g01 = 0, g10 = 0, g11 = 0;
            const bool sw = last && has_next;
            if (GATHER && sw && nxt.gather) {
                int t2 = threadIdx.x; asm volatile("" : "+v"(t2)); PG8_RC(t2); (void)Rb0; (void)Rb1; (void)C0; (void)C1;
                const int* gp_ = (const int*)(wsb + nxt.gather); const int o0 = R0 * 4, o1 = R1 * 4, o2 = (R0 + HALF) * 4, o3 = (R1 + HALF) * 4;
                asm volatile("global_load_dword %0, %1, %2" : "=v"(g00) : "v"(o0), "s"(gp_) : "memory");
                asm volatile("global_load_dword %0, %1, %2" : "=v"(g01) : "v"(o1), "s"(gp_) : "memory");
                asm volatile("global_load_dword %0, %1, %2" : "=v"(g10) : "v"(o2), "s"(gp_) : "memory");
                asm volatile("global_load_dword %0, %1, %2" : "=v"(g11) : "v"(o3), "s"(gp_) : "memory"); }
            PG8_LDB(B0, 0, 0); PG8_LDB(B1, 0, 1); PG8_SCHED; PG8_LDA(At, 0, 0); PG8_STAGE(PG8_SA(1, 1), a1, vA10, vA11);
            PG8_WAIT_V(8); PG8_WAIT_L(0); PG8_BAR; PG8_MMA(0, 0, At, B0); PG8_MMA(0, 1, At, B1); PG8_BAR; PG8_SCHED;
            if (sw) {
                int t3 = threadIdx.x; asm volatile("" : "+v"(t3)); PG8_RC(t3);
                if (!GATHER || !nxt.gather) { g00 = R0; g01 = R1; g10 = R0 + HALF; g11 = R1 + HALF; }
                else { asm volatile("s_waitcnt vmcnt(2)" : "+v"(g00), "+v"(g01), "+v"(g10), "+v"(g11) :: "memory");
                    g00 = (unsigned)g00 < (unsigned)NTOK ? g00 : 0; g01 = (unsigned)g01 < (unsigned)NTOK ? g01 : 0; g10 = (unsigned)g10 < (unsigned)NTOK ? g10 : 0; g11 = (unsigned)g11 < (unsigned)NTOK ? g11 : 0; }
                vA00 = (unsigned)(g00 * nxt.lda2 + C0 * 2); vA01 = (unsigned)(g01 * nxt.lda2 + C1 * 2); vA10 = (unsigned)(g10 * nxt.lda2 + C0 * 2); vA11 = (unsigned)(g11 * nxt.lda2 + C1 * 2);
                vB0 = (unsigned)(Rb0 * nxt.ldb2 + C0 * 2); vB1 = (unsigned)(Rb1 * nxt.ldb2 + C1 * 2); }
            PG8_LDA(At, 0, 1); PG8_STAGE(PG8_SB(0, 0), b2, vB0, vB1); PG8_STAGE(PG8_SB(0, 1), b2 + hb2, vB0, vB1); PG8_STAGE(PG8_SA(0, 0), a2, vA00, vA01);
            PG8_WAIT_V(8); PG8_WAIT_L(0); PG8_BAR; PG8_MMA(1, 0, At, B0); PG8_MMA(1, 1, At, B1); PG8_BAR; PG8_SCHED;
            PG8_LDB(B0, 1, 0); PG8_LDB(B1, 1, 1); PG8_SCHED; PG8_LDA(At, 1, 0); PG8_STAGE(PG8_SA(0, 1), a2, vA10, vA11);
            PG8_WAIT_V(8); PG8_WAIT_L(0); PG8_BAR; PG8_MMA(0, 0, At, B0); PG8_MMA(0, 1, At, B1); PG8_BAR; PG8_SCHED;
            PG8_LDA(At, 1, 1); PG8_STAGE(PG8_SB(1, 0), b3, vB0, vB1); PG8_STAGE(PG8_SB(1, 1), b3 + hb2, vB0, vB1); PG8_STAGE(PG8_SA(1, 0), a3, vA00, vA01);
            PG8_WAIT_V(8); PG8_WAIT_L(0); PG8_BAR; PG8_MMA(1, 0, At, B0); PG8_MMA(1, 1, At, B1); PG8_BAR; PG8_SCHED;
        }
        if (wr == 0) PG8_BAR;
        { int fr_ = fr, fq_ = fq; asm volatile("" : "+v"(fr_), "+v"(fq_));
          E(acc, cur, wr, wc, fr_, fq_); }
        if (!has_next) break;
#pragma unroll
        for (int a = 0; a < 2; ++a)
#pragma unroll
            for (int b = 0; b < 2; ++b)
#pragma unroll
                for (int m = 0; m < 4; ++m)
#pragma unroll
                    for (int n = 0; n < 2; ++n) acc[a][b][m][n] = (f32x4){0.f, 0.f, 0.f, 0.f};
        cur = nxt; cA = nAp; cB = nBp; chB = nhB; ++ui;
        if (wr == 1) PG8_BAR;
    }
    PG8_WAIT_V(0);
    PG8_BAR;
#undef PG8_SA
#undef PG8_SB
#undef PG8_STAGE
#undef PG8_LDA
#undef PG8_LDB
#undef PG8_MMA
#undef PG8_LD8
#undef PG8_WAIT_V
#undef PG8_WAIT_L
#undef PG8_BAR
#undef PG8_SCHED
#undef PG8_SETV
#undef PG8_RC
#undef PG8_OPAQUE
#undef PG8_RFL
}
template <class Epi, class Sched> __device__ __forceinline__ void gemm_phase(PG8_LAS unsigned char* lds, const char* wsb, const Sched& S, const Epi& E) { gemm_phase_t<false, false>(lds, wsb, S, E); }
struct PlainSched {
    unsigned A, B; int lda2, ldb2, nt, nM, nN, G, c;
    __device__ __forceinline__ bool next(int i, UnitD& u) const {
        int pm, pn; if (!static_tile(nM, nN, G, c, i, pm, pn)) return false;
        u.A = A + (unsigned)(pm * BM * lda2); u.B = B + (unsigned)(pn * BM * ldb2); u.gather = 0u; u.lda2 = lda2; u.ldb2 = ldb2; u.nt = nt; u.row0 = pm * BM; u.col0 = pn * BM; u.nvalid = BM; u.aux = 0; u.aux2 = 0; return true; }
};
struct EpiF32 { float* C; int ldc;
    __device__ __forceinline__ void operator()(const f32x4 (&acc)[2][2][4][2], const UnitD& u, int wr, int wc, int fr, int fq) const {
#pragma unroll
        for (int ai = 0; ai < 2; ++ai)
#pragma unroll
            for (int m = 0; m < 4; ++m) { const int r = ai * HALF + wr * 64 + m * 16 + fr; float* rowp = C + (size_t)(u.row0 + r) * ldc + u.col0 + wc * 32 + 8 * fq;
                if (r < u.nvalid) {
#pragma unroll
                    for (int bj = 0; bj < 2; ++bj) { *(f32x4*)(rowp + bj * HALF) = acc[ai][bj][m][0]; *(f32x4*)(rowp + bj * HALF + 4) = acc[ai][bj][m][1]; } } }
    }
};
struct EpiB16 { bf16* C; int ldc;
    __device__ __forceinline__ void operator()(const f32x4 (&acc)[2][2][4][2], const UnitD& u, int wr, int wc, int fr, int fq) const {
#pragma unroll
        for (int ai = 0; ai < 2; ++ai)
#pragma unroll
            for (int m = 0; m < 4; ++m) { const int r = ai * HALF + wr * 64 + m * 16 + fr; bf16* rowp = C + (size_t)(u.row0 + r) * ldc + u.col0 + wc * 32 + 8 * fq;
                if (r < u.nvalid) {
#pragma unroll
                    for (int bj = 0; bj < 2; ++bj) { const f32x4 v0 = acc[ai][bj][m][0], v1 = acc[ai][bj][m][1];
                        u32x4 w; w.x = cvt_pk_bf16(v0[0], v0[1]); w.y = cvt_pk_bf16(v0[2], v0[3]); w.z = cvt_pk_bf16(v1[0], v1[1]); w.w = cvt_pk_bf16(v1[2], v1[3]);
                        *(u32x4*)(rowp + bj * HALF) = w; } } }
    }
};
template <int NJ> struct JobSched {
    unsigned A[NJ], B[NJ]; int nM[NJ], nN[NJ], lda2[NJ], ldb2[NJ], nt[NJ]; int G, c;
    template <int J> __device__ __forceinline__ bool nextj(int L, UnitD& u) const {
        if constexpr (J >= NJ) { return false; }
        else { const int nw = nM[J] * nN[J];
            if (L < nw) { const int pm = L / nN[J], pn = L % nN[J];
                u.A = A[J] + (unsigned)(pm * BM * lda2[J]); u.B = B[J] + (unsigned)(pn * BM * ldb2[J]); u.gather = 0u; u.lda2 = lda2[J]; u.ldb2 = ldb2[J]; u.nt = nt[J];
                u.row0 = pm * BM; u.col0 = pn * BM; u.nvalid = BM; u.aux = J; u.aux2 = 0; return true; }
            return nextj<J + 1>(L - nw, u); } }
    __device__ __forceinline__ bool next(int i, UnitD& u) const { return nextj<0>(i * G + ((G & 7) == 0 ? (c & 7) * (G >> 3) + (c >> 3) : c), u); }
};
template <int NJ> struct EpiF32J { float* C[NJ]; int ldc;
    __device__ __forceinline__ void operator()(const f32x4 (&acc)[2][2][4][2], const UnitD& u, int wr, int wc, int fr, int fq) const {
        float* Cb = C[0];
#pragma unroll
        for (int j = 1; j < NJ; ++j) if (u.aux == j) Cb = C[j];
        EpiF32 e{Cb, ldc}; e(acc, u, wr, wc, fr, fq); }
};

struct MoeSched {
    const PG8_LAS int* tb; int G, c, NP; bool gu;
    unsigned wB; int layer;
    __device__ __forceinline__ bool next(int i, UnitD& u) const {
        const int L = i * G + ((G & 7) == 0 ? (c & 7) * (G >> 3) + (c >> 3) : c), tix = L / NP, pn = L % NP;
        if (tix >= tb[96]) return false;
        int e = 0;
        for (int q = 1; q < NEXP; ++q) if (tb[64 + q] <= tix) e = q;
        e = __builtin_amdgcn_readfirstlane(e);
        const int mt = tix - __builtin_amdgcn_readfirstlane(tb[64 + e]), cnt = __builtin_amdgcn_readfirstlane(tb[e]), base = __builtin_amdgcn_readfirstlane(tb[32 + e]);
        u.nvalid = cnt - mt * BM < BM ? cnt - mt * BM : BM; u.row0 = base + mt * BM; u.aux = e; u.aux2 = mt * BM;
        constexpr int EB = MOE8 ? 1 : 2;
        if (gu) { u.A = (unsigned)WS_F; u.gather = (unsigned)(WS_LIST + ((size_t)e * LISTCAP + (size_t)mt * BM) * 4); u.lda2 = D * EB; u.ldb2 = D * EB; u.nt = D * EB / 128;
                  u.B = wB + (unsigned)e * (unsigned)(2 * DEXP * D * EB) + (unsigned)pn * (unsigned)(BM * D * EB); u.col0 = pn * 128; }
        else { u.A = (unsigned)(WS_ACT + (size_t)(base + mt * BM) * DEXP * EB); u.gather = 0u; u.lda2 = DEXP * EB; u.ldb2 = DEXP * EB; u.nt = DEXP * EB / 128;
               u.B = wB + (unsigned)e * (unsigned)(D * DEXP * EB) + (unsigned)pn * (unsigned)(BM * DEXP * EB); u.col0 = pn * BM; }
        return true; }
};
__device__ __forceinline__ void st8_bf16(bf16* p, const f32x4& v0, const f32x4& v1) { u32x4 w; w.x = cvt_pk_bf16(v0[0], v0[1]); w.y = cvt_pk_bf16(v0[2], v0[3]); w.z = cvt_pk_bf16(v1[0], v1[1]); w.w = cvt_pk_bf16(v1[2], v1[3]); *(u32x4*)p = w; }
__device__ __forceinline__ float sigm(float x) { return __builtin_amdgcn_rcpf(1.0f + __expf(-x)); }
__device__ __forceinline__ float rate1(float x) { return 0.60653066f * sigm(x); }
struct EpiPoolS { bf16* CAT; const float* scale;
    __device__ __forceinline__ void operator()(const f32x4 (&acc)[2][2][4][2], const UnitD& u, int wr, int wc, int fr, int fq) const {
        const int cb = u.aux * 256 + wc * 32 + 8 * fq;
        f32x4 sv[2][2];
#pragma unroll
        for (int bj = 0; bj < 2; ++bj) { sv[bj][0] = *(const f32x4*)(scale + cb + bj * HALF); sv[bj][1] = *(const f32x4*)(scale + cb + bj * HALF + 4); }
#pragma unroll
        for (int ai = 0; ai < 2; ++ai)
#pragma unroll
            for (int m = 0; m < 4; ++m) { const int r = ai * HALF + wr * 64 + m * 16 + fr; bf16* rowp = CAT + (size_t)(u.row0 + r) * D + ATTN_W + cb;
#pragma unroll
                for (int bj = 0; bj < 2; ++bj) st8_bf16(rowp + bj * HALF, acc[ai][bj][m][0] * sv[bj][0], acc[ai][bj][m][1] * sv[bj][1]); }
    }
};
struct EpiSwiglu { bf16* ACT; const float* bg; const float* bu;
    __device__ __forceinline__ void operator()(const f32x4 (&acc)[2][2][4][2], const UnitD& u, int wr, int wc, int fr, int fq) const {
        const int cb = u.col0 + wc * 32 + 8 * fq; const float* pg = bg + u.aux * DEXP + cb; const float* pu = bu + u.aux * DEXP + cb;
        f32x4 g0 = *(const f32x4*)pg, g1 = *(const f32x4*)(pg + 4), u0 = *(const f32x4*)pu, u1 = *(const f32x4*)(pu + 4);
        asm volatile("" : "+v"(g0), "+v"(g1), "+v"(u0), "+v"(u1));
#pragma unroll
        for (int ai = 0; ai < 2; ++ai)
#pragma unroll
            for (int m = 0; m < 4; ++m) { const int r = ai * HALF + wr * 64 + m * 16 + fr;
                constexpr float dq = MOE8 ? 1.0f / MOE8_SW1 : 1.0f;
                f32x4 a0 = acc[ai][0][m][0] * dq + g0, a1 = acc[ai][0][m][1] * dq + g1, l0 = acc[ai][1][m][0] * dq + u0, l1 = acc[ai][1][m][1] * dq + u1;
#pragma unroll
                for (int j = 0; j < 4; ++j) { const float x0 = fminf(a0[j], 7.0f), x1 = fminf(a1[j], 7.0f); const float y0 = fminf(fmaxf(l0[j], -7.0f), 7.0f), y1 = fminf(fmaxf(l1[j], -7.0f), 7.0f);
                    a0[j] = x0 * sigm(1.702f * x0) * (y0 + 1.0f); a1[j] = x1 * sigm(1.702f * x1) * (y1 + 1.0f); }
                if (r < u.nvalid) {
                    if constexpr (MOE8) { u32x2 w8; w8.x = pk4_fp8(a0[0] * MOE8_SACT, a0[1] * MOE8_SACT, a0[2] * MOE8_SACT, a0[3] * MOE8_SACT); w8.y = pk4_fp8(a1[0] * MOE8_SACT, a1[1] * MOE8_SACT, a1[2] * MOE8_SACT, a1[3] * MOE8_SACT);
                        *(u32x2*)((unsigned char*)ACT + (size_t)(u.row0 + r) * DEXP + cb) = w8; }
                    else st8_bf16(ACT + (size_t)(u.row0 + r) * DEXP + cb, a0, a1); } }
    }
};
struct EpiDownF { bf16* YE; const float* bd; const float* listg;
    __device__ __forceinline__ void operator()(const f32x4 (&acc)[2][2][4][2], const UnitD& u, int wr, int wc, int fr, int fq) const {
        const int cb = u.col0 + wc * 32 + 8 * fq; const float* pb = bd + u.aux * D + cb; const float* gl = listg + (size_t)u.aux * LISTCAP + u.aux2;
        f32x4 bv[2][2];
#pragma unroll
        for (int bj = 0; bj < 2; ++bj) { bv[bj][0] = *(const f32x4*)(pb + bj * HALF); bv[bj][1] = *(const f32x4*)(pb + bj * HALF + 4); }
        float gts[2][4];
#pragma unroll
        for (int ai = 0; ai < 2; ++ai)
#pragma unroll
            for (int m = 0; m < 4; ++m) { const int r = ai * HALF + wr * 64 + m * 16 + fr; gts[ai][m] = r < u.nvalid ? gl[r] : 0.f; }
        asm volatile("" : "+v"(gts[0][0]), "+v"(gts[0][1]), "+v"(gts[0][2]), "+v"(gts[0][3]), "+v"(gts[1][0]), "+v"(gts[1][1]), "+v"(gts[1][2]), "+v"(gts[1][3]), "+v"(bv[0][0]), "+v"(bv[0][1]), "+v"(bv[1][0]), "+v"(bv[1][1]));
#pragma unroll
        for (int ai = 0; ai < 2; ++ai)
#pragma unroll
            for (int m = 0; m < 4; ++m) { const int r = ai * HALF + wr * 64 + m * 16 + fr;
                if (r < u.nvalid) { const float gt = gts[ai][m]; bf16* rowp = YE + (size_t)(u.row0 + r) * D + cb;
#pragma unroll
                    for (int bj = 0; bj < 2; ++bj) { constexpr float dq = MOE8 ? 1.0f / (MOE8_SW2 * MOE8_SACT) : 1.0f;
                        st8_bf16(rowp + bj * HALF, (acc[ai][bj][m][0] * dq + bv[bj][0]) * gt, (acc[ai][bj][m][1] * dq + bv[bj][1]) * gt); } } }
    }
};
struct EpiRw1 { float* C0; bf16* L0;
    __device__ __forceinline__ void operator()(const f32x4 (&acc)[2][2][4][2], const UnitD& u, int wr, int wc, int fr, int fq) const {
        if (u.aux < 3) { EpiB16 e{(bf16*)(C0 + (size_t)u.aux * NTOK * D), D}; e(acc, u, wr, wc, fr, fq); return; }
        bf16* Lb = L0 + (size_t)(u.aux - 3) * NTOK * 256; const int mode = u.aux;
#pragma unroll
        for (int ai = 0; ai < 2; ++ai)
#pragma unroll
            for (int m = 0; m < 4; ++m) { const int r = ai * HALF + wr * 64 + m * 16 + fr; bf16* rowp = Lb + (size_t)(u.row0 + r) * 256 + u.col0 + wc * 32 + 8 * fq;
#pragma unroll
                for (int bj = 0; bj < 2; ++bj) { f32x4 v0 = acc[ai][bj][m][0], v1 = acc[ai][bj][m][1];
                    if (mode == 3) {
#pragma unroll
                        for (int j = 0; j < 4; ++j) { v0[j] = 1.0f - 2.0f * __builtin_amdgcn_rcpf(__expf(2.0f * v0[j]) + 1.0f); v1[j] = 1.0f - 2.0f * __builtin_amdgcn_rcpf(__expf(2.0f * v1[j]) + 1.0f); } }
                    else if (mode == 5) {
#pragma unroll
                        for (int j = 0; j < 4; ++j) { v0[j] = sigm(v0[j]); v1[j] = sigm(v1[j]); } }
                    st8_bf16(rowp + bj * HALF, v0, v1); } }
    }
};
struct EpiRw2 { float* DEC; float* AS; float* G; const float* w0; const float* a0;
    __device__ __forceinline__ void operator()(const f32x4 (&acc)[2][2][4][2], const UnitD& u, int wr, int wc, int fr, int fq) const {
        if (u.aux == 2) { EpiB16 e{(bf16*)G, D}; e(acc, u, wr, wc, fr, fq); return; }
        const int d = u.col0 >> 11, cb = (u.col0 & 2047) + wc * 32 + 8 * fq; const bool dec = u.aux == 0;
        bf16* Cb = (bf16*)((dec ? DEC : AS) + (size_t)d * NTOK * D); const float* bp = (dec ? w0 : a0) + d * D + cb;
        f32x4 bv[2][2];
#pragma unroll
        for (int bj = 0; bj < 2; ++bj) { bv[bj][0] = *(const f32x4*)(bp + bj * HALF); bv[bj][1] = *(const f32x4*)(bp + bj * HALF + 4); }
#pragma unroll
        for (int ai = 0; ai < 2; ++ai)
#pragma unroll
            for (int m = 0; m < 4; ++m) { const int r = ai * HALF + wr * 64 + m * 16 + fr; bf16* rowp = Cb + (size_t)(u.row0 + r) * D + cb;
#pragma unroll
                for (int bj = 0; bj < 2; ++bj) { f32x4 v0 = acc[ai][bj][m][0] + bv[bj][0], v1 = acc[ai][bj][m][1] + bv[bj][1];
                    if (dec) { v0 = (f32x4){rate1(v0.x), rate1(v0.y), rate1(v0.z), rate1(v0.w)}; v1 = (f32x4){rate1(v1.x), rate1(v1.y), rate1(v1.z), rate1(v1.w)}; }
                    else { v0 = (f32x4){sigm(v0.x), sigm(v0.y), sigm(v0.z), sigm(v0.w)}; v1 = (f32x4){sigm(v1.x), sigm(v1.y), sigm(v1.z), sigm(v1.w)}; }
                    st8_bf16(rowp + bj * HALF, v0, v1); } }
    }
};
}

__device__ __forceinline__ void transpose_item(const float* W, int N, bf16* WT, int ldt, int k0, int n0, int drow0, int dk0, LAS float* scr, int lane) {
    float tv[32];
#pragma unroll
    for (int i = 0; i < 32; ++i) { const int kk = 2 * i + (lane >> 5); tv[i] = W[(size_t)(k0 + kk) * N + n0 + (lane & 31)]; }
#pragma unroll
    for (int i = 0; i < 32; ++i) { const int kk = 2 * i + (lane >> 5); scr[kk * 33 + (lane & 31)] = tv[i]; }
    asm volatile("s_waitcnt lgkmcnt(0)" ::: "memory");
    const int cch = lane & 7;
#pragma unroll
    for (int j = 0; j < 4; ++j) { const int n = (lane >> 3) + 8 * j; const LAS float* sp = scr + (8 * cch) * 33 + n;
        u32x4 o; o.x = pk2(sp[0 * 33], sp[1 * 33]); o.y = pk2(sp[2 * 33], sp[3 * 33]); o.z = pk2(sp[4 * 33], sp[5 * 33]); o.w = pk2(sp[6 * 33], sp[7 * 33]);
        *(u32x4*)(WT + (size_t)(drow0 + n) * ldt + dk0 + k0 + 8 * cch) = o; }
    asm volatile("s_waitcnt lgkmcnt(0)" ::: "memory");
}

constexpr int CV_GATE = (D / 64) * (DEXP / 32), CV_DOWN = (DEXP / 64) * (D / 32), CV_PER = 2 * CV_GATE + CV_DOWN;
struct CvItem { const float* W; unsigned char* WT; int N, ldt, k0, n0, drow0, esz; float scale; };
__device__ __forceinline__ void cv_decode(const Ctx& c, int le, int r, CvItem& T) {
    T.esz = MOE8 ? 1 : 2;
    if (r < 2 * CV_GATE) { const int up = r / CV_GATE; r %= CV_GATE; const int nb = DEXP / 32, n0 = (r % nb) * 32;
        T.W = (up ? inp(c, I_WUP) : inp(c, I_WGATE)) + (size_t)le * D * DEXP; T.N = DEXP; T.WT = c.ws + WB_GU + (size_t)le * 2 * DEXP * D * T.esz; T.ldt = D; T.k0 = (r / nb) * 64; T.n0 = n0; T.drow0 = (n0 / 128) * 256 + up * 128 + (n0 % 128); T.scale = MOE8 ? MOE8_SW1 : 1.f; }
    else { r -= 2 * CV_GATE; const int nb = D / 32;
        T.W = inp(c, I_WDOWN) + (size_t)le * DEXP * D; T.N = D; T.WT = c.ws + WB_DN + (size_t)le * D * DEXP * T.esz; T.ldt = DEXP; T.k0 = (r / nb) * 64; T.n0 = (r % nb) * 32; T.drow0 = T.n0; T.scale = MOE8 ? MOE8_SW2 : 1.f; }
}
__device__ __forceinline__ void cv_load(const CvItem& T, f32x4 (&tv)[8], int lane) {
    const float* p = T.W + (size_t)(T.k0 + 8 * (lane >> 3)) * T.N + T.n0 + 4 * (lane & 7);
#pragma unroll
    for (int i = 0; i < 8; ++i) tv[i] = *(const f32x4*)(p + (size_t)i * T.N);
}
__device__ __forceinline__ void cv_store(const CvItem& T, const f32x4 (&tv)[8], int lane) {
    const size_t eo = (size_t)(T.drow0 + 4 * (lane & 7)) * T.ldt + T.k0 + 8 * (lane >> 3);
#pragma unroll
    for (int j = 0; j < 4; ++j) {
        if (T.esz == 2) { u32x4 o; o.x = pk2(tv[0][j], tv[1][j]); o.y = pk2(tv[2][j], tv[3][j]); o.z = pk2(tv[4][j], tv[5][j]); o.w = pk2(tv[6][j], tv[7][j]);
            *(u32x4*)(T.WT + (eo + (size_t)j * T.ldt) * 2) = o; }
        else { const float sc = T.scale; u32x2 o; o.x = pk4_fp8(tv[0][j] * sc, tv[1][j] * sc, tv[2][j] * sc, tv[3][j] * sc); o.y = pk4_fp8(tv[4][j] * sc, tv[5][j] * sc, tv[6][j] * sc, tv[7][j] * sc);
            *(u32x2*)(T.WT + eo + (size_t)j * T.ldt) = o; } }
}
constexpr int CVF_Q = 48, CVF_F2 = 256 - (NTOK / 256 * (AB_IN / 256) - 256), CVF_F5 = 256 - (NTOK / 256 * (D / 256) - 256);
constexpr int CVF_TOTAL = (CVF_F2 + CVF_F5) * CVF_Q;
__device__ __forceinline__ void conv_fill(const Ctx& c, int first, int count) {
    __syncthreads();
    LAS float* scr = (LAS float*)(c.lds + c.wave * 8448);
    int k = c.wave;
    if (k < count) {
        CvItem cur; f32x4 tv[8]; cv_decode(c, (first + k) / CV_PER, (first + k) % CV_PER, cur); cv_load(cur, tv, c.lane);
        for (; k < count; k += 8) {
            CvItem nxt = cur; f32x4 tn[8]; const bool more = k + 8 < count;
            if (more) { cv_decode(c, (first + k + 8) / CV_PER, (first + k + 8) % CV_PER, nxt); cv_load(nxt, tn, c.lane); }
            cv_store(cur, tv, c.lane);
            if (more) { cur = nxt;
#pragma unroll
                for (int i = 0; i < 8; ++i) tv[i] = tn[i]; }
        }
    }
    __syncthreads();
}

__device__ __forceinline__ void ph_mod(const Ctx& c) {
    LAS float* s = (LAS float*)c.lds;
    LAS float* red = s + 3 * D;
    for (int i = c.tid; i < 3 * D; i += 512) { const int who = i / D, k = i % D; const float v = who < 2 ? inp(c, I_C)[who * D + k] : inp(c, I_CCTX)[k]; s[i] = v / (1.0f + __expf(-v)); }
    __syncthreads();
    const int kq = c.tid >> 5, c4 = (c.tid & 31) * 4;
    LAS float* red2 = red;
    for (int u = c.bid; u < 2 * (6 * D / 128); u += c.G) {
        const int layer = u / (6 * D / 128), col0 = (u % (6 * D / 128)) * 128;
        const float* w = inp(c, I_WMOD) + (size_t)layer * D * 6 * D + col0 + c4;
        f32x4 a0 = {0.f, 0.f, 0.f, 0.f}, a1 = a0, a2 = a0;
#pragma unroll 8
        for (int k = kq * 128; k < kq * 128 + 128; ++k) { const f32x4 wv = *(const f32x4*)(w + (size_t)k * 6 * D); a0 += wv * s[k]; a1 += wv * s[D + k]; a2 += wv * s[2 * D + k]; }
        *(LAS f32x4*)(red2 + (kq * 3 + 0) * 128 + c4) = a0; *(LAS f32x4*)(red2 + (kq * 3 + 1) * 128 + c4) = a1; *(LAS f32x4*)(red2 + (kq * 3 + 2) * 128 + c4) = a2;
        __syncthreads();
        if (c.tid < 384) { const int who = c.tid / 128, cc = c.tid % 128; float t = 0.f;
            for (int q = 0; q < 16; ++q) t += red2[(q * 3 + who) * 128 + cc];
            const int colg = col0 + cc;
            ((float*)(c.ws + WS_MOD))[((size_t)(layer * 3 + who) * 6) * D + colg] = t + inp(c, I_BMOD)[layer * 6 * D + colg]; }
        __syncthreads();
    }
    {
        __syncthreads();
        LAS float* scr = (LAS float*)(c.lds + c.wave * 8448);
        constexpr int N_WINI = (D / 64) * (AB_IN / 32), N_SQ = (D / 64) * (D / 32), N_POOL = 4 * (256 / 64) * (256 / 32), N_L1 = 2 * (D / 64) * 3, N_G1 = (D / 64) * (GLORA / 32), N_G2 = (GLORA / 64) * (D / 32);
        constexpr int N_SMALL = N_WINI + 5 * N_SQ + N_POOL + 2 * N_L1 + N_G1 + N_G2;
        constexpr int N_GATE = (D / 64) * (DEXP / 32), N_DOWN = (DEXP / 64) * (D / 32);
        constexpr int N_MOE = NEXP * (2 * N_GATE + N_DOWN);
        const int N_ALL = N_SMALL + N_MOE - (c.G == 256 ? CVF_TOTAL : 0);
#define TDEC(it_, T_) do { int r = (it_); T_.esz = 2; T_.scale = 1.f; \
            if (r >= N_SMALL) { r -= N_SMALL; cv_decode(c, r / CV_PER, r % CV_PER, T_); } \
            else if (r < N_WINI) { const int nb = AB_IN / 32; T_.W = inp(c, I_WIN); T_.N = AB_IN; T_.WT = c.ws + WB_WIN; T_.ldt = D; T_.k0 = (r / nb) * 64; T_.n0 = (r % nb) * 32; T_.drow0 = T_.n0; } \
            else if (r < N_WINI + 5 * N_SQ) { r -= N_WINI; const int which = r / N_SQ; r %= N_SQ; const int nb = D / 32; \
                T_.W = which == 0 ? inp(c, I_WOUT) : which == 1 ? inp(c, I_WR) : which == 2 ? inp(c, I_WK) : which == 3 ? inp(c, I_WV) : inp(c, I_WO); \
                T_.WT = c.ws + (which == 0 ? WB_WOUT : which == 1 ? WB_WR : which == 2 ? WB_WK : which == 3 ? WB_WV : WB_WO); T_.N = D; T_.ldt = D; T_.k0 = (r / nb) * 64; T_.n0 = (r % nb) * 32; T_.drow0 = T_.n0; } \
            else if (r < N_WINI + 5 * N_SQ + N_POOL) { r -= N_WINI + 5 * N_SQ; const int g = r / 32; r %= 32; \
                T_.W = inp(c, I_POOLW) + (size_t)g * 65536; T_.N = 256; T_.WT = c.ws + WB_POOL + (size_t)g * 65536 * 2; T_.ldt = 256; T_.k0 = (r / 8) * 64; T_.n0 = (r % 8) * 32; T_.drow0 = T_.n0; } \
            else if (r < N_WINI + 5 * N_SQ + N_POOL + 2 * N_L1) { r -= N_WINI + 5 * N_SQ + N_POOL; const int isa = r / N_L1; r %= N_L1; const int d = r / (N_L1 / 2); r %= (N_L1 / 2); \
                T_.W = (isa ? inp(c, I_A1) : inp(c, I_W1)) + (size_t)d * D * LORA; T_.N = LORA; T_.WT = c.ws + (isa ? WB_A1 : WB_W1); T_.ldt = D; T_.k0 = (r / 3) * 64; T_.n0 = (r % 3) * 32; T_.drow0 = d * 128 + (r % 3) * 32; } \
            else if (r < N_WINI + 5 * N_SQ + N_POOL + 2 * N_L1 + N_G1) { r -= N_WINI + 5 * N_SQ + N_POOL + 2 * N_L1; \
                T_.W = inp(c, I_G1); T_.N = GLORA; T_.WT = c.ws + WB_G1; T_.ldt = D; T_.k0 = (r / 8) * 64; T_.n0 = (r % 8) * 32; T_.drow0 = T_.n0; } \
            else { r -= N_WINI + 5 * N_SQ + N_POOL + 2 * N_L1 + N_G1; const int nb = D / 32; \
                T_.W = inp(c, I_G2); T_.N = D; T_.WT = c.ws + WB_G2; T_.ldt = GLORA; T_.k0 = (r / nb) * 64; T_.n0 = (r % nb) * 32; T_.drow0 = T_.n0; } } while (0)
        for (int rep = 0; rep < DBG_REP0; ++rep) {
        int it = c.gw;
        if (it < N_ALL) {
            CvItem cur; f32x4 tv[8]; TDEC(it, cur); cv_load(cur, tv, c.lane);
            for (; it < N_ALL; it += c.ngw) {
                CvItem nxt = cur; f32x4 tn[8]; const bool more = it + c.ngw < N_ALL;
                if (more) { TDEC(it + c.ngw, nxt); cv_load(nxt, tn, c.lane); }
                cv_store(cur, tv, c.lane);
                if (more) { cur = nxt;
#pragma unroll
                    for (int i = 0; i < 8; ++i) tv[i] = tn[i]; }
            }
        }
        }
#undef TDEC
        {
            const int gt0 = c.bid * 512 + c.tid, ngt0 = c.G * 512;
            for (int i = gt0; i < 2 * NEXP * (D / 8); i += ngt0) {
                const int ch = i & 255, e = (i >> 8) & 31, l = i >> 13; const float* src = inp(c, I_ROUTW) + (size_t)l * D * NEXP + (size_t)(ch * 8) * NEXP + e;
                float h[8], lo[8];
#pragma unroll
                for (int j = 0; j < 8; ++j) { const float w = src[(size_t)j * NEXP]; h[j] = bf2f(f2bf(w)); lo[j] = w - h[j]; }
                u32x4 oh, ol; oh.x = pk2(h[0], h[1]); oh.y = pk2(h[2], h[3]); oh.z = pk2(h[4], h[5]); oh.w = pk2(h[6], h[7]);
                ol.x = pk2(lo[0], lo[1]); ol.y = pk2(lo[2], lo[3]); ol.z = pk2(lo[4], lo[5]); ol.w = pk2(lo[6], lo[7]);
                bf16* dst = (bf16*)(c.ws + WB_RT) + ((size_t)(l * 2) * NEXP + e) * D + ch * 8;
                *(u32x4*)dst = oh; *(u32x4*)(dst + (size_t)NEXP * D) = ol;
            }
        }
        const int gt = c.bid * 512 + c.tid, ngt = c.G * 512;
        for (int i = gt; i < 2 * 2 * D * 32; i += ngt) {
            const int ch = i & 31, n = (i >> 5) & (D - 1), d = (i >> 16) & 1, isa = i >> 17;
            const float* src = (isa ? inp(c, I_A2) : inp(c, I_W2)) + (size_t)d * LORA * D + n;
            float v[8];
#pragma unroll
            for (int j = 0; j < 8; ++j) { const int kk = ch * 8 + j - d * 128; v[j] = (kk >= 0 && kk < LORA) ? src[(size_t)kk * D] : 0.f; }
            u32x4 o; o.x = pk2(v[0], v[1]); o.y = pk2(v[2], v[3]); o.z = pk2(v[4], v[5]); o.w = pk2(v[6], v[7]);
            *(u32x4*)((bf16*)(c.ws + (isa ? WB_A2 : WB_W2)) + ((size_t)d * D + n) * 256 + ch * 8) = o;
        }
        for (int i = gt; i < 2 * 2 * 32 * (D / 8); i += ngt) {
            const int ch = i & 255, rr = (i >> 8) & 31, d = (i >> 13) & 1, isa = i >> 14;
            *(u32x4*)((bf16*)(c.ws + (isa ? WB_A1 : WB_W1)) + (size_t)(d * 128 + 96 + rr) * D + ch * 8) = (u32x4){0u, 0u, 0u, 0u};
        }
    }
    if (c.bid == 0 && c.tid < 32) {
        const int d = c.tid; double inv = 1.0; for (int i = 0; i < d; ++i) inv *= 0.7498942093324559;
        double sn = 0.0, cs = 0.0, term = 1.0;
        for (int n = 0; n < 24; ++n) { if ((n & 1) == 0) cs += ((n & 2) ? -term : term); else sn += ((n & 2) ? -term : term); term *= inv / (double)(n + 1); }
        double cp = 1.0, sp = 0.0; float* ct = (float*)(c.ws + WS_ROPE); float* st = ct + 64 * 32;
        for (int p = 0; p < 64; ++p) { ct[p * 32 + d] = (float)cp; st[p * 32 + d] = (float)sp; const double nc = cp * cs - sp * sn, ns = sp * cs + cp * sn; cp = nc; sp = ns; }
    }
}

__device__ __forceinline__ void ph_prenorm0(const Ctx& c) {
    bf16* H = (bf16*)(c.ws + WS_H);
    const float* g = inp(c, I_NORMG);
    for (int row = c.gw; row < NTOK; row += c.ngw) {
        const RowInfo ri = rowinfo(row);
        const float* xr = row < NLAT ? inp(c, I_X) + (size_t)row * D : inp(c, I_CTX) + (size_t)(row - NLAT) * D;
        const float* sh = modp(c, 0, ri.who, 0); const float* sc = modp(c, 0, ri.who, 1);
        f32x4 v[8]; float ss = 0.f;
#pragma unroll
        for (int j = 0; j < 8; ++j) { v[j] = ((const f32x4*)xr)[j * 64 + c.lane]; ss += v[j].x * v[j].x + v[j].y * v[j].y + v[j].z * v[j].z + v[j].w * v[j].w; }
        const float rstd = rsqrtf(wsum(ss) * (1.0f / D) + 1e-6f);
#pragma unroll
        for (int j = 0; j < 8; ++j) { const int idx = j * 256 + c.lane * 4;
            const f32x4 gg = *(const f32x4*)(g + idx), s4 = *(const f32x4*)(sh + idx), c4 = *(const f32x4*)(sc + idx);
            const f32x4 h = v[j] * rstd * gg * (c4 + 1.0f) + s4;
            u32x2 o; o.x = pk2(h.x, h.y); o.y = pk2(h.z, h.w); *(u32x2*)(H + (size_t)row * D + idx) = o; }
    }
}

__device__ __forceinline__ void ph_prep0(const Ctx& c) {
    const bf16* U = (const bf16*)(c.ws + WS_U); bf16* Q = (bf16*)(c.ws + WS_Q); bf16* Kb = (bf16*)(c.ws + WS_K); bf16* Vb = (bf16*)(c.ws + WS_V); bf16* MP = (bf16*)(c.ws + WS_MP);
    const float* ct = (const float*)(c.ws + WS_ROPE); const float* st = ct + 64 * 32;
    const int lane = c.lane;
    for (int row = c.gw; row < NTOK; row += c.ngw) {
        const RowInfo ri = rowinfo(row); const bool lat = row < NLAT;
        const bf16* u = U + (size_t)row * AB_IN;
        const int kvpos = lat ? ri.t : SEQ + ri.t;
        const int prow = ri.t >> 6, pcol = ri.t & 63;
#pragma unroll
        for (int pass = 0; pass < 2; ++pass) {
            const int e0 = (pass ? ATTN_W : 0) + lane * 16;
            const u32x4 r0 = *(const u32x4*)(u + e0), r1 = *(const u32x4*)(u + e0 + 8);
            float x[16];
            x[0] = bf2f(r0.x & 0xffffu); x[1] = bf2f(r0.x >> 16); x[2] = bf2f(r0.y & 0xffffu); x[3] = bf2f(r0.y >> 16);
            x[4] = bf2f(r0.z & 0xffffu); x[5] = bf2f(r0.z >> 16); x[6] = bf2f(r0.w & 0xffffu); x[7] = bf2f(r0.w >> 16);
            x[8] = bf2f(r1.x & 0xffffu); x[9] = bf2f(r1.x >> 16); x[10] = bf2f(r1.y & 0xffffu); x[11] = bf2f(r1.y >> 16);
            x[12] = bf2f(r1.z & 0xffffu); x[13] = bf2f(r1.z >> 16); x[14] = bf2f(r1.w & 0xffffu); x[15] = bf2f(r1.w >> 16);
            float ss = 0.f;
#pragma unroll
            for (int i = 0; i < 16; ++i) ss += x[i] * x[i];
            ss = sum8(ss);
            const float rstd = rsqrtf(ss * (1.0f / HD) + 1e-6f);
            const float* gain = (pass ? inp(c, I_KGAIN) : inp(c, I_QGAIN)) + (lane & 7) * 16;
            const int s = lane & 7, sub = s & 3, pos = (s >> 2) ? pcol : prow;
            float gv[16], cv[16], sv[16];
#pragma unroll
            for (int q = 0; q < 4; ++q) { const f32x4 g4 = *(const f32x4*)(gain + 4 * q), c4 = *(const f32x4*)(ct + pos * 32 + (sub & 1) * 16 + 4 * q), s4 = *(const f32x4*)(st + pos * 32 + (sub & 1) * 16 + 4 * q);
                gv[4 * q] = g4.x; gv[4 * q + 1] = g4.y; gv[4 * q + 2] = g4.z; gv[4 * q + 3] = g4.w; cv[4 * q] = c4.x; cv[4 * q + 1] = c4.y; cv[4 * q + 2] = c4.z; cv[4 * q + 3] = c4.w;
                sv[4 * q] = s4.x; sv[4 * q + 1] = s4.y; sv[4 * q + 2] = s4.z; sv[4 * q + 3] = s4.w; }
            float o[16];
#pragma unroll
            for (int i = 0; i < 16; ++i) {
                const float xv = x[i] * rstd * gv[i];
                const float pv = dpp_mov<0x4E>(xv);
                if (lat) o[i] = (sub & 2) ? (xv * cv[i] + pv * sv[i]) : (xv * cv[i] - pv * sv[i]);
                else o[i] = xv;
            }
            u32x4 w0, w1;
            w0.x = pk2(o[0], o[1]); w0.y = pk2(o[2], o[3]); w0.z = pk2(o[4], o[5]); w0.w = pk2(o[6], o[7]);
            w1.x = pk2(o[8], o[9]); w1.y = pk2(o[10], o[11]); w1.z = pk2(o[12], o[13]); w1.w = pk2(o[14], o[15]);
            if (pass == 0) { bf16* dst = Q + (size_t)row * ATTN_W + lane * 16; *(u32x4*)dst = w0; *(u32x4*)(dst + 8) = w1; }
            else if (lane < 16) { bf16* dst = Kb + ((size_t)ri.b * KVLEN + kvpos) * KV_W + lane * 16; *(u32x4*)dst = w0; *(u32x4*)(dst + 8) = w1; }
        }
        if (lane >= 16 && lane < 32) {
            const bf16* src = u + ATTN_W + KV_W + (lane - 16) * 16; bf16* dst = Vb + ((size_t)ri.b * KVLEN + kvpos) * KV_W + (lane - 16) * 16;
            *(u32x4*)dst = *(const u32x4*)src; *(u32x4*)(dst + 8) = *(const u32x4*)(src + 8);
        }
        {
            const int c0 = lane * 16, gi = lane >> 4, half = 1 << gi;
            const int lo = ri.t - half < 0 ? 0 : ri.t - half, hi = ri.t + half > ri.n ? ri.n : ri.t + half;
            float acc[16];
#pragma unroll
            for (int i = 0; i < 16; ++i) acc[i] = 0.f;
            u32x4 pr0[16], pr1[16];
#pragma unroll
            for (int q = 0; q < 16; ++q) {
                int tt = ri.t - 8 + q; const bool ok = tt >= lo && tt < hi; tt = ok ? tt : ri.t;
                const bf16* p = U + (size_t)(ri.seq0 + tt) * AB_IN + ATTN_W + 2 * KV_W + c0;
                pr0[q] = *(const u32x4*)p; pr1[q] = *(const u32x4*)(p + 8);
                if (!ok) { pr0[q] = (u32x4){0u, 0u, 0u, 0u}; pr1[q] = (u32x4){0u, 0u, 0u, 0u}; }
            }
#pragma unroll
            for (int q = 0; q < 16; ++q) { const u32x4 r0 = pr0[q], r1 = pr1[q];
                acc[0] += bf2f(r0.x & 0xffffu); acc[1] += bf2f(r0.x >> 16); acc[2] += bf2f(r0.y & 0xffffu); acc[3] += bf2f(r0.y >> 16);
                acc[4] += bf2f(r0.z & 0xffffu); acc[5] += bf2f(r0.z >> 16); acc[6] += bf2f(r0.w & 0xffffu); acc[7] += bf2f(r0.w >> 16);
                acc[8] += bf2f(r1.x & 0xffffu); acc[9] += bf2f(r1.x >> 16); acc[10] += bf2f(r1.y & 0xffffu); acc[11] += bf2f(r1.y >> 16);
                acc[12] += bf2f(r1.z & 0xffffu); acc[13] += bf2f(r1.z >> 16); acc[14] += bf2f(r1.w & 0xffffu); acc[15] += bf2f(r1.w >> 16);
            }
            const float inv = 1.0f / (float)(hi - lo);
            const bf16* p = u + ATTN_W + 2 * KV_W + c0;
            const u32x4 r0 = *(const u32x4*)p, r1 = *(const u32x4*)(p + 8);
            float sv[16];
            sv[0] = bf2f(r0.x & 0xffffu); sv[1] = bf2f(r0.x >> 16); sv[2] = bf2f(r0.y & 0xffffu); sv[3] = bf2f(r0.y >> 16);
            sv[4] = bf2f(r0.z & 0xffffu); sv[5] = bf2f(r0.z >> 16); sv[6] = bf2f(r0.w & 0xffffu); sv[7] = bf2f(r0.w >> 16);
            sv[8] = bf2f(r1.x & 0xffffu); sv[9] = bf2f(r1.x >> 16); sv[10] = bf2f(r1.y & 0xffffu); sv[11] = bf2f(r1.y >> 16);
            sv[12] = bf2f(r1.z & 0xffffu); sv[13] = bf2f(r1.z >> 16); sv[14] = bf2f(r1.w & 0xffffu); sv[15] = bf2f(r1.w >> 16);
            u32x4 w0, w1;
            w0.x = pk2(acc[0] * inv - sv[0], acc[1] * inv - sv[1]); w0.y = pk2(acc[2] * inv - sv[2], acc[3] * inv - sv[3]);
            w0.z = pk2(acc[4] * inv - sv[4], acc[5] * inv - sv[5]); w0.w = pk2(acc[6] * inv - sv[6], acc[7] * inv - sv[7]);
            w1.x = pk2(acc[8] * inv - sv[8], acc[9] * inv - sv[9]); w1.y = pk2(acc[10] * inv - sv[10], acc[11] * inv - sv[11]);
            w1.z = pk2(acc[12] * inv - sv[12], acc[13] * inv - sv[13]); w1.w = pk2(acc[14] * inv - sv[14], acc[15] * inv - sv[15]);
            bf16* dst = MP + (size_t)row * POOL_W + c0; *(u32x4*)dst = w0; *(u32x4*)(dst + 8) = w1;
        }
    }
}


namespace attn {
using bf16 = unsigned short;
constexpr int   D = 128, NW = 8, QBLK = 32, KVBLK = 64;
constexpr float SCALE = 0.088388347648318440f;
constexpr float THR = 8.f;
constexpr int SDEPTH = 2;
constexpr int LDQ = 1024, LDK = 256, LDO = 2048;
constexpr size_t SHM_V = KVBLK * D * 2, SHM_K = KVBLK * D * 2, SHM_ATTN = 2 * SHM_V + 2 * SHM_K + NW * 64 * 4;
using bf16x8 = __attribute__((ext_vector_type(8))) short;
using s16x4  = __attribute__((ext_vector_type(4))) short;
using f32x16 = __attribute__((ext_vector_type(16))) float;
using f32x8  = __attribute__((ext_vector_type(8))) float;
using u32x4  = __attribute__((ext_vector_type(4))) unsigned;
#define KSWZ(row, colB) ((row) * 256 + ((colB) ^ (((row) & 7) << 4)))
#define SBAR() __builtin_amdgcn_sched_barrier(0)
__device__ __forceinline__ int crow(int r, int hi) { return (r & 3) + 8 * (r >> 2) + 4 * hi; }
__device__ __forceinline__ unsigned cvtpk(float lo, float hi) {
  unsigned r; asm volatile("v_cvt_pk_bf16_f32 %0, %1, %2" : "=v"(r) : "v"(lo), "v"(hi)); return r;
}
template <typename TIn> struct Stage;
template <> struct Stage<bf16>  { using T = bf16x8;
  __device__ static __forceinline__ T ld8(const bf16* p) { return *reinterpret_cast<const bf16x8*>(p); }
  __device__ static __forceinline__ bf16x8 tobf(T x) { return x; } };
__device__ __forceinline__ void partialSM(f32x16& p0, f32x16& p1, float& m_reg, float& mn, float& alpha) {
  constexpr float C = SCALE * 1.4426950408889634f;
  float pmax = p0[0]; for (int r = 1; r < 16; ++r) pmax = fmaxf(pmax, p0[r]); for (int r = 0; r < 16; ++r) pmax = fmaxf(pmax, p1[r]);
  { auto rr = __builtin_amdgcn_permlane32_swap(__float_as_uint(pmax), __float_as_uint(pmax), false, false);
    pmax = fmaxf(__uint_as_float(rr[0]), __uint_as_float(rr[1])); }
  if (__builtin_expect(__all(pmax - m_reg <= THR / SCALE), 1)) { mn = m_reg; alpha = 1.f; }
  else { mn = fmaxf(m_reg, pmax); alpha = __builtin_amdgcn_exp2f((m_reg - mn) * C); m_reg = mn; }
  float mnC = -mn * C;
  for (int r = 0; r < 16; ++r) p0[r] = fmaf(p0[r], C, mnC); for (int r = 0; r < 16; ++r) p1[r] = fmaf(p1[r], C, mnC);
  for (int r = 0; r < 16; ++r) p0[r] = __builtin_amdgcn_exp2f(p0[r]);
}
__device__ __forceinline__ void finishSM(f32x16& p0, f32x16& p1, float alpha, float& l_reg, bf16x8& pa0, bf16x8& pa1, bf16x8& pa2, bf16x8& pa3) {
  for (int r = 0; r < 16; ++r) p1[r] = __builtin_amdgcn_exp2f(p1[r]);
  float ps = 0; for (int r = 0; r < 16; ++r) ps += p0[r]; for (int r = 0; r < 16; ++r) ps += p1[r];
  { auto rr = __builtin_amdgcn_permlane32_swap(__float_as_uint(ps), __float_as_uint(ps), false, false);
    ps = __uint_as_float(rr[0]) + __uint_as_float(rr[1]); }
  l_reg = l_reg * alpha + ps;
#define PK4(P, BASE, OUT) do { unsigned a0 = cvtpk(P[BASE + 0], P[BASE + 1]), a1 = cvtpk(P[BASE + 2], P[BASE + 3]);   \
    unsigned b0 = cvtpk(P[BASE + 4], P[BASE + 5]), b1 = cvtpk(P[BASE + 6], P[BASE + 7]);                              \
    auto r0 = __builtin_amdgcn_permlane32_swap(a0, b0, false, false); auto r1 = __builtin_amdgcn_permlane32_swap(a1, b1, false, false); \
    u32x4 w = {r0[0], r1[0], r0[1], r1[1]}; OUT = *reinterpret_cast<bf16x8*>(&w); } while (0)
  PK4(p0, 0, pa0); PK4(p0, 8, pa1); PK4(p1, 0, pa2); PK4(p1, 8, pa3);
#undef PK4
}
__device__ __forceinline__ void qkt(f32x16& p0, f32x16& p1, const bf16* Ks, const bf16x8* qr, int r32, int hi) {
  p0 = f32x16{}; p1 = f32x16{};
  for (int d0 = 0; d0 < 8; ++d0) { int cb = (d0 * 16 + hi * 8) * 2;
    bf16x8 b0 = *reinterpret_cast<const bf16x8*>((const char*)Ks + KSWZ(r32, cb));
    bf16x8 b1 = *reinterpret_cast<const bf16x8*>((const char*)Ks + KSWZ(32 + r32, cb));
    p0 = __builtin_amdgcn_mfma_f32_32x32x16_bf16(b0, qr[d0], p0, 0, 0, 0);
    p1 = __builtin_amdgcn_mfma_f32_32x32x16_bf16(b1, qr[d0], p1, 0, 0, 0); }
}
__device__ __forceinline__ int v_st(int k, int c) { const int kk = (k & ~0xC) | ((k & 4) << 1) | ((k & 8) >> 1); return ((kk >> 3) * 4 + (c >> 5)) * 512 + ((kk & 7) * 32 + (c & 31)) * 2; }
__device__ __forceinline__ int v_rd_base(int lane) { return ((lane & 3) << 3) | (((lane >> 2) & 3) << 6) | (((lane >> 4) & 1) << 5) | (((lane >> 5) & 1) << 8); }
constexpr int v_rd_off(int d0, int ks, int half) { return d0 * 512 + ks * 4096 + half * 2048; }
template <int OFF> __device__ __forceinline__ s16x4 tr_read(int vb) {
  s16x4 r; asm volatile("ds_read_b64_tr_b16 %0, %1 offset:%2" : "=&v"(r) : "v"(vb), "i"(OFF) : "memory"); return r;
}
template <int D0> __device__ __forceinline__ void pv_one(f32x16& od, int vb, bf16x8 pa0, bf16x8 pa1, bf16x8 pa2, bf16x8 pa3) {
  const s16x4 l0 = tr_read<v_rd_off(D0, 0, 0)>(vb), h0 = tr_read<v_rd_off(D0, 0, 1)>(vb), l1 = tr_read<v_rd_off(D0, 1, 0)>(vb), h1 = tr_read<v_rd_off(D0, 1, 1)>(vb);
  const s16x4 l2 = tr_read<v_rd_off(D0, 2, 0)>(vb), h2 = tr_read<v_rd_off(D0, 2, 1)>(vb), l3 = tr_read<v_rd_off(D0, 3, 0)>(vb), h3 = tr_read<v_rd_off(D0, 3, 1)>(vb);
  asm volatile("s_waitcnt lgkmcnt(0)" ::: "memory"); SBAR();
#define PK(L, H) (bf16x8){L[0], L[1], L[2], L[3], H[0], H[1], H[2], H[3]}
  od = __builtin_amdgcn_mfma_f32_32x32x16_bf16(pa0, PK(l0, h0), od, 0, 0, 0);
  od = __builtin_amdgcn_mfma_f32_32x32x16_bf16(pa1, PK(l1, h1), od, 0, 0, 0);
  od = __builtin_amdgcn_mfma_f32_32x32x16_bf16(pa2, PK(l2, h2), od, 0, 0, 0);
  od = __builtin_amdgcn_mfma_f32_32x32x16_bf16(pa3, PK(l3, h3), od, 0, 0, 0);
#undef PK
}
__device__ __forceinline__ void pv_d0(f32x16* o, int vb, bf16x8 pa0, bf16x8 pa1, bf16x8 pa2, bf16x8 pa3) {
  pv_one<0>(o[0], vb, pa0, pa1, pa2, pa3); pv_one<1>(o[1], vb, pa0, pa1, pa2, pa3); pv_one<2>(o[2], vb, pa0, pa1, pa2, pa3); pv_one<3>(o[3], vb, pa0, pa1, pa2, pa3);
}

__device__ __forceinline__ void attn_dense_body(const bf16* __restrict__ Qb, const bf16* __restrict__ Kh, const bf16* __restrict__ Vh,
                                                bf16* __restrict__ Ob, int seq, char* lds) {
  using St = Stage<bf16>; using SQ = Stage<bf16>; using TQ = bf16;
  int tid = threadIdx.x; asm volatile("" : "+v"(tid));
  const int wid = tid >> 6, lane = tid & 63, r32 = lane & 31, hi = lane >> 5;
  bf16* V_lds = (bf16*)lds; bf16* K_lds = (bf16*)(lds + 2 * SHM_V);
  float* ws = (float*)(lds + 2 * SHM_V + 2 * SHM_K) + wid * 64; float* li_l = ws; float* al_l = ws + 32;
  float m_reg = -1e30f, l_reg = 0; f32x16 o[4] = {}; bf16x8 qr[8];
  const TQ* Qw = Qb + (long)(wid * QBLK + r32) * LDQ + hi * 8;
#pragma unroll
  for (int d0 = 0; d0 < 8; ++d0) qr[d0] = SQ::tobf(SQ::ld8(Qw + d0 * 16));
  const int sr = tid >> 4, sc = (tid & 15) * 8, vst0 = v_st(sr, sc), vst1 = v_st(32 + sr, sc);
  const int vb0 = (int)(uintptr_t)V_lds + v_rd_base(lane);
  struct { typename St::T vs0, vs1, ks0, ks1; } sr_[SDEPTH];
#define SLOAD(i, k0) do { sr_[i].vs0 = St::ld8(&Vh[(long)((k0) + sr) * LDK + sc]); sr_[i].vs1 = St::ld8(&Vh[(long)((k0) + 32 + sr) * LDK + sc]); \
    sr_[i].ks0 = St::ld8(&Kh[(long)((k0) + sr) * LDK + sc]); sr_[i].ks1 = St::ld8(&Kh[(long)((k0) + 32 + sr) * LDK + sc]); } while (0)
#define SWRITE(b, i) do { *(bf16x8*)((char*)V_lds + (b) * SHM_V + vst0) = St::tobf(sr_[i].vs0);          \
    *(bf16x8*)((char*)V_lds + (b) * SHM_V + vst1) = St::tobf(sr_[i].vs1); int kc = sc * 2;               \
    *(bf16x8*)((char*)K_lds + (b) * SHM_K + KSWZ(sr, kc)) = St::tobf(sr_[i].ks0);                       \
    *(bf16x8*)((char*)K_lds + (b) * SHM_K + KSWZ(32 + sr, kc)) = St::tobf(sr_[i].ks1); } while (0)
#define SWAIT() do { if constexpr (SDEPTH == 2) asm volatile("s_waitcnt vmcnt(4)" ::: "memory"); else asm volatile("s_waitcnt vmcnt(0)" ::: "memory"); } while (0)
#define RESC(a) do { if (__any((a) < 1.f)) { if (hi == 0) al_l[r32] = (a); asm volatile("s_waitcnt lgkmcnt(0)" ::: "memory"); \
    for (int d = 0; d < 4; ++d) for (int r = 0; r < 16; ++r) o[d][r] *= al_l[crow(r, hi)]; } } while (0)
  f32x16 pA0, pA1, pB0, pB1; float mnA, mnB, alA, alB; bf16x8 pa0, pa1, pa2, pa3; const int NT = seq / KVBLK;
  constexpr int SE = 0, SO = SDEPTH - 1;
  SLOAD(SE, 0); asm volatile("s_waitcnt vmcnt(0)" ::: "memory"); SWRITE(0, SE); __syncthreads();
  qkt(pA0, pA1, K_lds, qr, r32, hi); partialSM(pA0, pA1, m_reg, mnA, alA);
  SLOAD(SO, KVBLK); if constexpr (SDEPTH == 2) { if (2 < NT) SLOAD(SE, 2 * KVBLK); }
  SWAIT(); SWRITE(1, SO); __syncthreads();
  for (int j = 1; j + 1 < NT; j += 2) {
    SBAR(); qkt(pB0, pB1, (bf16*)((char*)K_lds + SHM_K), qr, r32, hi);
    finishSM(pA0, pA1, alA, l_reg, pa0, pa1, pa2, pa3); SBAR();
    SLOAD(SO, (j + SDEPTH) * KVBLK); SBAR();
    pv_d0(o, vb0, pa0, pa1, pa2, pa3); partialSM(pB0, pB1, m_reg, mnB, alB);
    __syncthreads(); SWAIT(); SWRITE(0, SE);
    RESC(alB); __syncthreads();
    SBAR(); qkt(pA0, pA1, K_lds, qr, r32, hi);
    finishSM(pB0, pB1, alB, l_reg, pa0, pa1, pa2, pa3); SBAR();
    if (SDEPTH == 1 || j + 3 < NT) SLOAD(SE, (j + 1 + SDEPTH) * KVBLK); SBAR();
    pv_d0(o, vb0 + (int)SHM_V, pa0, pa1, pa2, pa3); partialSM(pA0, pA1, m_reg, mnA, alA);
    __syncthreads(); SWAIT(); SWRITE(1, SO);
    RESC(alA); __syncthreads();
  }
  SBAR(); qkt(pB0, pB1, (bf16*)((char*)K_lds + SHM_K), qr, r32, hi);
  finishSM(pA0, pA1, alA, l_reg, pa0, pa1, pa2, pa3); SBAR();
  pv_d0(o, vb0, pa0, pa1, pa2, pa3); partialSM(pB0, pB1, m_reg, mnB, alB);
  __syncthreads(); RESC(alB);
  finishSM(pB0, pB1, alB, l_reg, pa0, pa1, pa2, pa3); SBAR();
  pv_d0(o, vb0 + (int)SHM_V, pa0, pa1, pa2, pa3);
  if (hi == 0) li_l[r32] = l_reg; asm volatile("s_waitcnt lgkmcnt(0)" ::: "memory");
  float rli[16];
#pragma unroll
  for (int r = 0; r < 16; ++r) rli[r] = __builtin_amdgcn_rcpf(li_l[crow(r, hi)]);
  bf16* Ow = Ob + (long)(wid * QBLK) * LDO;
#pragma unroll
  for (int r = 0; r < 16; ++r) { int orow = crow(r, hi);
    for (int d0 = 0; d0 < 4; ++d0) Ow[(long)orow * LDO + d0 * 32 + r32] = (bf16)(cvtpk(o[d0][r] * rli[r], 0.f) & 0xffffu); }
#undef SLOAD
#undef SWRITE
#undef SWAIT
#undef RESC
}

}

__device__ __forceinline__ void attn_simple_unit(const Ctx& c, const bf16* Qrows  , const bf16* Kh, const bf16* Vh  ,
                                                 int nkeys, bf16* Orows  ) {
    LAS float* Qs = (LAS float*)c.lds;
    LAS float* Ks = Qs + 64 * 132;
    LAS float* Vs = Ks + 64 * 132;
    LAS float* Ps = Vs + 64 * 128;
    const int tid = c.tid, qi = tid >> 3, g8 = tid & 7;
    __syncthreads();
    for (int i = tid; i < 64 * 16; i += 512) { const int r = i >> 4, cc = (i & 15) * 8; const u32x4 v = *(const u32x4*)(Qrows + (size_t)r * ATTN_W + cc);
        LAS float* d = Qs + r * 132 + cc; d[0] = bf2f(v.x & 0xffffu); d[1] = bf2f(v.x >> 16); d[2] = bf2f(v.y & 0xffffu); d[3] = bf2f(v.y >> 16);
        d[4] = bf2f(v.z & 0xffffu); d[5] = bf2f(v.z >> 16); d[6] = bf2f(v.w & 0xffffu); d[7] = bf2f(v.w >> 16); }
    float m = -1e30f, l = 0.f, o[16];
#pragma unroll
    for (int i = 0; i < 16; ++i) o[i] = 0.f;
    const float scale = 0.08838834764831845f;
    for (int k0 = 0; k0 < nkeys; k0 += 64) {
        __syncthreads();
        for (int i = tid; i < 64 * 16; i += 512) { const int r = i >> 4, cc = (i & 15) * 8;
            const u32x4 v = *(const u32x4*)(Kh + (size_t)(k0 + r) * KV_W + cc); const u32x4 w = *(const u32x4*)(Vh + (size_t)(k0 + r) * KV_W + cc);
            LAS float* d = Ks + r * 132 + cc; d[0] = bf2f(v.x & 0xffffu); d[1] = bf2f(v.x >> 16); d[2] = bf2f(v.y & 0xffffu); d[3] = bf2f(v.y >> 16);
            d[4] = bf2f(v.z & 0xffffu); d[5] = bf2f(v.z >> 16); d[6] = bf2f(v.w & 0xffffu); d[7] = bf2f(v.w >> 16);
            LAS float* e = Vs + r * 128 + cc; e[0] = bf2f(w.x & 0xffffu); e[1] = bf2f(w.x >> 16); e[2] = bf2f(w.y & 0xffffu); e[3] = bf2f(w.y >> 16);
            e[4] = bf2f(w.z & 0xffffu); e[5] = bf2f(w.z >> 16); e[6] = bf2f(w.w & 0xffffu); e[7] = bf2f(w.w >> 16); }
        __syncthreads();
        float s[8];
#pragma unroll
        for (int j = 0; j < 8; ++j) s[j] = 0.f;
        for (int d4 = 0; d4 < 128; d4 += 4) {
            const f32x4 q = *(const LAS f32x4*)(Qs + qi * 132 + d4);
#pragma unroll
            for (int j = 0; j < 8; ++j) { const f32x4 kk = *(const LAS f32x4*)(Ks + (g8 * 8 + j) * 132 + d4); s[j] += q.x * kk.x + q.y * kk.y + q.z * kk.z + q.w * kk.w; }
        }
        float mx = -1e30f;
#pragma unroll
        for (int j = 0; j < 8; ++j) { s[j] *= scale; mx = fmaxf(mx, s[j]); }
        mx = fmaxf(mx, __shfl_xor(mx, 1)); mx = fmaxf(mx, __shfl_xor(mx, 2)); mx = fmaxf(mx, __shfl_xor(mx, 4));
        const float mn = fmaxf(m, mx), alpha = __expf(m - mn);
        float ps = 0.f;
#pragma unroll
        for (int j = 0; j < 8; ++j) { const float p = __expf(s[j] - mn); ps += p; Ps[qi * 68 + g8 * 8 + j] = p; }
        ps += __shfl_xor(ps, 1); ps += __shfl_xor(ps, 2); ps += __shfl_xor(ps, 4);
        l = l * alpha + ps; m = mn;
#pragma unroll
        for (int i = 0; i < 16; ++i) o[i] *= alpha;
        __syncthreads();
        for (int j = 0; j < 64; ++j) {
            const float p = Ps[qi * 68 + j];
#pragma unroll
            for (int i4 = 0; i4 < 4; ++i4) { const f32x4 v = *(const LAS f32x4*)(Vs + j * 128 + g8 * 16 + i4 * 4);
                o[i4 * 4 + 0] += p * v.x; o[i4 * 4 + 1] += p * v.y; o[i4 * 4 + 2] += p * v.z; o[i4 * 4 + 3] += p * v.w; }
        }
    }
    const float il = 1.0f / l;
    u32x4 w0, w1;
    w0.x = pk2(o[0] * il, o[1] * il); w0.y = pk2(o[2] * il, o[3] * il); w0.z = pk2(o[4] * il, o[5] * il); w0.w = pk2(o[6] * il, o[7] * il);
    w1.x = pk2(o[8] * il, o[9] * il); w1.y = pk2(o[10] * il, o[11] * il); w1.z = pk2(o[12] * il, o[13] * il); w1.w = pk2(o[14] * il, o[15] * il);
    bf16* dst = Orows + (size_t)qi * D + g8 * 16; *(u32x4*)dst = w0; *(u32x4*)(dst + 8) = w1;
}
__device__ __forceinline__ void ph_attn_pool(const Ctx& c) {
    const bf16* Q = (const bf16*)(c.ws + WS_Q); const bf16* Kb = (const bf16*)(c.ws + WS_K); const bf16* Vb = (const bf16*)(c.ws + WS_V); bf16* CAT = (bf16*)(c.ws + WS_CAT);
    constexpr int NU_LAT = NB * NHEAD * (SEQ / 256), NU_CTX = NB * NHEAD * (CTXL / 256);
    for (int u = c.bid; u < NU_LAT + NU_CTX; u += c.G) {
        __syncthreads();
        int row0, h, b, koff, seq;
        if (u < NU_LAT) { const int qb = u % (SEQ / 256); h = (u / (SEQ / 256)) % NHEAD; b = u / (SEQ / 256 * NHEAD); row0 = b * SEQ + qb * 256; koff = 0; seq = KVLEN; }
        else { const int v = u - NU_LAT; h = v % NHEAD; b = v / NHEAD; row0 = NLAT + b * CTXL; koff = SEQ; seq = CTXL; }
        const size_t kb = ((size_t)b * KVLEN + koff) * KV_W + (h / 4) * HD;
        attn::attn_dense_body(Q + (size_t)row0 * ATTN_W + h * HD, Kb + kb, Vb + kb, CAT + (size_t)row0 * D + h * HD, seq, (char*)c.lds);
    }
    __syncthreads();
    {   pg8::JobSched<4> S;
#pragma unroll
        for (int g = 0; g < 4; ++g) { S.A[g] = (unsigned)(WS_MP + (size_t)g * 512); S.B[g] = (unsigned)(WB_POOL + (size_t)g * 131072); S.nM[g] = NTOK / 256; S.nN[g] = 1; S.lda2[g] = POOL_W * 2; S.ldb2[g] = 512; S.nt[g] = 4; }
        S.G = c.G; S.c = (c.bid + c.G - 16) % c.G;
        pg8::EpiPoolS e{(bf16*)(c.ws + WS_CAT), inp(c, I_POOLS)};
        pg8::gemm_phase(c.lds, (const char*)c.ws, S, e);
    }
}

__device__ __forceinline__ void ph_rowA(const Ctx& c, int layer) {
    const bf16* Y = (const bf16*)(c.ws + WS_Y); float* X = (float*)(c.ws + WS_X); bf16* F = (bf16*)(c.ws + WS_F);
    int* SELE = (int*)(c.ws + WS_SELE); int* SELP = (int*)(c.ws + WS_SELP); int* LIST = (int*)(c.ws + WS_LIST); float* LISTG = (float*)(c.ws + WS_LISTG);
    unsigned* CNT = (unsigned*)(c.ws + WS_CTL) + CW_CNT + layer * 64;
    const float* gpost = inp(c, I_NORMG) + (size_t)(layer * 4 + 1) * D; const float* gpre = inp(c, I_NORMG) + (size_t)(layer * 4 + 2) * D;
    const float* RW = inp(c, I_ROUTW) + (size_t)layer * D * NEXP; const float* RB = inp(c, I_ROUTB) + layer * NEXP;
    const int nrows = layer == 0 ? NTOK : NLAT; const int lane = c.lane;
    for (int row = c.gw; row < nrows; row += c.ngw) {
        const RowInfo ri = rowinfo(row);
        const float* xr = layer == 0 ? (row < NLAT ? inp(c, I_X) + (size_t)row * D : inp(c, I_CTX) + (size_t)(row - NLAT) * D) : X + (size_t)row * D;
        const float* m2 = modp(c, layer, ri.who, 2); const float* m3 = modp(c, layer, ri.who, 3); const float* m4 = modp(c, layer, ri.who, 4);
        f32x4 v[8]; float ss = 0.f;
#pragma unroll
        for (int jj = 0; jj < 4; ++jj) { const u32x4 q = *(const u32x4*)(Y + (size_t)row * D + jj * 512 + lane * 8);
            v[2 * jj] = (f32x4){bf2f(q.x & 0xffffu), bf2f(q.x >> 16), bf2f(q.y & 0xffffu), bf2f(q.y >> 16)}; v[2 * jj + 1] = (f32x4){bf2f(q.z & 0xffffu), bf2f(q.z >> 16), bf2f(q.w & 0xffffu), bf2f(q.w >> 16)}; }
#pragma unroll
        for (int j = 0; j < 8; ++j) ss += v[j].x * v[j].x + v[j].y * v[j].y + v[j].z * v[j].z + v[j].w * v[j].w;
        float rstd = rsqrtf(wsum(ss) * (1.0f / D) + 1e-6f);
        ss = 0.f;
#pragma unroll
        for (int j = 0; j < 8; ++j) { const int idx = ((j >> 1) * 512 + lane * 8 + (j & 1) * 4);
            const f32x4 x0 = *(const f32x4*)(xr + idx), gg = *(const f32x4*)(gpost + idx), mm = *(const f32x4*)(m2 + idx);
            v[j] = x0 + mm * (v[j] * rstd * gg);
            *(f32x4*)(X + (size_t)row * D + idx) = v[j];
            ss += v[j].x * v[j].x + v[j].y * v[j].y + v[j].z * v[j].z + v[j].w * v[j].w; }
        rstd = rsqrtf(wsum(ss) * (1.0f / D) + 1e-6f);
        LAS float* fl = (LAS float*)(c.lds + c.wave * 8192);
        unsigned fp8lo = 0u;
#pragma unroll
        for (int j = 0; j < 8; ++j) { const int idx = ((j >> 1) * 512 + lane * 8 + (j & 1) * 4);
            const f32x4 gg = *(const f32x4*)(gpre + idx), s4 = *(const f32x4*)(m3 + idx), c4 = *(const f32x4*)(m4 + idx);
            const f32x4 f = v[j] * rstd * gg * (c4 + 1.0f) + s4;
            if constexpr (MOE8) { const unsigned p8 = pk4_fp8(f.x, f.y, f.z, f.w);
                if (j & 1) { u32x2 o8; o8.x = fp8lo; o8.y = p8; *(u32x2*)((unsigned char*)F + (size_t)row * D + idx - 4) = o8; } else fp8lo = p8; }
            else { u32x2 o; o.x = pk2(f.x, f.y); o.y = pk2(f.z, f.w); *(u32x2*)(F + (size_t)row * D + idx) = o; }
            *(LAS f32x4*)(fl + idx) = f; }
        float mine;
        {
            typedef short bf16x8_t __attribute__((ext_vector_type(8)));
            __syncthreads();
            const int fr = lane & 15, fq = lane >> 4;
            const bf16* wth = (const bf16*)(c.ws + WB_RT) + (size_t)(layer * 2) * NEXP * D; const bf16* wtl = wth + (size_t)NEXP * D;
            const LAS float* fa = (const LAS float*)c.lds + (fr & 7) * 2048 + c.wave * 256 + fq * 8;
            f32x4 acc0 = {0.f, 0.f, 0.f, 0.f}, acc1 = acc0;
#pragma unroll 2
            for (int s8 = 0; s8 < 8; ++s8) {
                const int k0 = c.wave * 256 + s8 * 32 + fq * 8;
                const bf16x8_t bh0 = *(const bf16x8_t*)(wth + (size_t)fr * D + k0), bh1 = *(const bf16x8_t*)(wth + (size_t)(16 + fr) * D + k0);
                const bf16x8_t bl0 = *(const bf16x8_t*)(wtl + (size_t)fr * D + k0), bl1 = *(const bf16x8_t*)(wtl + (size_t)(16 + fr) * D + k0);
                f32x4 f0 = *(const LAS f32x4*)(fa + s8 * 32), f1 = *(const LAS f32x4*)(fa + s8 * 32 + 4);
                if (fr >= 8) { f0 = (f32x4){0.f, 0.f, 0.f, 0.f}; f1 = f0; }
                const float fv[8] = {f0.x, f0.y, f0.z, f0.w, f1.x, f1.y, f1.z, f1.w};
                bf16x8_t ah, al;
#pragma unroll
                for (int j = 0; j < 8; ++j) { const unsigned hb = f2bf(fv[j]); ah[j] = (short)hb; al[j] = (short)f2bf(fv[j] - bf2f(hb)); }
                acc0 = __builtin_amdgcn_mfma_f32_16x16x32_bf16(ah, bh0, acc0, 0, 0, 0); acc1 = __builtin_amdgcn_mfma_f32_16x16x32_bf16(ah, bh1, acc1, 0, 0, 0);
                acc0 = __builtin_amdgcn_mfma_f32_16x16x32_bf16(al, bh0, acc0, 0, 0, 0); acc1 = __builtin_amdgcn_mfma_f32_16x16x32_bf16(al, bh1, acc1, 0, 0, 0);
                acc0 = __builtin_amdgcn_mfma_f32_16x16x32_bf16(ah, bl0, acc0, 0, 0, 0); acc1 = __builtin_amdgcn_mfma_f32_16x16x32_bf16(ah, bl1, acc1, 0, 0, 0);
            }
            LAS float* pb = (LAS float*)(c.lds + 65536);
            if (fq < 2) {
#pragma unroll
                for (int r = 0; r < 4; ++r) { pb[(c.wave * 8 + 4 * fq + r) * 32 + fr] = acc0[r]; pb[(c.wave * 8 + 4 * fq + r) * 32 + 16 + fr] = acc1[r]; } }
            __syncthreads();
            float t = 0.f;
            if (lane < NEXP) {
#pragma unroll
                for (int w8 = 0; w8 < 8; ++w8) t += pb[(w8 * 8 + c.wave) * 32 + lane]; }
            mine = lane < NEXP ? t + RB[lane] : -3.0e38f;
            __syncthreads();
        }
        int sel[4]; float sv[4];
#pragma unroll
        for (int r = 0; r < 4; ++r) {
            const float mx = wmax(mine);
            const unsigned long long bal = __ballot(mine == mx && lane < NEXP);
            const int idx = __ffsll((long long)bal) - 1;
            sel[r] = idx; sv[r] = mx; if (lane == idx) mine = -3.0e38f;
        }
        const float e1 = __expf(sv[1] - sv[0]), e2 = __expf(sv[2] - sv[0]), e3 = __expf(sv[3] - sv[0]);
        const float inv = 1.0f / (1.0f + e1 + e2 + e3);
        if (lane < 4) {
            const int e = lane == 0 ? sel[0] : lane == 1 ? sel[1] : lane == 2 ? sel[2] : sel[3];
            const float gt = (lane == 0 ? 1.0f : lane == 1 ? e1 : lane == 2 ? e2 : e3) * inv;
            const unsigned pos = __hip_atomic_fetch_add(CNT + e, 1u, __ATOMIC_RELAXED, __HIP_MEMORY_SCOPE_AGENT);
            LIST[e * LISTCAP + pos] = row; LISTG[e * LISTCAP + pos] = gt;
            SELE[row * 4 + lane] = e; SELP[row * 4 + lane] = (int)pos;
        }
    }
}

constexpr int TB_OFF = 131072;
__device__ __forceinline__ void moe_tables(const Ctx& c, int layer, LAS int* tb) {
    __syncthreads();
    if (c.tid == 0) { const unsigned* CNT = (const unsigned*)(c.ws + WS_CTL) + CW_CNT + layer * 64; int base = 0, tp = 0;
        for (int e = 0; e < NEXP; ++e) { const int n = (int)__hip_atomic_load(CNT + e, __ATOMIC_RELAXED, __HIP_MEMORY_SCOPE_AGENT); tb[e] = n; tb[32 + e] = base; tb[64 + e] = tp; base += (n + 255) / 256 * 256; tp += (n + 255) / 256; }
        tb[96] = tp; }
    __syncthreads();
}
__device__ __forceinline__ void ph_moe_gu(const Ctx& c, int layer) {
    LAS int* tb = (LAS int*)(c.lds + TB_OFF);
    moe_tables(c, layer, tb);
    pg8::MoeSched S{tb, c.G, c.bid, 8, true, (unsigned)(WB_GU + (size_t)layer * NEXP * 2 * DEXP * D * (MOE8 ? 1 : 2)), layer};
    pg8::EpiSwiglu e{(bf16*)(c.ws + WS_ACT), inp(c, I_BGATE) + (size_t)layer * NEXP * DEXP, inp(c, I_BUP) + (size_t)layer * NEXP * DEXP};
    pg8::gemm_phase_t<MOE8, true>(c.lds, (const char*)c.ws, S, e);
}
__device__ __forceinline__ void ph_moe_down(const Ctx& c, int layer) {
    LAS int* tb = (LAS int*)(c.lds + TB_OFF);
    moe_tables(c, layer, tb);
    pg8::MoeSched S{tb, c.G, c.bid, 8, false, (unsigned)(WB_DN + (size_t)layer * NEXP * D * DEXP * (MOE8 ? 1 : 2)), layer};
    pg8::EpiDownF e{(bf16*)(c.ws + WS_YE), inp(c, I_BDOWN) + (size_t)layer * NEXP * D, (const float*)(c.ws + WS_LISTG)};
    pg8::gemm_phase_t<MOE8, false>(c.lds, (const char*)c.ws, S, e);
}

__device__ __forceinline__ void ph_rowB(const Ctx& c, int layer) {
    float* X = (float*)(c.ws + WS_X); const bf16* YE = (const bf16*)(c.ws + WS_YE); float* H1 = (float*)(c.ws + WS_H1);
    const int* SELE = (const int*)(c.ws + WS_SELE); const int* SELP = (const int*)(c.ws + WS_SELP);
    const unsigned* CNT = (const unsigned*)(c.ws + WS_CTL) + CW_CNT + layer * 64;
    const float* gpf = inp(c, I_NORMG) + (size_t)(layer * 4 + 3) * D; const float* gpm1 = inp(c, I_NORMG) + (size_t)(1 * 4 + 0) * D;
    const int nrows = layer == 0 ? NTOK : NLAT; const int lane = c.lane;
    int mybase;
    { int n = lane < NEXP ? (int)__hip_atomic_load(CNT + (lane & 31), __ATOMIC_RELAXED, __HIP_MEMORY_SCOPE_AGENT) : 0; n = (n + 255) / 256 * 256; int incl = n;
#pragma unroll
      for (int o = 1; o < 32; o <<= 1) { const int t = shi(incl, (lane - o) & 63); if ((lane & 31) >= o) incl += t; }
      mybase = incl - n; }
    for (int row = c.gw; row < nrows; row += c.ngw) {
        const RowInfo ri = rowinfo(row);
        f32x4 v[8];
#pragma unroll
        for (int j = 0; j < 8; ++j) v[j] = (f32x4){0.f, 0.f, 0.f, 0.f};
#pragma unroll
        for (int r = 0; r < 4; ++r) {
            const int e = SELE[row * 4 + r], pos = SELP[row * 4 + r];
            const int slot = shi(mybase, e) + pos;
            const bf16* yr = YE + (size_t)slot * D;
#pragma unroll
            for (int jj = 0; jj < 4; ++jj) { const u32x4 w = *(const u32x4*)(yr + jj * 512 + lane * 8);
                v[2 * jj].x += bf2f(w.x & 0xffffu); v[2 * jj].y += bf2f(w.x >> 16); v[2 * jj].z += bf2f(w.y & 0xffffu); v[2 * jj].w += bf2f(w.y >> 16);
                v[2 * jj + 1].x += bf2f(w.z & 0xffffu); v[2 * jj + 1].y += bf2f(w.z >> 16); v[2 * jj + 1].z += bf2f(w.w & 0xffffu); v[2 * jj + 1].w += bf2f(w.w >> 16); }
        }
        float ss = 0.f;
#pragma unroll
        for (int j = 0; j < 8; ++j) ss += v[j].x * v[j].x + v[j].y * v[j].y + v[j].z * v[j].z + v[j].w * v[j].w;
        float rstd = rsqrtf(wsum(ss) * (1.0f / D) + 1e-6f);
        const float* m5 = modp(c, layer, ri.who, 5);
        ss = 0.f;
#pragma unroll
        for (int j = 0; j < 8; ++j) { const int idx = ((j >> 1) * 512 + lane * 8 + (j & 1) * 4);
            const f32x4 x0 = *(const f32x4*)(X + (size_t)row * D + idx), gg = *(const f32x4*)(gpf + idx), mm = *(const f32x4*)(m5 + idx);
            v[j] = x0 + mm * (v[j] * rstd * gg);
            ss += v[j].x * v[j].x + v[j].y * v[j].y + v[j].z * v[j].z + v[j].w * v[j].w; }
        if (layer == 1) {
#pragma unroll
            for (int j = 0; j < 8; ++j) *(f32x4*)(c.out + (size_t)row * D + ((j >> 1) * 512 + lane * 8 + (j & 1) * 4)) = v[j];
        } else {
            rstd = rsqrtf(wsum(ss) * (1.0f / D) + 1e-6f);
            const float* sh = modp(c, 1, ri.who, 0); const float* sc = modp(c, 1, ri.who, 1);
            u32x2 hlo = {0u, 0u};
#pragma unroll
            for (int j = 0; j < 8; ++j) { const int idx = ((j >> 1) * 512 + lane * 8 + (j & 1) * 4);
                *(f32x4*)(X + (size_t)row * D + idx) = v[j];
                const f32x4 gg = *(const f32x4*)(gpm1 + idx), s4 = *(const f32x4*)(sh + idx), c4 = *(const f32x4*)(sc + idx);
                const f32x4 hv = v[j] * rstd * gg * (c4 + 1.0f) + s4; u32x2 hw; hw.x = pk2(hv.x, hv.y); hw.y = pk2(hv.z, hv.w);
                if (j & 1) { u32x4 h4; h4.x = hlo.x; h4.y = hlo.y; h4.z = hw.x; h4.w = hw.y; *(u32x4*)((bf16*)H1 + (size_t)row * D + idx - 4) = h4; } else hlo = hw; }
        }
    }
}

__device__ __forceinline__ void ph_shiftmix(const Ctx& c) {
    const bf16* H1 = (const bf16*)(c.ws + WS_H1); bf16* XS = (bf16*)(c.ws + WS_XS); const float* mix = inp(c, I_MIX);
    const int lane = c.lane;
    constexpr int RPW = 5;
    for (int row0 = c.gw; row0 < NTOK; row0 += RPW * c.ngw) {
#pragma unroll 1
        for (int j = 0; j < 4; ++j) { const int idx = j * 512 + lane * 8;
            f32x4 m0[6], m1[6];
#pragma unroll
            for (int s = 0; s < 6; ++s) { m0[s] = *(const f32x4*)(mix + s * D + idx); m1[s] = *(const f32x4*)(mix + s * D + idx + 4); }
            u32x4 qh[RPW], qp[RPW], qn[RPW];
#pragma unroll
            for (int i = 0; i < RPW; ++i) { const int row = row0 + i * c.ngw; qh[i] = (u32x4){0u, 0u, 0u, 0u}; qp[i] = qh[i]; qn[i] = qh[i];
                if (row < NTOK) { const RowInfo ri = rowinfo(row);
                    qh[i] = *(const u32x4*)(H1 + (size_t)row * D + idx);
                    if (ri.t > 0) qp[i] = *(const u32x4*)(H1 + (size_t)(row - 1) * D + idx);
                    if (ri.t < ri.n - 1) qn[i] = *(const u32x4*)(H1 + (size_t)(row + 1) * D + idx); } }
#define UNP(q_, lo_) ((f32x4){bf2f((lo_ ? q_.x : q_.z) & 0xffffu), bf2f((lo_ ? q_.x : q_.z) >> 16), bf2f((lo_ ? q_.y : q_.w) & 0xffffu), bf2f((lo_ ? q_.y : q_.w) >> 16)})
#pragma unroll
            for (int i = 0; i < RPW; ++i) { const int row = row0 + i * c.ngw;
                if (row < NTOK) {
                    const f32x4 h0 = UNP(qh[i], true), h1 = UNP(qh[i], false);
                    const f32x4 xx0 = (UNP(qp[i], true) + UNP(qn[i], true)) * 0.5f - h0, xx1 = (UNP(qp[i], false) + UNP(qn[i], false)) * 0.5f - h1;
#pragma unroll
                    for (int s = 0; s < 6; ++s) { const f32x4 o0 = h0 + xx0 * m0[s], o1 = h1 + xx1 * m1[s];
                        u32x4 w; w.x = pk2(o0.x, o0.y); w.y = pk2(o0.z, o0.w); w.z = pk2(o1.x, o1.y); w.w = pk2(o1.z, o1.w); *(u32x4*)(XS + ((size_t)s * NTOK + row) * D + idx) = w; } } }
#undef UNP
        }
    }
}

__device__ __forceinline__ void ph_rw_gemm1(const Ctx& c) {
    constexpr size_t XSZ = (size_t)NTOK * D * 2;
    pg8::JobSched<6> S;
    S.A[0] = (unsigned)WS_XS; S.A[1] = (unsigned)(WS_XS + 2 * XSZ); S.A[2] = (unsigned)(WS_XS + 3 * XSZ); S.A[3] = (unsigned)(WS_XS + 1 * XSZ); S.A[4] = (unsigned)(WS_XS + 4 * XSZ); S.A[5] = (unsigned)(WS_XS + 5 * XSZ);
    S.B[0] = (unsigned)WB_WR; S.B[1] = (unsigned)WB_WK; S.B[2] = (unsigned)WB_WV; S.B[3] = (unsigned)WB_W1; S.B[4] = (unsigned)WB_A1; S.B[5] = (unsigned)WB_G1;
    S.nM[0] = NLAT / 256; S.nM[1] = NTOK / 256; S.nM[2] = NTOK / 256; S.nM[3] = NTOK / 256; S.nM[4] = NTOK / 256; S.nM[5] = NLAT / 256;
#pragma unroll
    for (int j = 0; j < 6; ++j) { S.nN[j] = j < 3 ? D / 256 : 1; S.lda2[j] = D * 2; S.ldb2[j] = D * 2; S.nt[j] = D / 64; }
    S.G = c.G; S.c = c.bid;
    static_assert(WS_KK == WS_R + (size_t)NTOK * D * 4 && WS_VV == WS_KK + (size_t)NTOK * D * 4 && WS_LA == WS_LW + (size_t)NTOK * 512 && WS_LG == WS_LA + (size_t)NTOK * 512, "contiguous outputs");
    pg8::EpiRw1 e{(float*)(c.ws + WS_R), (bf16*)(c.ws + WS_LW)};
    pg8::gemm_phase(c.lds, (const char*)c.ws, S, e);
}
__device__ __forceinline__ void ph_rw_gemm2(const Ctx& c) {
    pg8::JobSched<3> S;
    S.A[0] = (unsigned)WS_LW; S.A[1] = (unsigned)WS_LA; S.A[2] = (unsigned)WS_LG;
    S.B[0] = (unsigned)WB_W2; S.B[1] = (unsigned)WB_A2; S.B[2] = (unsigned)WB_G2;
    S.nM[0] = NTOK / 256; S.nM[1] = NTOK / 256; S.nM[2] = NLAT / 256; S.nN[0] = 16; S.nN[1] = 16; S.nN[2] = 8;
#pragma unroll
    for (int j = 0; j < 3; ++j) { S.lda2[j] = 512; S.ldb2[j] = 512; S.nt[j] = 4; }
    S.G = c.G; S.c = c.bid;
    pg8::EpiRw2 e{(float*)(c.ws + WS_DEC), (float*)(c.ws + WS_AS), (float*)(c.ws + WS_G), inp(c, I_W0), inp(c, I_A0)};
    pg8::gemm_phase(c.lds, (const char*)c.ws, S, e);
}

constexpr int SC_T = 32, SC_NCH = (CTXL + SEQ) / SC_T, SC_VS = 6 * RN;
__device__ __forceinline__ int scan_row(int s, int dir, int b) {
    return s < CTXL ? (NLAT + b * CTXL + (dir ? (CTXL - 1 - s) : s)) : (b * SEQ + (dir ? (SEQ - 1 - (s - CTXL)) : (s - CTXL)));
}
struct ScanLd { u32x2 k, v, r, w, a; };
__device__ __forceinline__ f32x4 bf4(const u32x2& q) { return (f32x4){bf2f(q.x & 0xffffu), bf2f(q.x >> 16), bf2f(q.y & 0xffffu), bf2f(q.y >> 16)}; }
__device__ __forceinline__ void scan_issue(ScanLd& L, const bf16* Kp, const bf16* Vp, const bf16* Rp, const bf16* Wp, const bf16* Ap, int row, int col) {
    const size_t o = (size_t)row * D + col;
    L.k = *(const u32x2*)(Kp + o); L.v = *(const u32x2*)(Vp + o); L.w = *(const u32x2*)(Wp + o); L.a = *(const u32x2*)(Ap + o);
    L.r = row < NLAT ? *(const u32x2*)(Rp + o) : (u32x2){0u, 0u};
}
__device__ __forceinline__ void scan_put(const ScanLd& Lb, LAS float* dst  , const f32x4& kk4, const f32x4& ka4) {
    const f32x4 Lk = bf4(Lb.k), Lv = bf4(Lb.v), Lr = bf4(Lb.r), La = bf4(Lb.a), Le = bf4(Lb.w);
    const f32x4 Lw = (f32x4){__expf(-Le.x), __expf(-Le.y), __expf(-Le.z), __expf(-Le.w)};
    const f32x4 kr = Lk * kk4;
    const float ss = sum16(kr.x * kr.x + kr.y * kr.y + kr.z * kr.z + kr.w * kr.w);
    const f32x4 kk = kr * rsqrtf(fmaxf(ss, 1e-24f));
    *(LAS f32x4*)(dst + 0 * RN) = Lw;
    *(LAS f32x4*)(dst + 1 * RN) = Lk * ((La - 1.0f) * ka4 + 1.0f);
    *(LAS f32x4*)(dst + 2 * RN) = -kk;
    *(LAS f32x4*)(dst + 3 * RN) = kk * La;
    *(LAS f32x4*)(dst + 4 * RN) = Lr;
    *(LAS f32x4*)(dst + 5 * RN) = Lv;
}
struct ScanOp { f32x4 w0, w1, k0, k1, a0, a1, b0, b1, r0, r1; float v; };
template <bool WANTY, bool PROBE = false> __device__ __forceinline__ void scan_ld(ScanOp& o, const LAS float* p, const LAS float* pv) {
    if (PROBE) {
        o.w0 = *(const LAS f32x4*)(p); o.w1 = o.w0; o.k0 = *(const LAS f32x4*)(p + RN); o.k1 = o.k0; o.a0 = *(const LAS f32x4*)(p + 2 * RN); o.a1 = o.a0; o.b0 = *(const LAS f32x4*)(p + 3 * RN); o.b1 = o.b0;
        if (WANTY) { o.r0 = *(const LAS f32x4*)(p + 4 * RN); o.r1 = o.r0; }
        o.v = pv[5 * RN]; return; }
    o.w0 = *(const LAS f32x4*)(p); o.w1 = *(const LAS f32x4*)(p + 4); o.k0 = *(const LAS f32x4*)(p + RN); o.k1 = *(const LAS f32x4*)(p + RN + 4);
    o.b0 = *(const LAS f32x4*)(p + 3 * RN); o.b1 = *(const LAS f32x4*)(p + 3 * RN + 4);
    if (WANTY) { o.r0 = *(const LAS f32x4*)(p + 4 * RN); o.r1 = *(const LAS f32x4*)(p + 4 * RN + 4); }
    o.v = pv[5 * RN];
    asm volatile("" ::: "memory");
    o.a0 = *(const LAS f32x4*)(p + 2 * RN); o.a1 = *(const LAS f32x4*)(p + 2 * RN + 4);
}
__device__ __forceinline__ float scan_stepA(const f32x2& S0, const f32x2& S1, const f32x2& S2, const f32x2& S3, const ScanOp& o) {
    const f32x2 t01 = S0 * (f32x2){o.a0.x, o.a0.y} + S1 * (f32x2){o.a0.z, o.a0.w}, t23 = S2 * (f32x2){o.a1.x, o.a1.y} + S3 * (f32x2){o.a1.z, o.a1.w};
    const f32x2 t = t01 + t23;
    return t.x + t.y;
}
template <bool WANTY> __device__ __forceinline__ void scan_stepB(f32x2& S0, f32x2& S1, f32x2& S2, f32x2& S3, const ScanOp& o, float tsum, float& yp) {
    const float v = o.v;
    const f32x2 P0 = S0 * (f32x2){o.w0.x, o.w0.y} + (f32x2){o.k0.x, o.k0.y} * v, P1 = S1 * (f32x2){o.w0.z, o.w0.w} + (f32x2){o.k0.z, o.k0.w} * v;
    const f32x2 P2 = S2 * (f32x2){o.w1.x, o.w1.y} + (f32x2){o.k1.x, o.k1.y} * v, P3 = S3 * (f32x2){o.w1.z, o.w1.w} + (f32x2){o.k1.z, o.k1.w} * v;
    const float sa = sum8(tsum);
    S0 = (f32x2){o.b0.x, o.b0.y} * sa + P0; S1 = (f32x2){o.b0.z, o.b0.w} * sa + P1; S2 = (f32x2){o.b1.x, o.b1.y} * sa + P2; S3 = (f32x2){o.b1.z, o.b1.w} * sa + P3;
    if (WANTY) {
        const f32x2 y01 = S0 * (f32x2){o.r0.x, o.r0.y} + S1 * (f32x2){o.r0.z, o.r0.w}, y23 = S2 * (f32x2){o.r1.x, o.r1.y} + S3 * (f32x2){o.r1.z, o.r1.w};
        const f32x2 y2 = y01 + y23;
        yp = y2.x + y2.y;
    }
}
template <int CTRL> __device__ __forceinline__ float scan_ycomb(float x, float y, bool c) { const float z = c ? y : x, w = c ? x : y; return z + dpp_mov<CTRL>(w); }
#define SCAN_STEP(CUR, NXT, K, LOADNEXT) { const float ts_ = scan_stepA(S0, S1, S2, S3, CUR); __builtin_amdgcn_sched_barrier(0); \
    if (LOADNEXT) scan_ld<WANTY, PROBE>(NXT, q + ((K) + 1) * SC_VS, qv + ((K) + 1) * SC_VS); __builtin_amdgcn_sched_barrier(0); scan_stepB<WANTY>(S0, S1, S2, S3, CUR, ts_, yp##K); }
template <bool WANTY, bool PROBE = false> __device__ __forceinline__ void scan_chunk(f32x2& S0, f32x2& S1, f32x2& S2, f32x2& S3, const LAS float* p, const LAS float* pv, LAS float* yw, int l7) {
    ScanOp cur, nxt; scan_ld<WANTY, PROBE>(cur, p, pv);
    float ysel = 0.f;
    const bool c3 = (l7 & 4) != 0, c2 = (((l7 >> 1) ^ (l7 >> 2)) & 1) != 0, c1 = ((l7 ^ (l7 >> 2)) & 1) != 0;
#pragma unroll 1
    for (int s4 = 0; s4 < SC_T; s4 += 8) {
        const LAS float* q = p + s4 * SC_VS; const LAS float* qv = pv + s4 * SC_VS;
        if (WANTY) { if (s4 > 0) yw[(s4 - 8) * 32] = ysel; asm volatile("" ::: "memory"); }
        float yp0 = 0.f, yp1 = 0.f, yp2 = 0.f, yp3 = 0.f, yp4 = 0.f, yp5 = 0.f, yp6 = 0.f, yp7 = 0.f, ya0 = 0.f, ya1 = 0.f, yb0 = 0.f;
        SCAN_STEP(cur, nxt, 0, true) SCAN_STEP(nxt, cur, 1, true) if (WANTY) ya0 = scan_ycomb<0xB1>(yp0, yp1, c1);
        SCAN_STEP(cur, nxt, 2, true) SCAN_STEP(nxt, cur, 3, true) if (WANTY) { ya1 = scan_ycomb<0xB1>(yp2, yp3, c1); yb0 = scan_ycomb<0x4E>(ya0, ya1, c2); }
        SCAN_STEP(cur, nxt, 4, true) SCAN_STEP(nxt, cur, 5, true) if (WANTY) ya0 = scan_ycomb<0xB1>(yp4, yp5, c1);
        SCAN_STEP(cur, nxt, 6, true) SCAN_STEP(nxt, cur, 7, s4 + 8 < SC_T)
        if (WANTY) { ya1 = scan_ycomb<0xB1>(yp6, yp7, c1); ysel = scan_ycomb<0x141>(yb0, scan_ycomb<0x4E>(ya0, ya1, c2), c3); }
    }
    if (WANTY) yw[(SC_T - 8) * 32] = ysel;
}
template <bool PROBE = false> __device__ __forceinline__ void ph_scan(const Ctx& c) {
    const bf16* R = (const bf16*)(c.ws + WS_R); const bf16* K = (const bf16*)(c.ws + WS_KK); const bf16* V = (const bf16*)(c.ws + WS_VV);
    bf16* YS = (bf16*)(c.ws + (PROBE ? WS_YE : WS_YS));
    LAS float* ops = (LAS float*)c.lds;
    LAS float* yb = ops + 2 * SC_T * SC_VS;
    const int tid = c.tid, lane = c.lane, wave = c.wave;
    static_assert(SC_NCH * 4 * 1 >= 1, "");
    for (int unit = c.bid; unit < 2 * 2 * NB * RH; unit += c.G) {
        const bool firstunit = unit == c.bid && c.G * 4 * SC_NCH >= NEXP * CV_PER;
        const int chain = unit >> 1, half = unit & 1, dir = chain / (NB * RH), b = (chain / RH) % NB, h = chain % RH;
        const bf16* Wp = (const bf16*)(c.ws + WS_DEC + (size_t)dir * NTOK * D * 4); const bf16* Ap = (const bf16*)(c.ws + WS_AS + (size_t)dir * NTOK * D * 4);
        __syncthreads();
        if (wave >= 4) {
            const int lt = tid - 256, st0 = lt >> 4, c4 = (lt & 15) * 4, col = h * RN + c4;
            const f32x4 kk4 = *(const f32x4*)(inp(c, I_KK) + col), ka4 = *(const f32x4*)(inp(c, I_KA) + col);
            ScanLd A0, A1, B0, B1;
            scan_issue(A0, K, V, R, Wp, Ap, scan_row(st0, dir, b), col); scan_issue(A1, K, V, R, Wp, Ap, scan_row(st0 + 16, dir, b), col);
            scan_issue(B0, K, V, R, Wp, Ap, scan_row(SC_T + st0, dir, b), col); scan_issue(B1, K, V, R, Wp, Ap, scan_row(SC_T + st0 + 16, dir, b), col);
            scan_put(A0, ops + st0 * SC_VS + c4, kk4, ka4); scan_put(A1, ops + (st0 + 16) * SC_VS + c4, kk4, ka4);
            __syncthreads();
            f32x4 cvv[8]; int cvp = -1;
            for (int cix = 0; cix < SC_NCH; ++cix) {
                if (cix + 1 < SC_NCH) { LAS float* dstb = ops + ((cix + 1) & 1) * SC_T * SC_VS; scan_put(B0, dstb + st0 * SC_VS + c4, kk4, ka4); scan_put(B1, dstb + (st0 + 16) * SC_VS + c4, kk4, ka4); }
                if (cvp >= 0) { CvItem cvP; cv_decode(c, NEXP + cvp / CV_PER, cvp % CV_PER, cvP); cv_store(cvP, cvv, lane); }
                if (cix >= 1 && (cix - 1) * SC_T >= CTXL && lt < 256) {
                    const int st = lt >> 3, q4 = (lt & 7) * 4; const int row = scan_row((cix - 1) * SC_T + st, dir, b);
                    const f32x4 yv = *(const LAS f32x4*)(yb + ((cix - 1) & 1) * SC_T * 32 + st * 32 + q4); u32x2 yw; yw.x = pk2(yv.x, yv.y); yw.y = pk2(yv.z, yv.w);
                    *(u32x2*)(YS + (size_t)dir * NLAT * D * 2 + (size_t)row * D + h * RN + half * 32 + q4) = yw; }
                asm volatile("" ::: "memory");
                if (cix + 2 < SC_NCH) { const int s2 = (cix + 2) * SC_T + st0; scan_issue(B0, K, V, R, Wp, Ap, scan_row(s2, dir, b), col); scan_issue(B1, K, V, R, Wp, Ap, scan_row(s2 + 16, dir, b), col); }
                const int cvi = cix * (c.G * 4) + c.bid * 4 + (wave - 4);
                cvp = (firstunit && cvi < NEXP * CV_PER) ? cvi : -1;
                if (cvp >= 0) { CvItem cvT; cv_decode(c, NEXP + cvi / CV_PER, cvi % CV_PER, cvT); cv_load(cvT, cvv, lane); }
                __syncthreads();
            }
            if (cvp >= 0) { CvItem cvP; cv_decode(c, NEXP + cvp / CV_PER, cvp % CV_PER, cvP); cv_store(cvP, cvv, lane); }
            { const int st = lt >> 3, q4 = (lt & 7) * 4; const int row = scan_row((SC_NCH - 1) * SC_T + st, dir, b);
              const f32x4 yv = *(const LAS f32x4*)(yb + ((SC_NCH - 1) & 1) * SC_T * 32 + st * 32 + q4); u32x2 yw; yw.x = pk2(yv.x, yv.y); yw.y = pk2(yv.z, yv.w);
              *(u32x2*)(YS + (size_t)dir * NLAT * D * 2 + (size_t)row * D + h * RN + half * 32 + q4) = yw; }
        } else {
            const int rl = wave * 8 + (lane >> 3), row = half * 32 + rl, c0 = (lane & 7) * 8;
            f32x2 S0 = {0.f, 0.f}, S1 = {0.f, 0.f}, S2 = {0.f, 0.f}, S3 = {0.f, 0.f};
            __syncthreads();
            __builtin_amdgcn_s_setprio(3);
            for (int cix = 0; cix < SC_NCH; ++cix) {
                const LAS float* p = ops + (cix & 1) * SC_T * SC_VS + c0; const LAS float* pv = ops + (cix & 1) * SC_T * SC_VS + row; LAS float* yo = yb + (cix & 1) * SC_T * 32 + rl;
                if (cix * SC_T >= CTXL) scan_chunk<true, PROBE>(S0, S1, S2, S3, p, pv, yo + ((lane & 4) + ((((lane >> 1) ^ (lane >> 2)) & 1) << 1) + ((lane ^ (lane >> 2)) & 1)) * 32, lane & 7); else scan_chunk<false, PROBE>(S0, S1, S2, S3, p, pv, yo, 0);
                __syncthreads();
            }
            __builtin_amdgcn_s_setprio(0);
        }
    }
    if (c.G * 4 * SC_NCH < NEXP * CV_PER) {
        __syncthreads();
        for (int it = c.gw; it < NEXP * CV_PER; it += c.ngw) { CvItem T; f32x4 tv[8]; cv_decode(c, NEXP + it / CV_PER, it % CV_PER, T); cv_load(T, tv, lane); cv_store(T, tv, lane); }
    }
}

__device__ __forceinline__ void ph_readout(const Ctx& c) {
    const bf16* R = (const bf16*)(c.ws + WS_R); const bf16* K = (const bf16*)(c.ws + WS_KK); const bf16* V = (const bf16*)(c.ws + WS_VV);
    const bf16* AS = (const bf16*)(c.ws + WS_AS); const bf16* YS = (const bf16*)(c.ws + WS_YS); const bf16* G = (const bf16*)(c.ws + WS_G); bf16* O = (bf16*)(c.ws + WS_O);
    const float* lnw = inp(c, I_LNW); const float* lnb = inp(c, I_LNB); const float* kap = inp(c, I_KA); const float* rkp = inp(c, I_RK);
    const int lane = c.lane;
    for (int row = c.gw; row < NLAT; row += c.ngw) {
#pragma unroll 2
        for (int ps = 0; ps < 4; ++ps) {
            const int col = ps * 512 + lane * 8; const size_t o = (size_t)row * D + col;
            float y[8], r[8], k[8], v[8], a0[8], a1[8], g[8];
#define LD8(dst, p) do { const f32x4 q0_ = *(const f32x4*)(p), q1_ = *(const f32x4*)((p) + 4); dst[0] = q0_.x; dst[1] = q0_.y; dst[2] = q0_.z; dst[3] = q0_.w; dst[4] = q1_.x; dst[5] = q1_.y; dst[6] = q1_.z; dst[7] = q1_.w; } while (0)
#define LB8(dst, p) do { const u32x4 q_ = *(const u32x4*)(p); dst[0] = bf2f(q_.x & 0xffffu); dst[1] = bf2f(q_.x >> 16); dst[2] = bf2f(q_.y & 0xffffu); dst[3] = bf2f(q_.y >> 16); \
                dst[4] = bf2f(q_.z & 0xffffu); dst[5] = bf2f(q_.z >> 16); dst[6] = bf2f(q_.w & 0xffffu); dst[7] = bf2f(q_.w >> 16); } while (0)
            LB8(y, YS + o); LB8(r, YS + (size_t)NLAT * D * 2 + o);
#pragma unroll
            for (int j = 0; j < 8; ++j) y[j] += r[j];
            LB8(r, R + o); LB8(k, K + o); LB8(v, V + o); LB8(a0, AS + o); LB8(a1, AS + (size_t)NTOK * D * 2 + o); LB8(g, G + o);
#undef LB8
            float lw[8], lb[8], ka[8], rk[8];
            LD8(lw, lnw + col); LD8(lb, lnb + col); LD8(ka, kap + col); LD8(rk, rkp + col);
#undef LD8
            float s1 = 0.f;
#pragma unroll
            for (int j = 0; j < 8; ++j) s1 += y[j];
            const float mu = sum8(s1) * (1.0f / RN);
            float s2 = 0.f, s3 = 0.f;
#pragma unroll
            for (int j = 0; j < 8; ++j) { y[j] -= mu; s2 += y[j] * y[j];
                const float rr = r[j] * rk[j]; s3 += rr * (k[j] * (1.0f + (a0[j] - 1.0f) * ka[j]) + k[j] * (1.0f + (a1[j] - 1.0f) * ka[j])); }
            const float rs = rsqrtf(sum8(s2) * (1.0f / RN) + 64e-5f), bon = sum8(s3);
            float ov[8];
#pragma unroll
            for (int j = 0; j < 8; ++j) ov[j] = (y[j] * rs * lw[j] + lb[j] + bon * v[j]) * g[j];
            u32x4 w; w.x = pk2(ov[0], ov[1]); w.y = pk2(ov[2], ov[3]); w.z = pk2(ov[4], ov[5]); w.w = pk2(ov[6], ov[7]);
            *(u32x4*)(O + o) = w;
        }
    }
}

__device__ __forceinline__ bool launder(Ctx& c, unsigned char* ws) {
    unsigned long long wi = (unsigned long long)ws; asm volatile("" : "+s"(wi)); c.ws = (unsigned char*)(GAS unsigned char*)wi;
    int t = threadIdx.x; asm volatile("" : "+v"(t)); c.tid = t; c.lane = t & 63; c.wave = __builtin_amdgcn_readfirstlane(t >> 6);
    int bx = blockIdx.x; asm volatile("" : "+s"(bx)); c.bid = bx; c.gw = bx * 8 + c.wave; return true; }
constexpr int NPH = 20;
__global__ void __launch_bounds__(512, 2) fwd(Args args) {
    extern __shared__ __attribute__((aligned(16))) unsigned char lds_raw[];
    Ctx c; c.out = args.out; c.ws = args.ws; c.lds = (LAS unsigned char*)lds_raw;
    c.tid = threadIdx.x; c.lane = c.tid & 63; c.wave = __builtin_amdgcn_readfirstlane(c.tid >> 6); c.bid = blockIdx.x; c.G = gridDim.x;
    c.gw = c.bid * 8 + c.wave; c.ngw = c.G * 8;
    volatile LAS unsigned* misc = (volatile LAS unsigned*)(c.lds + LDS_BYTES - 64);
    if (c.tid < 16) misc[c.tid] = 0u;
    if (c.tid < 39) ((LAS unsigned long long*)(c.lds + PTAB_OFF))[c.tid] = (unsigned long long)args.in[c.tid];
    __syncthreads();
    constexpr int lo = 0, hi = (DBG_HI);
    (void)xcd_barrier_post((unsigned*)(c.ws + WS_CTL) + CW_BAR, misc);
#ifdef ONLY_PHASE
#define IN(k) ((k) == ONLY_PHASE && lo <= (k) && (k) < hi && launder(c, args.ws))
#else
#define IN(k) (lo <= (k) && (k) < hi && launder(c, args.ws))
#endif
#define SEAM(k) do { if ((lo <= (k) && (k) + 1 < hi)) { unsigned char* w_ = args.ws; asm volatile("" : "+s"(w_)); XcdBarrier b_; b_.bar = (unsigned*)(w_ + WS_CTL) + CW_BAR; b_.x = xb_xcc_id(); \
        b_.st = (volatile LAS unsigned*)((LAS unsigned char*)lds_raw + LDS_BYTES - 64); xcd_barrier(b_); } } while (0)
    if (IN(0)) { ph_mod(c); } SEAM(0);
    for (int layer = 0; layer < 2; ++layer) {
        if (layer == 0) {
            if (IN(1)) { ph_prenorm0(c); if (DUPQ(1)) ph_prenorm0(c); } SEAM(1);
            if (IN(2)) { for (int rp_ = 0; rp_ < 1 + DUPQ(2); ++rp_) { pg8::PlainSched S{(unsigned)WS_H, (unsigned)WB_WIN, D * 2, D * 2, D / 64, NTOK / 256, AB_IN / 256, c.G, c.bid}; pg8::EpiB16 e{(bf16*)(c.ws + WS_U), AB_IN}; pg8::gemm_phase(c.lds, (const char*)c.ws, S, e); }  if (c.G == 256 && c.bid >= 256 - CVF_F2) conv_fill(c, NEXP * CV_PER - CVF_TOTAL + (c.bid - (256 - CVF_F2)) * CVF_Q, CVF_Q); } SEAM(2);
            if (IN(3)) { ph_prep0(c); if (DUPQ(3)) ph_prep0(c); } SEAM(3);
            if (IN(4)) { ph_attn_pool(c); if (DUPQ(4)) ph_attn_pool(c); } SEAM(4);
            if (IN(5)) { for (int rp_ = 0; rp_ < 1 + DUPQ(5); ++rp_) { pg8::PlainSched S{(unsigned)WS_CAT, (unsigned)WB_WOUT, D * 2, D * 2, D / 64, NTOK / 256, D / 256, c.G, c.bid}; pg8::EpiB16 e{(bf16*)(c.ws + WS_Y), D}; pg8::gemm_phase(c.lds, (const char*)c.ws, S, e); }  if (c.G == 256 && c.bid >= 256 - CVF_F5) conv_fill(c, NEXP * CV_PER - CVF_TOTAL + CVF_F2 * CVF_Q + (c.bid - (256 - CVF_F5)) * CVF_Q, CVF_Q); } SEAM(5);
        } else {
            if (IN(10)) { ph_shiftmix(c); if (DUPQ(10)) ph_shiftmix(c); } SEAM(10);
            if (IN(11)) { ph_rw_gemm1(c); if (DUPQ(11)) ph_rw_gemm1(c); } SEAM(11);
            if (IN(12)) { ph_rw_gemm2(c); if (DUPQ(12)) ph_rw_gemm2(c); } SEAM(12);
            if (IN(13)) { ph_scan<false>(c); if (DUPQ(13)) ph_scan<(DBG_SCANPROBE != 0)>(c); } SEAM(13);
            if (IN(14)) { ph_readout(c); if (DUPQ(14)) ph_readout(c); } SEAM(14);
            if (IN(15)) { for (int rp_ = 0; rp_ < 1 + DUPQ(15); ++rp_) { pg8::PlainSched S{(unsigned)WS_O, (unsigned)WB_WO, D * 2, D * 2, D / 64, NLAT / 256, D / 256, c.G, c.bid}; pg8::EpiB16 e{(bf16*)(c.ws + WS_Y), D}; pg8::gemm_phase(c.lds, (const char*)c.ws, S, e); } } SEAM(15);
        }
        const int p0 = layer ? 16 : 6;
        if (IN(p0)) { ph_rowA(c, layer); } SEAM(p0);
        if (IN(p0 + 1)) { ph_moe_gu(c, layer); if (DUPQ(7)) ph_moe_gu(c, layer); } SEAM(p0 + 1);
        if (IN(p0 + 2)) { ph_moe_down(c, layer); if (DUPQ(8)) ph_moe_down(c, layer); } SEAM(p0 + 2);
        if (IN(p0 + 3)) { ph_rowB(c, layer); } SEAM(p0 + 3);
    }
#undef IN
#undef SEAM
}
}

extern "C" void kernel_launch(void* const* d_in, const int* in_sizes, int n_in, void* d_out, int out_size, void* d_ws, size_t ws_size, hipStream_t stream) {
    static int grid = 0;
    if (grid == 0) {
        if (n_in != 39 || out_size != NLAT * D || ws_size < WS_END3) { fprintf(stderr, "kernel_launch: unexpected shapes: n_in %d out %d ws %zu (need %zu)\n", n_in, out_size, ws_size, (size_t)WS_END3); grid = -1; return; }
        int dev = 0, cus = 0;
        if (hipGetDevice(&dev) != hipSuccess || hipDeviceGetAttribute(&cus, hipDeviceAttributeMultiprocessorCount, dev) != hipSuccess) { grid = -1; return; }
        if (hipFuncSetAttribute((const void*)fwd, hipFuncAttributeMaxDynamicSharedMemorySize, LDS_BYTES) != hipSuccess) { fprintf(stderr, "kernel_launch: hipFuncSetAttribute failed\n"); grid = -1; return; }
        int per_cu = 0;
        if (hipOccupancyMaxActiveBlocksPerMultiprocessor(&per_cu, (const void*)fwd, 512, LDS_BYTES) != hipSuccess || per_cu < 1) fprintf(stderr, "kernel_launch: occupancy query says %d\n", per_cu);
        (void)hipGetLastError();
        grid = cus;
    }
    if (grid < 0) return;
    (void)hipMemsetAsync((char*)d_ws + WS_CTL, 0, CTL_BYTES, stream);
    Args a{};
    for (int i = 0; i < 39; ++i) a.in[i] = (const float*)d_in[i];
    a.out = (float*)d_out; a.ws = (unsigned char*)d_ws;
    a.ph_lo = 0; a.ph_hi = NPH;
    hipLaunchKernelGGL(fwd, dim3(grid), dim3(512), LDS_BYTES, stream, a);
}
```

```cpp
#include <hip/hip_runtime.h>
#include <cstdio>
#include <cstdint>

#ifndef DBG_HI
#define DBG_HI NPH
#endif
#ifndef MOE_FP8
#define MOE_FP8 1
#endif
#ifndef DBG_SCANPROBE
#define DBG_SCANPROBE 0
#endif
#ifndef DBG_DUP
#define DBG_DUP 0
#endif
#define DUPQ(k) ((DBG_DUP >> (k)) & 1)
#ifndef DBG_REP0
#define DBG_REP0 1
#endif
#ifndef DBG_SMALL
#define DBG_SMALL 13568
#endif
#ifndef DBG_W2
#define DBG_W2 0
#endif
#ifndef DBG_MOE
#define DBG_MOE 0
#endif
#ifndef FAST_RKV
#define FAST_RKV 0
#endif
namespace {
constexpr int D = 2048, NB = 2, SEQ = 4096, CTXL = 256;
constexpr int NLAT = NB * SEQ, NCTX = NB * CTXL, NTOK = NLAT + NCTX;
constexpr int KVLEN = SEQ + CTXL;
constexpr int NHEAD = 8, NKVH = 2, HD = 128, ATTN_W = 1024, KV_W = 256, POOL_W = 1024, AB_IN = 2560;
constexpr int NEXP = 32, TOPK = 4, DEXP = 1024;
constexpr int RH = 32, RN = 64;
constexpr int LORA = 96, GLORA = 256;
constexpr int NSLOT = NTOK * TOPK + NEXP * 256;
constexpr int LISTCAP = NTOK;
constexpr int NPHASE = 21;

constexpr size_t al256(size_t x) { return (x + 255) / 256 * 256; }
constexpr size_t WS_CTL = 0, CTL_BYTES = 1u << 20;
constexpr int CW_BAR = 4096;
constexpr int CW_CNT = 16384;
constexpr size_t WS_MOD = CTL_BYTES;
constexpr size_t WS_ROPE = WS_MOD + al256((size_t)2 * 3 * 6 * D * 4);
constexpr size_t WS_SELE = WS_ROPE + al256(2 * 64 * 32 * 4);
constexpr size_t WS_SELP = WS_SELE + al256((size_t)NTOK * 4 * 4);
constexpr size_t WS_LIST = WS_SELP + al256((size_t)NTOK * 4 * 4);
constexpr size_t WS_LISTG = WS_LIST + al256((size_t)NEXP * LISTCAP * 4);
constexpr size_t WS_X = WS_LISTG + al256((size_t)NEXP * LISTCAP * 4);
constexpr size_t WS_Y = WS_X + (size_t)NTOK * D * 4;
constexpr size_t WS_F = WS_Y + (size_t)NTOK * D * 4;
constexpr size_t WS_ACT = WS_F + (size_t)NTOK * D * 2;
constexpr size_t WS_YE = WS_ACT + (size_t)NSLOT * DEXP * 2;
constexpr size_t WB_WIN = WS_YE + (size_t)NSLOT * D * 2;
constexpr size_t WB_WOUT = WB_WIN + (size_t)AB_IN * D * 2;
constexpr size_t WB_WR = WB_WOUT + (size_t)D * D * 2;
constexpr size_t WB_WK = WB_WR + (size_t)D * D * 2;
constexpr size_t WB_WV = WB_WK + (size_t)D * D * 2;
constexpr size_t WB_WO = WB_WV + (size_t)D * D * 2;
constexpr size_t WB_POOL = WB_WO + (size_t)D * D * 2;
constexpr size_t WB_W1 = WB_POOL + (size_t)4 * 256 * 256 * 2;
constexpr size_t WB_A1 = WB_W1 + (size_t)256 * D * 2;
constexpr size_t WB_G1 = WB_A1 + (size_t)256 * D * 2;
constexpr size_t WB_W2 = WB_G1 + (size_t)256 * D * 2;
constexpr size_t WB_A2 = WB_W2 + (size_t)2 * D * 256 * 2;
constexpr size_t WB_G2 = WB_A2 + (size_t)2 * D * 256 * 2;
constexpr size_t WB_GU = WB_G2 + (size_t)D * 256 * 2;
constexpr size_t WB_DN = WB_GU + (size_t)2 * NEXP * 2 * DEXP * D * 2;
constexpr size_t WS_L = WB_DN + (size_t)2 * NEXP * D * DEXP * 2;
constexpr size_t WS_H = WS_L;
constexpr size_t WS_U = WS_H + (size_t)NTOK * D * 2;
constexpr size_t WS_Q = WS_U + (size_t)NTOK * AB_IN * 2;
constexpr size_t WS_K = WS_Q + (size_t)NTOK * ATTN_W * 2;
constexpr size_t WS_V = WS_K + (size_t)NB * KVLEN * KV_W * 2;
constexpr size_t WS_MP = WS_V + (size_t)NB * KVLEN * KV_W * 2;
constexpr size_t WS_CAT = WS_MP + (size_t)NTOK * POOL_W * 2;
constexpr size_t WS_L0END = WS_CAT + (size_t)NTOK * D * 2;
constexpr size_t WS_XS = WS_L;
constexpr size_t WS_DEC = WS_L;
constexpr size_t WS_AS = WS_DEC + (size_t)2 * NTOK * D * 4;
constexpr size_t WS_H1 = WS_AS + (size_t)2 * NTOK * D * 4;
constexpr size_t WS_G = WS_H1;
constexpr size_t WS_R = WS_H1 + (size_t)NTOK * D * 4;
constexpr size_t WS_KK = WS_R + (size_t)NTOK * D * 4;
constexpr size_t WS_VV = WS_KK + (size_t)NTOK * D * 4;
constexpr size_t WS_LW = WS_VV + (size_t)NTOK * D * 4;
constexpr size_t WS_LA = WS_LW + (size_t)NTOK * 256 * 2;
constexpr size_t WS_LG = WS_LA + (size_t)NTOK * 256 * 2;
constexpr size_t WS_YS = WS_LG + (size_t)NTOK * 256 * 2;
constexpr size_t WS_O = WS_YS + (size_t)2 * NLAT * D * 4;
constexpr size_t WS_L1END = WS_O + (size_t)NLAT * D * 2;
constexpr size_t WS_END2 = WS_L1END > WS_L0END ? WS_L1END : WS_L0END;
static_assert((size_t)6 * NTOK * D * 2 <= (size_t)4 * NTOK * D * 4, "XS fits under DEC|AS");
constexpr size_t WB_RT = al256(WS_END2);
constexpr size_t WS_END3 = WB_RT + (size_t)2 * 2 * NEXP * D * 2;
static_assert(WS_END3 <= 2147483648ull, "workspace fits the guaranteed 2 GiB and 32-bit offsets");

constexpr bool MOE8 = (MOE_FP8 != 0);
constexpr float MOE8_SW1 = 64.f, MOE8_SW2 = 32.f, MOE8_SACT = 4.f;
constexpr int LDS_BYTES = 147456;

typedef unsigned short bf16;
typedef float f32x4 __attribute__((ext_vector_type(4)));
typedef unsigned u32x2 __attribute__((ext_vector_type(2)));
typedef unsigned u32x4 __attribute__((ext_vector_type(4)));
#define LAS __attribute__((address_space(3)))
#define GAS __attribute__((address_space(1)))

__device__ __forceinline__ float bf2f(unsigned v) { return __uint_as_float(v << 16); }
__device__ __forceinline__ unsigned f2bf(float f) { unsigned u = __float_as_uint(f); return (u + 0x7fffu + ((u >> 16) & 1u)) >> 16; }
__device__ __forceinline__ unsigned pk2(float lo, float hi) { return f2bf(lo) | (f2bf(hi) << 16); }
__device__ __forceinline__ unsigned pk4_fp8(float a, float b, float cc, float d) {
    int w = __builtin_amdgcn_cvt_pk_fp8_f32(a, b, 0, false); w = __builtin_amdgcn_cvt_pk_fp8_f32(cc, d, w, true); return (unsigned)w; }
__device__ __forceinline__ int lane_now() { int t = threadIdx.x; asm volatile("" : "+v"(t)); return t & 63; }
__device__ __forceinline__ float shx(float v, int mask) { return __builtin_bit_cast(float, __builtin_amdgcn_ds_bpermute((lane_now() ^ mask) << 2, __builtin_bit_cast(int, v))); }
__device__ __forceinline__ int shi(int v, int src) { return __builtin_amdgcn_ds_bpermute(src << 2, v); }
typedef float f32x2 __attribute__((ext_vector_type(2)));
__device__ __forceinline__ float dpp_add(float v, float u) { return v + u; }
template <int CTRL> __device__ __forceinline__ float dpp_mov(float v) { return __builtin_bit_cast(float, __builtin_amdgcn_update_dpp(0, __builtin_bit_cast(int, v), CTRL, 0xF, 0xF, true)); }
__device__ __forceinline__ float sum8(float v) { v += dpp_mov<0xB1>(v); v += dpp_mov<0x4E>(v); v += dpp_mov<0x141>(v); return v; }
__device__ __forceinline__ float sum16(float v) { v = sum8(v); v += dpp_mov<0x140>(v); return v; }
__device__ __forceinline__ float rl_f(float v, int l) { return __builtin_bit_cast(float, __builtin_amdgcn_readlane(__builtin_bit_cast(int, v), l)); }
__device__ __forceinline__ float wsum(float v) { v = sum16(v); return (rl_f(v, 0) + rl_f(v, 16)) + (rl_f(v, 32) + rl_f(v, 48)); }
__device__ __forceinline__ float wmax(float v) {
    v = fmaxf(v, dpp_mov<0xB1>(v)); v = fmaxf(v, dpp_mov<0x4E>(v)); v = fmaxf(v, dpp_mov<0x141>(v)); v = fmaxf(v, dpp_mov<0x140>(v));
    return fmaxf(fmaxf(rl_f(v, 0), rl_f(v, 16)), fmaxf(rl_f(v, 32), rl_f(v, 48))); }
__device__ __forceinline__ float sigmoidf_(float x) { return __builtin_amdgcn_rcpf(1.0f + __expf(-x)); }

#define XB_TMO      128
#define XB_XCNT(j)  (256  + 64 * (j))
#define XB_XSUB(j)  (1280 + 64 * (j))
#define XB_XGEN(j)  (2304 + 64 * (j))
#define XB_TOP      3328
#define XB_TOPGEN   3392
#define XCD_BAR_WORDS 3456
#define XB_SPIN_CAP (1u << 18)
__device__ __forceinline__ unsigned xb_ld(unsigned* p)              { return __hip_atomic_load(p, __ATOMIC_RELAXED, __HIP_MEMORY_SCOPE_AGENT); }
__device__ __forceinline__ unsigned xb_add(unsigned* p, unsigned v) { return __hip_atomic_fetch_add(p, v, __ATOMIC_RELAXED, __HIP_MEMORY_SCOPE_AGENT); }
__device__ __forceinline__ unsigned xb_xcc_id() { return (unsigned)__builtin_amdgcn_s_getreg((3 << 11) | 20) & 0xFu; }
#define XB_SPIN(cond, bar) do { unsigned _sp = 0; while (cond) { __builtin_amdgcn_s_sleep(1); \
    if ((++_sp & 255u) == 0u) { if (xb_ld(&(bar)[XB_TMO])) break; if (_sp > XB_SPIN_CAP) { atomicAdd(&(bar)[XB_TMO], 1u); break; } } } } while (0)
struct XcdBarrier { unsigned* bar; unsigned x; volatile LAS unsigned* st; };
__device__ __forceinline__ XcdBarrier xcd_barrier_post(unsigned* bar, volatile LAS unsigned* st) {
    XcdBarrier b; b.bar = bar; b.x = xb_xcc_id(); b.st = st;
    if (threadIdx.x == 0) (void)xb_add(&bar[XB_XCNT(b.x)], 1u);
    return b;
}
__device__ __forceinline__ void xcd_barrier_complete(unsigned* bar, unsigned x, unsigned& nloc, unsigned& nx) {
    const unsigned G = gridDim.x * gridDim.y * gridDim.z;
    unsigned sum, cnt, mine, sp = 0u;
    for (;;) {
        sum = 0u; cnt = 0u; mine = 0u;
#pragma unroll
        for (unsigned j = 0; j < 16; ++j) { const unsigned c = xb_ld(&bar[XB_XCNT(j)]); sum += c; cnt += (c > 0u) ? 1u : 0u; mine = (j == x) ? c : mine; }
        if (sum == G) break;
        __builtin_amdgcn_s_sleep(1);
        if ((++sp & 255u) == 0u) { if (xb_ld(&bar[XB_TMO])) break; if (sp > XB_SPIN_CAP) { atomicAdd(&bar[XB_TMO], 1u); break; } }
    }
    nloc = mine > 0u ? mine : 1u; nx = cnt > 0u ? cnt : 1u;
}
__device__ __forceinline__ void xcd_barrier(const XcdBarrier& b) {
    asm volatile("s_waitcnt vmcnt(0)" ::: "memory");
    __syncthreads();
    if (threadIdx.x == 0) {
        unsigned* bar = b.bar; asm volatile("" : "+s"(bar));
        __builtin_amdgcn_s_waitcnt(0);
        unsigned nloc = b.st[0], nx = b.st[1];
        if (nloc == 0u) { xcd_barrier_complete(bar, b.x, nloc, nx); b.st[0] = nloc; b.st[1] = nx; }
        const unsigned old = xb_add(&bar[XB_XSUB(b.x)], 1u);
        const unsigned gen = old / nloc;
        if (old + 1u == (gen + 1u) * nloc) {
            __builtin_amdgcn_fence(__ATOMIC_RELEASE, "agent");
            asm volatile("s_waitcnt vmcnt(0)" ::: "memory");
            const unsigned og = xb_add(&bar[XB_TOP], 1u);
            const unsigned tg = og / nx;
            if (og + 1u == (tg + 1u) * nx) xb_add(&bar[XB_TOPGEN], 1u);
            else XB_SPIN(xb_ld(&bar[XB_TOPGEN]) == tg, bar);
            __builtin_amdgcn_fence(__ATOMIC_ACQUIRE, "agent");
            xb_add(&bar[XB_XGEN(b.x)], 1u);
            asm volatile("s_waitcnt vmcnt(0)" ::: "memory");
        } else {
            XB_SPIN(xb_ld(&bar[XB_XGEN(b.x)]) == gen, bar);
            __builtin_amdgcn_fence(__ATOMIC_ACQUIRE, "agent");
            asm volatile("s_waitcnt vmcnt(0)" ::: "memory");
        }
    }
    __syncthreads();
}

struct Args { const float* in[39]; float* out; unsigned char* ws; int ph_lo, ph_hi; };
enum { I_X = 0, I_C, I_CTX, I_CCTX, I_WMOD, I_BMOD, I_NORMG, I_WIN, I_QGAIN, I_KGAIN, I_POOLW, I_POOLS, I_WOUT, I_MIX, I_WR, I_WK, I_WV, I_WO,
       I_W0, I_W1, I_W2, I_A0, I_A1, I_A2, I_G1, I_G2, I_KK, I_KA, I_RK, I_LNW, I_LNB, I_ROUTW, I_ROUTB, I_WGATE, I_BGATE, I_WUP, I_BUP, I_WDOWN, I_BDOWN };

struct Ctx {
    float* out; unsigned char* ws; LAS unsigned char* lds; int tid, lane, wave, gw, ngw, bid, G;
};
#if defined(__HIP_DEVICE_COMPILE__)
#define ASSUME_GLOBAL(p) do { __builtin_assume(!__builtin_amdgcn_is_shared((const void*)(p))); __builtin_assume(!__builtin_amdgcn_is_private((const void*)(p))); } while (0)
#else
#define ASSUME_GLOBAL(p) do { } while (0)
#endif
constexpr int PTAB_OFF = LDS_BYTES - 1024;
__device__ __forceinline__ const float* inp(const Ctx& c, int i) {
    const LAS unsigned* t = (const LAS unsigned*)(c.lds + PTAB_OFF) + 2 * i;
    const unsigned lo = __builtin_amdgcn_readfirstlane(t[0]), hi = __builtin_amdgcn_readfirstlane(t[1]);
    return (const float*)(const GAS float*)(((unsigned long long)hi << 32) | lo);
}
__device__ __forceinline__ const float* modp(const Ctx& c, int layer, int who, int part) { return (const float*)(c.ws + WS_MOD) + ((size_t)(layer * 3 + who) * 6 + part) * D; }
struct RowInfo { int b, t, n, who, seq0; };
__device__ __forceinline__ RowInfo rowinfo(int row) {
    RowInfo r;
    if (row < NLAT) { r.b = row / SEQ; r.t = row % SEQ; r.n = SEQ; r.who = r.b; r.seq0 = r.b * SEQ; }
    else { const int rc = row - NLAT; r.b = rc / CTXL; r.t = rc % CTXL; r.n = CTXL; r.who = 2; r.seq0 = NLAT + r.b * CTXL; }
    return r;
}

struct GemmS { const bf16* A; int lda; const int* gather; int M; const float* B; int ldb; int N; int K; };
template <class Epi>
__device__ __forceinline__ void sgemm_unit(const Ctx& c, const GemmS& g, int m0, int n0, const Epi& epi) {
    LAS float* As = (LAS float*)c.lds;
    LAS float* Bs = As + 16 * 132;
    const int tid = c.tid, ty = tid >> 5, tx = tid & 31;
    float acc[8][4];
#pragma unroll
    for (int i = 0; i < 8; ++i)
#pragma unroll
        for (int j = 0; j < 4; ++j) acc[i][j] = 0.f;
    const int ar = tid >> 2, akq = (tid & 3) * 4;
    const int arow_l = m0 + ar;
    long arow = -1;
    if (arow_l < g.M) arow = g.gather ? (long)g.gather[arow_l] : (long)arow_l;
    const int bk = tid >> 5, bn = (tid & 31) * 4;
    const bool bok = (n0 + bn) < g.N;
    for (int k0 = 0; k0 < g.K; k0 += 16) {
        u32x2 av = (u32x2){0u, 0u};
        if (arow >= 0) av = *(const u32x2*)(g.A + arow * g.lda + k0 + akq);
        f32x4 bv = (f32x4){0.f, 0.f, 0.f, 0.f};
        if (bok) bv = *(const f32x4*)(g.B + (size_t)(k0 + bk) * g.ldb + n0 + bn);
        __syncthreads();
        As[(akq + 0) * 132 + ar] = bf2f(av.x & 0xffffu); As[(akq + 1) * 132 + ar] = bf2f(av.x >> 16);
        As[(akq + 2) * 132 + ar] = bf2f(av.y & 0xffffu); As[(akq + 3) * 132 + ar] = bf2f(av.y >> 16);
        *(LAS f32x4*)(Bs + bk * 128 + bn) = bv;
        __syncthreads();
#pragma unroll
        for (int k = 0; k < 16; ++k) {
            const f32x4 a0 = *(const LAS f32x4*)(As + k * 132 + ty * 8), a1 = *(const LAS f32x4*)(As + k * 132 + ty * 8 + 4);
            const f32x4 b = *(const LAS f32x4*)(Bs + k * 128 + tx * 4);
            const float a[8] = {a0.x, a0.y, a0.z, a0.w, a1.x, a1.y, a1.z, a1.w};
#pragma unroll
            for (int i = 0; i < 8; ++i) { acc[i][0] += a[i] * b.x; acc[i][1] += a[i] * b.y; acc[i][2] += a[i] * b.z; acc[i][3] += a[i] * b.w; }
        }
    }
#pragma unroll
    for (int i = 0; i < 8; ++i) {
        const int r = m0 + ty * 8 + i;
        if (r < g.M) {
#pragma unroll
            for (int j = 0; j < 4; ++j) { const int cc = n0 + tx * 4 + j; if (cc < g.N) epi(r, cc, acc[i][j]); }
        }
    }
}
template <class Epi>
__device__ __forceinline__ void sgemm_all(const Ctx& c, const GemmS& g, const Epi& epi, int u0, int ustride) {
    const int nM = (g.M + 127) / 128, nN = (g.N + 127) / 128;
    for (int u = u0; u < nM * nN; u += ustride) sgemm_unit(c, g, (u / nN) * 128, (u % nN) * 128, epi);
}

struct EpiStoreBf16 { bf16* C; int ldc; __device__ __forceinline__ void operator()(int r, int cc, float v) const { C[(size_t)r * ldc + cc] = (bf16)f2bf(v); } };
struct EpiStoreF32 { float* C; int ldc; __device__ __forceinline__ void operator()(int r, int cc, float v) const { C[(size_t)r * ldc + cc] = v; } };
struct EpiPool { bf16* C; const float* scale; __device__ __forceinline__ void operator()(int r, int cc, float v) const { C[(size_t)r * D + cc] = (bf16)f2bf(v * scale[cc]); } };
struct EpiTanhBf16 { bf16* C; int ldc; __device__ __forceinline__ void operator()(int r, int cc, float v) const { C[(size_t)r * ldc + cc] = (bf16)f2bf(tanhf(v)); } };
struct EpiSigBf16 { bf16* C; int ldc; __device__ __forceinline__ void operator()(int r, int cc, float v) const { C[(size_t)r * ldc + cc] = (bf16)f2bf(sigmoidf_(v)); } };
struct EpiDecay { float* C; const float* w0; __device__ __forceinline__ void operator()(int r, int cc, float v) const {
    const float z = -(w0[cc] + v);
    const float sp = (z > 20.f) ? z : log1pf(__expf(z));
    C[(size_t)r * D + cc] = __expf(-__expf(-sp - 0.5f)); } };
struct EpiSigBias { float* C; const float* a0; __device__ __forceinline__ void operator()(int r, int cc, float v) const { C[(size_t)r * D + cc] = sigmoidf_(a0[cc] + v); } };
struct EpiGateTmp { float* GT; const float* bias; int slot0; __device__ __forceinline__ void operator()(int r, int cc, float v) const { GT[(size_t)(slot0 + r) * DEXP + cc] = v + bias[cc]; } };
struct EpiUpAct { const float* GT; bf16* ACT; const float* bias; int slot0; __device__ __forceinline__ void operator()(int r, int cc, float v) const {
    const float glu = fminf(GT[(size_t)(slot0 + r) * DEXP + cc], 7.0f);
    const float lin = fminf(fmaxf(v + bias[cc], -7.0f), 7.0f);
    ACT[(size_t)(slot0 + r) * DEXP + cc] = (bf16)f2bf(glu * sigmoidf_(1.702f * glu) * (lin + 1.0f)); } };
struct EpiDown { bf16* YE; const float* bias; const float* gate; int slot0; __device__ __forceinline__ void operator()(int r, int cc, float v) const {
    YE[(size_t)(slot0 + r) * D + cc] = (bf16)f2bf((v + bias[cc]) * gate[r]); } };


namespace pg8 {
#define PG8_LAS __attribute__((address_space(3)))
typedef short bf16x8 __attribute__((ext_vector_type(8)));
constexpr int BM = 256, BK = 64, HALF = 128, HTB = HALF * BK * 2, STAGE_BYTES = 8 * HTB, NXCD = 8, WGM = 8;
__host__ __device__ __forceinline__ int lds_byte(int r, int c) { const int st = (r >> 4) * 2 + (c >> 5), rr = r & 15, cc = c & 31, ob = rr * 64 + cc * 2; return st * 1024 + (ob ^ (((ob >> 9) & 1) << 5)); }
__host__ __device__ __forceinline__ void stage_rc(int b, int& R, int& C) { const int st = b / 1024, sb = b % 1024, swz = sb ^ (((sb >> 9) & 1) << 5); R = (st >> 1) * 16 + swz / 64; C = (st & 1) * 32 + (swz % 64) / 2; }
__host__ __device__ __forceinline__ int perm32(int rho) { const int n = rho >> 4, i = rho & 15; return 8 * (i >> 2) + 4 * n + (i & 3); }
__device__ __forceinline__ unsigned cvt_pk_bf16(float lo, float hi) { unsigned r; asm volatile("v_cvt_pk_bf16_f32 %0, %1, %2" : "=v"(r) : "v"(lo), "v"(hi)); return r; }

struct UnitD {
    unsigned A;
    unsigned B;
    unsigned gather;
    int lda2, ldb2;
    int nt;
    int row0, col0;
    int nvalid;
    int aux, aux2;
};
__device__ __forceinline__ bool static_tile(int nM, int nN, int G, int c, int i, int& pm, int& pn) {
    const int nwg = nM * nN; const long L = (long)i * G + c; if (L >= nwg) return false;
    int wgid = (int)L; { const int q = nwg / NXCD, r = nwg % NXCD, xcd = wgid % NXCD, off = wgid / NXCD; wgid = (xcd < r ? xcd * (q + 1) : r * (q + 1) + (xcd - r) * q) + off; }
    const int nig = WGM * nN, gid = wgid / nig, fm = gid * WGM, gsz = (nM - fm) < WGM ? (nM - fm) : WGM;
    pm = fm + ((wgid % nig) % gsz); pn = (wgid % nig) / gsz; return true;
}
typedef int v8i32 __attribute__((ext_vector_type(8)));
template <bool F8, bool GATHER, class Epi, class Sched>
__device__ __forceinline__ void gemm_phase_t(PG8_LAS unsigned char* lds, const char* wsb, const Sched& S, const Epi& E) {
    int tid = threadIdx.x; asm volatile("" : "+v"(tid));
    const int wid = __builtin_amdgcn_readfirstlane(tid >> 6), lane = tid & 63, wr = wid >> 2, wc = wid & 3, fr = lane & 15, fq = lane >> 4;
#define PG8_RC(tv) int R0, C0, R1, C1; stage_rc((tv) * 16, R0, C0); stage_rc((tv) * 16 + 8192, R1, C1); const int Rb0 = (R0 & ~31) + perm32(R0 & 31), Rb1 = (R1 & ~31) + perm32(R1 & 31)
    const unsigned kstep = (unsigned)(BK * 2);
    const unsigned ldsw = (unsigned)wid * 1024u;
    const int aoff = F8 ? lds_byte(wr * 64 + fr, fq * 16) : lds_byte(wr * 64 + fr, fq * 8), boff = F8 ? lds_byte(wc * 32 + fr, fq * 16) : lds_byte(wc * 32 + fr, fq * 8);
#define PG8_SA(b, h) (((b) * 2 + (h)) * HTB)
#define PG8_SB(b, h) ((4 + (b) * 2 + (h)) * HTB)
#define PG8_STAGE(bufoff, gbase, v0, v1) do { \
        __builtin_amdgcn_global_load_lds((const unsigned*)(wsb + (size_t)(unsigned)((gbase) + (v0))), (PG8_LAS unsigned*)(lds + (bufoff) + ldsw), 16, 0, 0); \
        __builtin_amdgcn_global_load_lds((const unsigned*)(wsb + (size_t)(unsigned)((gbase) + (v1))), (PG8_LAS unsigned*)(lds + (bufoff) + ldsw + 8192), 16, 0, 0); } while (0)
#define PG8_LD8(addr_) ({ const u32x4 l_ = *(const PG8_LAS u32x4*)(addr_), h_ = *(const PG8_LAS u32x4*)((addr_) + 16); (v8i32){(int)l_.x, (int)l_.y, (int)l_.z, (int)l_.w, (int)h_.x, (int)h_.y, (int)h_.z, (int)h_.w}; })
#define PG8_LDA(dst, b, h) do { if constexpr (F8) { _Pragma("unroll") for (int m = 0; m < 4; ++m) dst##8[m] = PG8_LD8(lds + PG8_SA(b, h) + aoff + m * 2048); } \
        else { _Pragma("unroll") for (int m = 0; m < 4; ++m) _Pragma("unroll") for (int k = 0; k < 2; ++k) dst[m][k] = *(const PG8_LAS bf16x8*)(lds + PG8_SA(b, h) + aoff + m * 2048 + k * 1024); } } while (0)
#define PG8_LDB(dst, b, h) do { if constexpr (F8) { _Pragma("unroll") for (int n = 0; n < 2; ++n) dst##8[n] = PG8_LD8(lds + PG8_SB(b, h) + boff + n * 2048); } \
        else { _Pragma("unroll") for (int n = 0; n < 2; ++n) _Pragma("unroll") for (int k = 0; k < 2; ++k) dst[n][k] = *(const PG8_LAS bf16x8*)(lds + PG8_SB(b, h) + boff + n * 2048 + k * 1024); } } while (0)
#define PG8_MMA(ai, bj, At, Bt) do { __builtin_amdgcn_s_setprio(1); _Pragma("unroll") for (int m = 0; m < 4; ++m) _Pragma("unroll") for (int n = 0; n < 2; ++n) { \
        if constexpr (F8) { acc[ai][bj][m][n] = __builtin_amdgcn_mfma_scale_f32_16x16x128_f8f6f4(Bt##8[n], At##8[m], acc[ai][bj][m][n], 0, 0, 0, 0x7f7f7f7f, 0, 0x7f7f7f7f); } \
        else { _Pragma("unroll") for (int k = 0; k < 2; ++k) acc[ai][bj][m][n] = __builtin_amdgcn_mfma_f32_16x16x32_bf16(Bt[n][k], At[m][k], acc[ai][bj][m][n], 0, 0, 0); } } \
        __builtin_amdgcn_s_setprio(0); } while (0)
#define PG8_WAIT_V(n) asm volatile("s_waitcnt vmcnt(" #n ")" ::: "memory")
#define PG8_WAIT_L(n) asm volatile("s_waitcnt lgkmcnt(" #n ")" ::: "memory")
#define PG8_BAR __builtin_amdgcn_s_barrier()
#define PG8_SCHED __builtin_amdgcn_sched_barrier(0)
#define PG8_RFL(x) x = __builtin_amdgcn_readfirstlane(x)
#define PG8_OPAQUE(u) do { PG8_RFL((u).A); PG8_RFL((u).B); PG8_RFL((u).gather); PG8_RFL((u).lda2); PG8_RFL((u).ldb2); PG8_RFL((u).nt); PG8_RFL((u).row0); PG8_RFL((u).col0); PG8_RFL((u).nvalid); PG8_RFL((u).aux); PG8_RFL((u).aux2); \
        asm volatile("" : "+s"((u).A), "+s"((u).B), "+s"((u).gather), "+s"((u).lda2), "+s"((u).ldb2), "+s"((u).nt)); \
        asm volatile("" : "+s"((u).row0), "+s"((u).col0), "+s"((u).nvalid), "+s"((u).aux), "+s"((u).aux2)); } while (0)
#define PG8_SETV(u, vA00, vA01, vA10, vA11, vB0, vB1) do { \
        int r00 = R0, r01 = R1, r10 = R0 + HALF, r11 = R1 + HALF; \
        if (GATHER && (u).gather) { const int* gp_ = (const int*)(wsb + (u).gather); r00 = gp_[r00]; r01 = gp_[r01]; r10 = gp_[r10]; r11 = gp_[r11]; \
            r00 = (unsigned)r00 < (unsigned)NTOK ? r00 : 0; r01 = (unsigned)r01 < (unsigned)NTOK ? r01 : 0; r10 = (unsigned)r10 < (unsigned)NTOK ? r10 : 0; r11 = (unsigned)r11 < (unsigned)NTOK ? r11 : 0; } \
        vA00 = (unsigned)(r00 * (u).lda2 + C0 * 2); vA01 = (unsigned)(r01 * (u).lda2 + C1 * 2); vA10 = (unsigned)(r10 * (u).lda2 + C0 * 2); vA11 = (unsigned)(r11 * (u).lda2 + C1 * 2); \
        vB0 = (unsigned)(Rb0 * (u).ldb2 + C0 * 2); vB1 = (unsigned)(Rb1 * (u).ldb2 + C1 * 2); } while (0)
    UnitD cur, nxt; int ui = 0;
    if (!S.next(0, cur)) return;
    PG8_OPAQUE(cur);
    f32x4 acc[2][2][4][2];
#pragma unroll
    for (int a = 0; a < 2; ++a)
#pragma unroll
        for (int b = 0; b < 2; ++b)
#pragma unroll
            for (int m = 0; m < 4; ++m)
#pragma unroll
                for (int n = 0; n < 2; ++n) acc[a][b][m][n] = (f32x4){0.f, 0.f, 0.f, 0.f};
    bf16x8 At[F8 ? 1 : 4][2], B0[F8 ? 1 : 2][2], B1[F8 ? 1 : 2][2];
    v8i32 At8[F8 ? 4 : 1], B08[F8 ? 2 : 1], B18[F8 ? 2 : 1];
    (void)At; (void)B0; (void)B1; (void)At8; (void)B08; (void)B18;
    unsigned vA00, vA01, vA10, vA11, vB0, vB1;
    { PG8_RC(tid); PG8_SETV(cur, vA00, vA01, vA10, vA11, vB0, vB1); }
    unsigned cA = cur.A, cB = cur.B, chB = (unsigned)HALF * cur.ldb2;
    PG8_STAGE(PG8_SB(0, 0), cB, vB0, vB1); PG8_STAGE(PG8_SB(0, 1), cB + chB, vB0, vB1); PG8_STAGE(PG8_SA(0, 0), cA, vA00, vA01); PG8_STAGE(PG8_SA(0, 1), cA, vA10, vA11);
    if (wr == 1) PG8_BAR;
    PG8_WAIT_V(2); PG8_BAR;
    PG8_STAGE(PG8_SB(1, 0), cB + kstep, vB0, vB1); PG8_STAGE(PG8_SA(1, 0), cA + kstep, vA00, vA01); PG8_STAGE(PG8_SB(1, 1), cB + chB + kstep, vB0, vB1);
    PG8_WAIT_V(6); PG8_BAR;
    for (;;) {
        bool has_next = S.next(ui + 1, nxt);
        if (!has_next) { nxt = cur; }
        PG8_OPAQUE(nxt);
        { int hn = __builtin_amdgcn_readfirstlane(has_next ? 1 : 0); asm volatile("" : "+s"(hn)); has_next = hn != 0; }
        const int nt = cur.nt;
        const unsigned nAp = has_next ? nxt.A : cA, nBp = has_next ? nxt.B : cB, nhB = has_next ? (unsigned)HALF * nxt.ldb2 : chB;
        for (int t = 0; t < nt; t += 2) {
            const bool last = (t == nt - 2);
            const unsigned a1 = cA + (unsigned)(t + 1) * kstep;
            const unsigned a2 = last ? nAp : cA + (unsigned)(t + 2) * kstep, b2 = last ? nBp : cB + (unsigned)(t + 2) * kstep, hb2 = last ? nhB : chB;
            const unsigned a3 = a2 + kstep, b3 = b2 + kstep;
            int g00 = 0, g01 = 0, g10 = 0, g11 = 0;
            const bool sw = last && has_next;
            if (GATHER && sw && nxt.gather) {
                int t2 = threadIdx.x; asm volatile("" : "+v"(t2)); PG8_RC(t2); (void)Rb0; (void)Rb1; (void)C0; (void)C1;
                const int* gp_ = (const int*)(wsb + nxt.gather); const int o0 = R0 * 4, o1 = R1 * 4, o2 = (R0 + HALF) * 4, o3 = (R1 + HALF) * 4;
                asm volatile("global_load_dword %0, %1, %2" : "=v"(g00) : "v"(o0), "s"(gp_) : "memory");
                asm volatile("global_load_dword %0, %1, %2" : "=v"(g01) : "v"(o1), "s"(gp_) : "memory");
                asm volatile("global_load_dword %0, %1, %2" : "=v"(g10) : "v"(o2), "s"(gp_) : "memory");
                asm volatile("global_load_dword %0, %1, %2" : "=v"(g11) : "v"(o3), "s"(gp_) : "memory"); }
            PG8_LDB(B0, 0, 0); PG8_LDB(B1, 0, 1); PG8_SCHED; PG8_LDA(At, 0, 0); PG8_STAGE(PG8_SA(1, 1), a1, vA10, vA11);
            PG8_WAIT_V(8); PG8_WAIT_L(0); PG8_BAR; PG8_MMA(0, 0, At, B0); PG8_MMA(0, 1, At, B1); PG8_BAR; PG8_SCHED;
            if (sw) {
                int t3 = threadIdx.x; asm volatile("" : "+v"(t3)); PG8_RC(t3);
                if (!GATHER || !nxt.gather) { g00 = R0; g01 = R1; g10 = R0 + HALF; g11 = R1 + HALF; }
                else { asm volatile("s_waitcnt vmcnt(2)" : "+v"(g00), "+v"(g01), "+v"(g10), "+v"(g11) :: "memory");
                    g00 = (unsigned)g00 < (unsigned)NTOK ? g00 : 0; g01 = (unsigned)g01 < (unsigned)NTOK ? g01 : 0; g10 = (unsigned)g10 < (unsigned)NTOK ? g10 : 0; g11 = (unsigned)g11 < (unsigned)NTOK ? g11 : 0; }
                vA00 = (unsigned)(g00 * nxt.lda2 + C0 * 2); vA01 = (unsigned)(g01 * nxt.lda2 + C1 * 2); vA10 = (unsigned)(g10 * nxt.lda2 + C0 * 2); vA11 = (unsigned)(g11 * nxt.lda2 + C1 * 2);
                vB0 = (unsigned)(Rb0 * nxt.ldb2 + C0 * 2); vB1 = (unsigned)(Rb1 * nxt.ldb2 + C1 * 2); }
            PG8_LDA(At, 0, 1); PG8_STAGE(PG8_SB(0, 0), b2, vB0, vB1); PG8_STAGE(PG8_SB(0, 1), b2 + hb2, vB0, vB1); PG8_STAGE(PG8_SA(0, 0), a2, vA00, vA01);
            PG8_WAIT_V(8); PG8_WAIT_L(0); PG8_BAR; PG8_MMA(1, 0, At, B0); PG8_MMA(1, 1, At, B1); PG8_BAR; PG8_SCHED;
            PG8_LDB(B0, 1, 0); PG8_LDB(B1, 1, 1); PG8_SCHED; PG8_LDA(At, 1, 0); PG8_STAGE(PG8_SA(0, 1), a2, vA10, vA11);
            PG8_WAIT_V(8); PG8_WAIT_L(0); PG8_BAR; PG8_MMA(0, 0, At, B0); PG8_MMA(0, 1, At, B1); PG8_BAR; PG8_SCHED;
            PG8_LDA(At, 1, 1); PG8_STAGE(PG8_SB(1, 0), b3, vB0, vB1); PG8_STAGE(PG8_SB(1, 1), b3 + hb2, vB0, vB1); PG8_STAGE(PG8_SA(1, 0), a3, vA00, vA01);
            PG8_WAIT_V(8); PG8_WAIT_L(0); PG8_BAR; PG8_MMA(1, 0, At, B0); PG8_MMA(1, 1, At, B1); PG8_BAR; PG8_SCHED;
        }
        if (wr == 0) PG8_BAR;
        { int fr_ = fr, fq_ = fq; asm volatile("" : "+v"(fr_), "+v"(fq_));
          E(acc, cur, wr, wc, fr_, fq_); }
        if (!has_next) break;
#pragma unroll
        for (int a = 0; a < 2; ++a)
#pragma unroll
            for (int b = 0; b < 2; ++b)
#pragma unroll
                for (int m = 0; m < 4; ++m)
#pragma unroll
                    for (int n = 0; n < 2; ++n) acc[a][b][m][n] = (f32x4){0.f, 0.f, 0.f, 0.f};
        cur = nxt; cA = nAp; cB = nBp; chB = nhB; ++ui;
        if (wr == 1) PG8_BAR;
    }
    PG8_WAIT_V(0);
    PG8_BAR;
#undef PG8_SA
#undef PG8_SB
#undef PG8_STAGE
#undef PG8_LDA
#undef PG8_LDB
#undef PG8_MMA
#undef PG8_LD8
#undef PG8_WAIT_V
#undef PG8_WAIT_L
#undef PG8_BAR
#undef PG8_SCHED
#undef PG8_SETV
#undef PG8_RC
#undef PG8_OPAQUE
#undef PG8_RFL
}
template <class Epi, class Sched> __device__ __forceinline__ void gemm_phase(PG8_LAS unsigned char* lds, const char* wsb, const Sched& S, const Epi& E) { gemm_phase_t<false, false>(lds, wsb, S, E); }
struct PlainSched {
    unsigned A, B; int lda2, ldb2, nt, nM, nN, G, c;
    __device__ __forceinline__ bool next(int i, UnitD& u) const {
        int pm, pn; if (!static_tile(nM, nN, G, c, i, pm, pn)) return false;
        u.A = A + (unsigned)(pm * BM * lda2); u.B = B + (unsigned)(pn * BM * ldb2); u.gather = 0u; u.lda2 = lda2; u.ldb2 = ldb2; u.nt = nt; u.row0 = pm * BM; u.col0 = pn * BM; u.nvalid = BM; u.aux = 0; u.aux2 = 0; return true; }
};
struct EpiF32 { float* C; int ldc;
    __device__ __forceinline__ void operator()(const f32x4 (&acc)[2][2][4][2], const UnitD& u, int wr, int wc, int fr, int fq) const {
#pragma unroll
        for (int ai = 0; ai < 2; ++ai)
#pragma unroll
            for (int m = 0; m < 4; ++m) { const int r = ai * HALF + wr * 64 + m * 16 + fr; float* rowp = C + (size_t)(u.row0 + r) * ldc + u.col0 + wc * 32 + 8 * fq;
                if (r < u.nvalid) {
#pragma unroll
                    for (int bj = 0; bj < 2; ++bj) { *(f32x4*)(rowp + bj * HALF) = acc[ai][bj][m][0]; *(f32x4*)(rowp + bj * HALF + 4) = acc[ai][bj][m][1]; } } }
    }
};
struct EpiB16 { bf16* C; int ldc;
    __device__ __forceinline__ void operator()(const f32x4 (&acc)[2][2][4][2], const UnitD& u, int wr, int wc, int fr, int fq) const {
#pragma unroll
        for (int ai = 0; ai < 2; ++ai)
#pragma unroll
            for (int m = 0; m < 4; ++m) { const int r = ai * HALF + wr * 64 + m * 16 + fr; bf16* rowp = C + (size_t)(u.row0 + r) * ldc + u.col0 + wc * 32 + 8 * fq;
                if (r < u.nvalid) {
#pragma unroll
                    for (int bj = 0; bj < 2; ++bj) { const f32x4 v0 = acc[ai][bj][m][0], v1 = acc[ai][bj][m][1];
                        u32x4 w; w.x = cvt_pk_bf16(v0[0], v0[1]); w.y = cvt_pk_bf16(v0[2], v0[3]); w.z = cvt_pk_bf16(v1[0], v1[1]); w.w = cvt_pk_bf16(v1[2], v1[3]);
                        *(u32x4*)(rowp + bj * HALF) = w; } } }
    }
};
template <int NJ> struct JobSched {
    unsigned A[NJ], B[NJ]; int nM[NJ], nN[NJ], lda2[NJ], ldb2[NJ], nt[NJ]; int G, c;
    template <int J> __device__ __forceinline__ bool nextj(int L, UnitD& u) const {
        if constexpr (J >= NJ) { return false; }
        else { const int nw = nM[J] * nN[J];
            if (L < nw) { const int pm = L / nN[J], pn = L % nN[J];
                u.A = A[J] + (unsigned)(pm * BM * lda2[J]); u.B = B[J] + (unsigned)(pn * BM * ldb2[J]); u.gather = 0u; u.lda2 = lda2[J]; u.ldb2 = ldb2[J]; u.nt = nt[J];
                u.row0 = pm * BM; u.col0 = pn * BM; u.nvalid = BM; u.aux = J; u.aux2 = 0; return true; }
            return nextj<J + 1>(L - nw, u); } }
    __device__ __forceinline__ bool next(int i, UnitD& u) const { return nextj<0>(i * G + ((G & 7) == 0 ? (c & 7) * (G >> 3) + (c >> 3) : c), u); }
};
template <int NJ> struct EpiF32J { float* C[NJ]; int ldc;
    __device__ __forceinline__ void operator()(const f32x4 (&acc)[2][2][4][2], const UnitD& u, int wr, int wc, int fr, int fq) const {
        float* Cb = C[0];
#pragma unroll
        for (int j = 1; j < NJ; ++j) if (u.aux == j) Cb = C[j];
        EpiF32 e{Cb, ldc}; e(acc, u, wr, wc, fr, fq); }
};

struct MoeSched {
    const PG8_LAS int* tb; int G, c, NP; bool gu;
    unsigned wB; int layer;
    __device__ __forceinline__ bool next(int i, UnitD& u) const {
        const int L = i * G + ((G & 7) == 0 ? (c & 7) * (G >> 3) + (c >> 3) : c), tix = L / NP, pn = L % NP;
        if (tix >= tb[96]) return false;
        int e = 0;
        for (int q = 1; q < NEXP; ++q) if (tb[64 + q] <= tix) e = q;
        e = __builtin_amdgcn_readfirstlane(e);
        const int mt = tix - __builtin_amdgcn_readfirstlane(tb[64 + e]), cnt = __builtin_amdgcn_readfirstlane(tb[e]), base = __builtin_amdgcn_readfirstlane(tb[32 + e]);
        u.nvalid = cnt - mt * BM < BM ? cnt - mt * BM : BM; u.row0 = base + mt * BM; u.aux = e; u.aux2 = mt * BM;
        constexpr int EB = MOE8 ? 1 : 2;
        if (gu) { u.A = (unsigned)WS_F; u.gather = (unsigned)(WS_LIST + ((size_t)e * LISTCAP + (size_t)mt * BM) * 4); u.lda2 = D * EB; u.ldb2 = D * EB; u.nt = D * EB / 128;
                  u.B = wB + (unsigned)e * (unsigned)(2 * DEXP * D * EB) + (unsigned)pn * (unsigned)(BM * D * EB); u.col0 = pn * 128; }
        else { u.A = (unsigned)(WS_ACT + (size_t)(base + mt * BM) * DEXP * EB); u.gather = 0u; u.lda2 = DEXP * EB; u.ldb2 = DEXP * EB; u.nt = DEXP * EB / 128;
               u.B = wB + (unsigned)e * (unsigned)(D * DEXP * EB) + (unsigned)pn * (unsigned)(BM * DEXP * EB); u.col0 = pn * BM; }
        return true; }
};
__device__ __forceinline__ void st8_bf16(bf16* p, const f32x4& v0, const f32x4& v1) { u32x4 w; w.x = cvt_pk_bf16(v0[0], v0[1]); w.y = cvt_pk_bf16(v0[2], v0[3]); w.z = cvt_pk_bf16(v1[0], v1[1]); w.w = cvt_pk_bf16(v1[2], v1[3]); *(u32x4*)p = w; }
__device__ __forceinline__ float sigm(float x) { return __builtin_amdgcn_rcpf(1.0f + __expf(-x)); }
__device__ __forceinline__ float rate1(float x) { return 0.60653066f * sigm(x); }
struct EpiPoolS { bf16* CAT; const float* scale;
    __device__ __forceinline__ void operator()(const f32x4 (&acc)[2][2][4][2], const UnitD& u, int wr, int wc, int fr, int fq) const {
        const int cb = u.aux * 256 + wc * 32 + 8 * fq;
        f32x4 sv[2][2];
#pragma unroll
        for (int bj = 0; bj < 2; ++bj) { sv[bj][0] = *(const f32x4*)(scale + cb + bj * HALF); sv[bj][1] = *(const f32x4*)(scale + cb + bj * HALF + 4); }
#pragma unroll
        for (int ai = 0; ai < 2; ++ai)
#pragma unroll
            for (int m = 0; m < 4; ++m) { const int r = ai * HALF + wr * 64 + m * 16 + fr; bf16* rowp = CAT + (size_t)(u.row0 + r) * D + ATTN_W + cb;
#pragma unroll
                for (int bj = 0; bj < 2; ++bj) st8_bf16(rowp + bj * HALF, acc[ai][bj][m][0] * sv[bj][0], acc[ai][bj][m][1] * sv[bj][1]); }
    }
};
struct EpiSwiglu { bf16* ACT; const float* bg; const float* bu;
    __device__ __forceinline__ void operator()(const f32x4 (&acc)[2][2][4][2], const UnitD& u, int wr, int wc, int fr, int fq) const {
        const int cb = u.col0 + wc * 32 + 8 * fq; const float* pg = bg + u.aux * DEXP + cb; const float* pu = bu + u.aux * DEXP + cb;
        f32x4 g0 = *(const f32x4*)pg, g1 = *(const f32x4*)(pg + 4), u0 = *(const f32x4*)pu, u1 = *(const f32x4*)(pu + 4);
        asm volatile("" : "+v"(g0), "+v"(g1), "+v"(u0), "+v"(u1));
#pragma unroll
        for (int ai = 0; ai < 2; ++ai)
#pragma unroll
            for (int m = 0; m < 4; ++m) { const int r = ai * HALF + wr * 64 + m * 16 + fr;
                constexpr float dq = MOE8 ? 1.0f / MOE8_SW1 : 1.0f;
                f32x4 a0 = acc[ai][0][m][0] * dq + g0, a1 = acc[ai][0][m][1] * dq + g1, l0 = acc[ai][1][m][0] * dq + u0, l1 = acc[ai][1][m][1] * dq + u1;
#pragma unroll
                for (int j = 0; j < 4; ++j) { const float x0 = fminf(a0[j], 7.0f), x1 = fminf(a1[j], 7.0f); const float y0 = fminf(fmaxf(l0[j], -7.0f), 7.0f), y1 = fminf(fmaxf(l1[j], -7.0f), 7.0f);
                    a0[j] = x0 * sigm(1.702f * x0) * (y0 + 1.0f); a1[j] = x1 * sigm(1.702f * x1) * (y1 + 1.0f); }
                if (r < u.nvalid) {
                    if constexpr (MOE8) { u32x2 w8; w8.x = pk4_fp8(a0[0] * MOE8_SACT, a0[1] * MOE8_SACT, a0[2] * MOE8_SACT, a0[3] * MOE8_SACT); w8.y = pk4_fp8(a1[0] * MOE8_SACT, a1[1] * MOE8_SACT, a1[2] * MOE8_SACT, a1[3] * MOE8_SACT);
                        *(u32x2*)((unsigned char*)ACT + (size_t)(u.row0 + r) * DEXP + cb) = w8; }
                    else st8_bf16(ACT + (size_t)(u.row0 + r) * DEXP + cb, a0, a1); } }
    }
};
struct EpiDownF { bf16* YE; const float* bd; const float* listg;
    __device__ __forceinline__ void operator()(const f32x4 (&acc)[2][2][4][2], const UnitD& u, int wr, int wc, int fr, int fq) const {
        const int cb = u.col0 + wc * 32 + 8 * fq; const float* pb = bd + u.aux * D + cb; const float* gl = listg + (size_t)u.aux * LISTCAP + u.aux2;
        f32x4 bv[2][2];
#pragma unroll
        for (int bj = 0; bj < 2; ++bj) { bv[bj][0] = *(const f32x4*)(pb + bj * HALF); bv[bj][1] = *(const f32x4*)(pb + bj * HALF + 4); }
        float gts[2][4];
#pragma unroll
        for (int ai = 0; ai < 2; ++ai)
#pragma unroll
            for (int m = 0; m < 4; ++m) { const int r = ai * HALF + wr * 64 + m * 16 + fr; gts[ai][m] = r < u.nvalid ? gl[r] : 0.f; }
        asm volatile("" : "+v"(gts[0][0]), "+v"(gts[0][1]), "+v"(gts[0][2]), "+v"(gts[0][3]), "+v"(gts[1][0]), "+v"(gts[1][1]), "+v"(gts[1][2]), "+v"(gts[1][3]), "+v"(bv[0][0]), "+v"(bv[0][1]), "+v"(bv[1][0]), "+v"(bv[1][1]));
#pragma unroll
        for (int ai = 0; ai < 2; ++ai)
#pragma unroll
            for (int m = 0; m < 4; ++m) { const int r = ai * HALF + wr * 64 + m * 16 + fr;
                if (r < u.nvalid) { const float gt = gts[ai][m]; bf16* rowp = YE + (size_t)(u.row0 + r) * D + cb;
#pragma unroll
                    for (int bj = 0; bj < 2; ++bj) { constexpr float dq = MOE8 ? 1.0f / (MOE8_SW2 * MOE8_SACT) : 1.0f;
                        st8_bf16(rowp + bj * HALF, (acc[ai][bj][m][0] * dq + bv[bj][0]) * gt, (acc[ai][bj][m][1] * dq + bv[bj][1]) * gt); } } }
    }
};
struct EpiRw1 { float* C0; bf16* L0;
    __device__ __forceinline__ void operator()(const f32x4 (&acc)[2][2][4][2], const UnitD& u, int wr, int wc, int fr, int fq) const {
        if (u.aux < 3) { EpiB16 e{(bf16*)(C0 + (size_t)u.aux * NTOK * D), D}; e(acc, u, wr, wc, fr, fq); return; }
        bf16* Lb = L0 + (size_t)(u.aux - 3) * NTOK * 256; const int mode = u.aux;
#pragma unroll
        for (int ai = 0; ai < 2; ++ai)
#pragma unroll
            for (int m = 0; m < 4; ++m) { const int r = ai * HALF + wr * 64 + m * 16 + fr; bf16* rowp = Lb + (size_t)(u.row0 + r) * 256 + u.col0 + wc * 32 + 8 * fq;
#pragma unroll
                for (int bj = 0; bj < 2; ++bj) { f32x4 v0 = acc[ai][bj][m][0], v1 = acc[ai][bj][m][1];
                    if (mode == 3) {
#pragma unroll
                        for (int j = 0; j < 4; ++j) { v0[j] = 1.0f - 2.0f * __builtin_amdgcn_rcpf(__expf(2.0f * v0[j]) + 1.0f); v1[j] = 1.0f - 2.0f * __builtin_amdgcn_rcpf(__expf(2.0f * v1[j]) + 1.0f); } }
                    else if (mode == 5) {
#pragma unroll
                        for (int j = 0; j < 4; ++j) { v0[j] = sigm(v0[j]); v1[j] = sigm(v1[j]); } }
                    st8_bf16(rowp + bj * HALF, v0, v1); } }
    }
};
struct EpiRw2 { float* DEC; float* AS; float* G; const float* w0; const float* a0;
    __device__ __forceinline__ void operator()(const f32x4 (&acc)[2][2][4][2], const UnitD& u, int wr, int wc, int fr, int fq) const {
        if (u.aux == 2) { EpiB16 e{(bf16*)G, D}; e(acc, u, wr, wc, fr, fq); return; }
        const int d = u.col0 >> 11, cb = (u.col0 & 2047) + wc * 32 + 8 * fq; const bool dec = u.aux == 0;
        bf16* Cb = (bf16*)((dec ? DEC : AS) + (size_t)d * NTOK * D); const float* bp = (dec ? w0 : a0) + d * D + cb;
        f32x4 bv[2][2];
#pragma unroll
        for (int bj = 0; bj < 2; ++bj) { bv[bj][0] = *(const f32x4*)(bp + bj * HALF); bv[bj][1] = *(const f32x4*)(bp + bj * HALF + 4); }
#pragma unroll
        for (int ai = 0; ai < 2; ++ai)
#pragma unroll
            for (int m = 0; m < 4; ++m) { const int r = ai * HALF + wr * 64 + m * 16 + fr; bf16* rowp = Cb + (size_t)(u.row0 + r) * D + cb;
#pragma unroll
                for (int bj = 0; bj < 2; ++bj) { f32x4 v0 = acc[ai][bj][m][0] + bv[bj][0], v1 = acc[ai][bj][m][1] + bv[bj][1];
                    if (dec) { v0 = (f32x4){rate1(v0.x), rate1(v0.y), rate1(v0.z), rate1(v0.w)}; v1 = (f32x4){rate1(v1.x), rate1(v1.y), rate1(v1.z), rate1(v1.w)}; }
                    else { v0 = (f32x4){sigm(v0.x), sigm(v0.y), sigm(v0.z), sigm(v0.w)}; v1 = (f32x4){sigm(v1.x), sigm(v1.y), sigm(v1.z), sigm(v1.w)}; }
                    st8_bf16(rowp + bj * HALF, v0, v1); } }
    }
};
}

__device__ __forceinline__ void transpose_item(const float* W, int N, bf16* WT, int ldt, int k0, int n0, int drow0, int dk0, LAS float* scr, int lane) {
    float tv[32];
#pragma unroll
    for (int i = 0; i < 32; ++i) { const int kk = 2 * i + (lane >> 5); tv[i] = W[(size_t)(k0 + kk) * N + n0 + (lane & 31)]; }
#pragma unroll
    for (int i = 0; i < 32; ++i) { const int kk = 2 * i + (lane >> 5); scr[kk * 33 + (lane & 31)] = tv[i]; }
    asm volatile("s_waitcnt lgkmcnt(0)" ::: "memory");
    const int cch = lane & 7;
#pragma unroll
    for (int j = 0; j < 4; ++j) { const int n = (lane >> 3) + 8 * j; const LAS float* sp = scr + (8 * cch) * 33 + n;
        u32x4 o; o.x = pk2(sp[0 * 33], sp[1 * 33]); o.y = pk2(sp[2 * 33], sp[3 * 33]); o.z = pk2(sp[4 * 33], sp[5 * 33]); o.w = pk2(sp[6 * 33], sp[7 * 33]);
        *(u32x4*)(WT + (size_t)(drow0 + n) * ldt + dk0 + k0 + 8 * cch) = o; }
    asm volatile("s_waitcnt lgkmcnt(0)" ::: "memory");
}

constexpr int CV_GATE = (D / 64) * (DEXP / 32), CV_DOWN = (DEXP / 64) * (D / 32), CV_PER = 2 * CV_GATE + CV_DOWN;
struct CvItem { const float* W; unsigned char* WT; int N, ldt, k0, n0, drow0, esz; float scale; };
__device__ __forceinline__ void cv_decode(const Ctx& c, int le, int r, CvItem& T) {
    T.esz = MOE8 ? 1 : 2;
    if (r < 2 * CV_GATE) { const int up = r / CV_GATE; r %= CV_GATE; const int nb = DEXP / 32, n0 = (r % nb) * 32;
        T.W = (up ? inp(c, I_WUP) : inp(c, I_WGATE)) + (size_t)le * D * DEXP; T.N = DEXP; T.WT = c.ws + WB_GU + (size_t)le * 2 * DEXP * D * T.esz; T.ldt = D; T.k0 = (r / nb) * 64; T.n0 = n0; T.drow0 = (n0 / 128) * 256 + up * 128 + (n0 % 128); T.scale = MOE8 ? MOE8_SW1 : 1.f; }
    else { r -= 2 * CV_GATE; const int nb = D / 32;
        T.W = inp(c, I_WDOWN) + (size_t)le * DEXP * D; T.N = D; T.WT = c.ws + WB_DN + (size_t)le * D * DEXP * T.esz; T.ldt = DEXP; T.k0 = (r / nb) * 64; T.n0 = (r % nb) * 32; T.drow0 = T.n0; T.scale = MOE8 ? MOE8_SW2 : 1.f; }
}
__device__ __forceinline__ void cv_load(const CvItem& T, f32x4 (&tv)[8], int lane) {
    const float* p = T.W + (size_t)(T.k0 + 8 * (lane >> 3)) * T.N + T.n0 + 4 * (lane & 7);
#pragma unroll
    for (int i = 0; i < 8; ++i) tv[i] = *(const f32x4*)(p + (size_t)i * T.N);
}
__device__ __forceinline__ void cv_store(const CvItem& T, const f32x4 (&tv)[8], int lane) {
    const size_t eo = (size_t)(T.drow0 + 4 * (lane & 7)) * T.ldt + T.k0 + 8 * (lane >> 3);
#pragma unroll
    for (int j = 0; j < 4; ++j) {
        if (T.esz == 2) { u32x4 o; o.x = pk2(tv[0][j], tv[1][j]); o.y = pk2(tv[2][j], tv[3][j]); o.z = pk2(tv[4][j], tv[5][j]); o.w = pk2(tv[6][j], tv[7][j]);
            *(u32x4*)(T.WT + (eo + (size_t)j * T.ldt) * 2) = o; }
        else { const float sc = T.scale; u32x2 o; o.x = pk4_fp8(tv[0][j] * sc, tv[1][j] * sc, tv[2][j] * sc, tv[3][j] * sc); o.y = pk4_fp8(tv[4][j] * sc, tv[5][j] * sc, tv[6][j] * sc, tv[7][j] * sc);
            *(u32x2*)(T.WT + eo + (size_t)j * T.ldt) = o; } }
}
constexpr int CVF_Q = 48, CVF_F2 = 256 - (NTOK / 256 * (AB_IN / 256) - 256), CVF_F5 = 256 - (NTOK / 256 * (D / 256) - 256);
constexpr int CVF_TOTAL = (CVF_F2 + CVF_F5) * CVF_Q;
__device__ __forceinline__ void conv_fill(const Ctx& c, int first, int count) {
    __syncthreads();
    LAS float* scr = (LAS float*)(c.lds + c.wave * 8448);
    int k = c.wave;
    if (k < count) {
        CvItem cur; f32x4 tv[8]; cv_decode(c, (first + k) / CV_PER, (first + k) % CV_PER, cur); cv_load(cur, tv, c.lane);
        for (; k < count; k += 8) {
            CvItem nxt = cur; f32x4 tn[8]; const bool more = k + 8 < count;
            if (more) { cv_decode(c, (first + k + 8) / CV_PER, (first + k + 8) % CV_PER, nxt); cv_load(nxt, tn, c.lane); }
            cv_store(cur, tv, c.lane);
            if (more) { cur = nxt;
#pragma unroll
                for (int i = 0; i < 8; ++i) tv[i] = tn[i]; }
        }
    }
    __syncthreads();
}

__device__ __forceinline__ void ph_mod(const Ctx& c) {
    LAS float* s = (LAS float*)c.lds;
    LAS float* red = s + 3 * D;
    for (int i = c.tid; i < 3 * D; i += 512) { const int who = i / D, k = i % D; const float v = who < 2 ? inp(c, I_C)[who * D + k] : inp(c, I_CCTX)[k]; s[i] = v / (1.0f + __expf(-v)); }
    __syncthreads();
    const int kq = c.tid >> 5, c4 = (c.tid & 31) * 4;
    LAS float* red2 = red;
    for (int u = c.bid; u < 2 * (6 * D / 128); u += c.G) {
        const int layer = u / (6 * D / 128), col0 = (u % (6 * D / 128)) * 128;
        const float* w = inp(c, I_WMOD) + (size_t)layer * D * 6 * D + col0 + c4;
        f32x4 a0 = {0.f, 0.f, 0.f, 0.f}, a1 = a0, a2 = a0;
#pragma unroll 8
        for (int k = kq * 128; k < kq * 128 + 128; ++k) { const f32x4 wv = *(const f32x4*)(w + (size_t)k * 6 * D); a0 += wv * s[k]; a1 += wv * s[D + k]; a2 += wv * s[2 * D + k]; }
        *(LAS f32x4*)(red2 + (kq * 3 + 0) * 128 + c4) = a0; *(LAS f32x4*)(red2 + (kq * 3 + 1) * 128 + c4) = a1; *(LAS f32x4*)(red2 + (kq * 3 + 2) * 128 + c4) = a2;
        __syncthreads();
        if (c.tid < 384) { const int who = c.tid / 128, cc = c.tid % 128; float t = 0.f;
            for (int q = 0; q < 16; ++q) t += red2[(q * 3 + who) * 128 + cc];
            const int colg = col0 + cc;
            ((float*)(c.ws + WS_MOD))[((size_t)(layer * 3 + who) * 6) * D + colg] = t + inp(c, I_BMOD)[layer * 6 * D + colg]; }
        __syncthreads();
    }
    {
        __syncthreads();
        LAS float* scr = (LAS float*)(c.lds + c.wave * 8448);
        constexpr int N_WINI = (D / 64) * (AB_IN / 32), N_SQ = (D / 64) * (D / 32), N_POOL = 4 * (256 / 64) * (256 / 32), N_L1 = 2 * (D / 64) * 3, N_G1 = (D / 64) * (GLORA / 32), N_G2 = (GLORA / 64) * (D / 32);
        constexpr int N_SMALL = N_WINI + 5 * N_SQ + N_POOL + 2 * N_L1 + N_G1 + N_G2;
        constexpr int N_GATE = (D / 64) * (DEXP / 32), N_DOWN = (DEXP / 64) * (D / 32);
        constexpr int N_MOE = NEXP * (2 * N_GATE + N_DOWN);
        const int N_ALL = N_SMALL + N_MOE - (c.G == 256 ? CVF_TOTAL : 0);
#define TDEC(it_, T_) do { int r = (it_); T_.esz = 2; T_.scale = 1.f; \
            if (r >= N_SMALL) { r -= N_SMALL; cv_decode(c, r / CV_PER, r % CV_PER, T_); } \
            else if (r < N_WINI) { const int nb = AB_IN / 32; T_.W = inp(c, I_WIN); T_.N = AB_IN; T_.WT = c.ws + WB_WIN; T_.ldt = D; T_.k0 = (r / nb) * 64; T_.n0 = (r % nb) * 32; T_.drow0 = T_.n0; } \
            else if (r < N_WINI + 5 * N_SQ) { r -= N_WINI; const int which = r / N_SQ; r %= N_SQ; const int nb = D / 32; \
                T_.W = which == 0 ? inp(c, I_WOUT) : which == 1 ? inp(c, I_WR) : which == 2 ? inp(c, I_WK) : which == 3 ? inp(c, I_WV) : inp(c, I_WO); \
                T_.WT = c.ws + (which == 0 ? WB_WOUT : which == 1 ? WB_WR : which == 2 ? WB_WK : which == 3 ? WB_WV : WB_WO); T_.N = D; T_.ldt = D; T_.k0 = (r / nb) * 64; T_.n0 = (r % nb) * 32; T_.drow0 = T_.n0; } \
            else if (r < N_WINI + 5 * N_SQ + N_POOL) { r -= N_WINI + 5 * N_SQ; const int g = r / 32; r %= 32; \
                T_.W = inp(c, I_POOLW) + (size_t)g * 65536; T_.N = 256; T_.WT = c.ws + WB_POOL + (size_t)g * 65536 * 2; T_.ldt = 256; T_.k0 = (r / 8) * 64; T_.n0 = (r % 8) * 32; T_.drow0 = T_.n0; } \
            else if (r < N_WINI + 5 * N_SQ + N_POOL + 2 * N_L1) { r -= N_WINI + 5 * N_SQ + N_POOL; const int isa = r / N_L1; r %= N_L1; const int d = r / (N_L1 / 2); r %= (N_L1 / 2); \
                T_.W = (isa ? inp(c, I_A1) : inp(c, I_W1)) + (size_t)d * D * LORA; T_.N = LORA; T_.WT = c.ws + (isa ? WB_A1 : WB_W1); T_.ldt = D; T_.k0 = (r / 3) * 64; T_.n0 = (r % 3) * 32; T_.drow0 = d * 128 + (r % 3) * 32; } \
            else if (r < N_WINI + 5 * N_SQ + N_POOL + 2 * N_L1 + N_G1) { r -= N_WINI + 5 * N_SQ + N_POOL + 2 * N_L1; \
                T_.W = inp(c, I_G1); T_.N = GLORA; T_.WT = c.ws + WB_G1; T_.ldt = D; T_.k0 = (r / 8) * 64; T_.n0 = (r % 8) * 32; T_.drow0 = T_.n0; } \
            else { r -= N_WINI + 5 * N_SQ + N_POOL + 2 * N_L1 + N_G1; const int nb = D / 32; \
                T_.W = inp(c, I_G2); T_.N = D; T_.WT = c.ws + WB_G2; T_.ldt = GLORA; T_.k0 = (r / nb) * 64; T_.n0 = (r % nb) * 32; T_.drow0 = T_.n0; } } while (0)
        for (int rep = 0; rep < DBG_REP0; ++rep) {
        int it = c.gw;
        if (it < N_ALL) {
            CvItem cur; f32x4 tv[8]; TDEC(it, cur); cv_load(cur, tv, c.lane);
            for (; it < N_ALL; it += c.ngw) {
                CvItem nxt = cur; f32x4 tn[8]; const bool more = it + c.ngw < N_ALL;
                if (more) { TDEC(it + c.ngw, nxt); cv_load(nxt, tn, c.lane); }
                cv_store(cur, tv, c.lane);
                if (more) { cur = nxt;
#pragma unroll
                    for (int i = 0; i < 8; ++i) tv[i] = tn[i]; }
            }
        }
        }
#undef TDEC
        {
            const int gt0 = c.bid * 512 + c.tid, ngt0 = c.G * 512;
            for (int i = gt0; i < 2 * NEXP * (D / 8); i += ngt0) {
                const int ch = i & 255, e = (i >> 8) & 31, l = i >> 13; const float* src = inp(c, I_ROUTW) + (size_t)l * D * NEXP + (size_t)(ch * 8) * NEXP + e;
                float h[8], lo[8];
#pragma unroll
                for (int j = 0; j < 8; ++j) { const float w = src[(size_t)j * NEXP]; h[j] = bf2f(f2bf(w)); lo[j] = w - h[j]; }
                u32x4 oh, ol; oh.x = pk2(h[0], h[1]); oh.y = pk2(h[2], h[3]); oh.z = pk2(h[4], h[5]); oh.w = pk2(h[6], h[7]);
                ol.x = pk2(lo[0], lo[1]); ol.y = pk2(lo[2], lo[3]); ol.z = pk2(lo[4], lo[5]); ol.w = pk2(lo[6], lo[7]);
                bf16* dst = (bf16*)(c.ws + WB_RT) + ((size_t)(l * 2) * NEXP + e) * D + ch * 8;
                *(u32x4*)dst = oh; *(u32x4*)(dst + (size_t)NEXP * D) = ol;
            }
        }
        const int gt = c.bid * 512 + c.tid, ngt = c.G * 512;
        for (int i = gt; i < 2 * 2 * D * 32; i += ngt) {
            const int ch = i & 31, n = (i >> 5) & (D - 1), d = (i >> 16) & 1, isa = i >> 17;
            const float* src = (isa ? inp(c, I_A2) : inp(c, I_W2)) + (size_t)d * LORA * D + n;
            float v[8];
#pragma unroll
            for (int j = 0; j < 8; ++j) { const int kk = ch * 8 + j - d * 128; v[j] = (kk >= 0 && kk < LORA) ? src[(size_t)kk * D] : 0.f; }
            u32x4 o; o.x = pk2(v[0], v[1]); o.y = pk2(v[2], v[3]); o.z = pk2(v[4], v[5]); o.w = pk2(v[6], v[7]);
            *(u32x4*)((bf16*)(c.ws + (isa ? WB_A2 : WB_W2)) + ((size_t)d * D + n) * 256 + ch * 8) = o;
        }
        for (int i = gt; i < 2 * 2 * 32 * (D / 8); i += ngt) {
            const int ch = i & 255, rr = (i >> 8) & 31, d = (i >> 13) & 1, isa = i >> 14;
            *(u32x4*)((bf16*)(c.ws + (isa ? WB_A1 : WB_W1)) + (size_t)(d * 128 + 96 + rr) * D + ch * 8) = (u32x4){0u, 0u, 0u, 0u};
        }
    }
    if (c.bid == 0 && c.tid < 32) {
        const int d = c.tid; double inv = 1.0; for (int i = 0; i < d; ++i) inv *= 0.7498942093324559;
        double sn = 0.0, cs = 0.0, term = 1.0;
        for (int n = 0; n < 24; ++n) { if ((n & 1) == 0) cs += ((n & 2) ? -term : term); else sn += ((n & 2) ? -term : term); term *= inv / (double)(n + 1); }
        double cp = 1.0, sp = 0.0; float* ct = (float*)(c.ws + WS_ROPE); float* st = ct + 64 * 32;
        for (int p = 0; p < 64; ++p) { ct[p * 32 + d] = (float)cp; st[p * 32 + d] = (float)sp; const double nc = cp * cs - sp * sn, ns = sp * cs + cp * sn; cp = nc; sp = ns; }
    }
}

__device__ __forceinline__ void ph_prenorm0(const Ctx& c) {
    bf16* H = (bf16*)(c.ws + WS_H);
    const float* g = inp(c, I_NORMG);
    for (int row = c.gw; row < NTOK; row += c.ngw) {
        const RowInfo ri = rowinfo(row);
        const float* xr = row < NLAT ? inp(c, I_X) + (size_t)row * D : inp(c, I_CTX) + (size_t)(row - NLAT) * D;
        const float* sh = modp(c, 0, ri.who, 0); const float* sc = modp(c, 0, ri.who, 1);
        f32x4 v[8]; float ss = 0.f;
#pragma unroll
        for (int j = 0; j < 8; ++j) { v[j] = ((const f32x4*)xr)[j * 64 + c.lane]; ss += v[j].x * v[j].x + v[j].y * v[j].y + v[j].z * v[j].z + v[j].w * v[j].w; }
        const float rstd = rsqrtf(wsum(ss) * (1.0f / D) + 1e-6f);
#pragma unroll
        for (int j = 0; j < 8; ++j) { const int idx = j * 256 + c.lane * 4;
            const f32x4 gg = *(const f32x4*)(g + idx), s4 = *(const f32x4*)(sh + idx), c4 = *(const f32x4*)(sc + idx);
            const f32x4 h = v[j] * rstd * gg * (c4 + 1.0f) + s4;
            u32x2 o; o.x = pk2(h.x, h.y); o.y = pk2(h.z, h.w); *(u32x2*)(H + (size_t)row * D + idx) = o; }
    }
}

__device__ __forceinline__ void ph_prep0(const Ctx& c) {
    const bf16* U = (const bf16*)(c.ws + WS_U); bf16* Q = (bf16*)(c.ws + WS_Q); bf16* Kb = (bf16*)(c.ws + WS_K); bf16* Vb = (bf16*)(c.ws + WS_V); bf16* MP = (bf16*)(c.ws + WS_MP);
    const float* ct = (const float*)(c.ws + WS_ROPE); const float* st = ct + 64 * 32;
    const int lane = c.lane;
    for (int row = c.gw; row < NTOK; row += c.ngw) {
        const RowInfo ri = rowinfo(row); const bool lat = row < NLAT;
        const bf16* u = U + (size_t)row * AB_IN;
        const int kvpos = lat ? ri.t : SEQ + ri.t;
        const int prow = ri.t >> 6, pcol = ri.t & 63;
#pragma unroll
        for (int pass = 0; pass < 2; ++pass) {
            const int e0 = (pass ? ATTN_W : 0) + lane * 16;
            const u32x4 r0 = *(const u32x4*)(u + e0), r1 = *(const u32x4*)(u + e0 + 8);
            float x[16];
            x[0] = bf2f(r0.x & 0xffffu); x[1] = bf2f(r0.x >> 16); x[2] = bf2f(r0.y & 0xffffu); x[3] = bf2f(r0.y >> 16);
            x[4] = bf2f(r0.z & 0xffffu); x[5] = bf2f(r0.z >> 16); x[6] = bf2f(r0.w & 0xffffu); x[7] = bf2f(r0.w >> 16);
            x[8] = bf2f(r1.x & 0xffffu); x[9] = bf2f(r1.x >> 16); x[10] = bf2f(r1.y & 0xffffu); x[11] = bf2f(r1.y >> 16);
            x[12] = bf2f(r1.z & 0xffffu); x[13] = bf2f(r1.z >> 16); x[14] = bf2f(r1.w & 0xffffu); x[15] = bf2f(r1.w >> 16);
            float ss = 0.f;
#pragma unroll
            for (int i = 0; i < 16; ++i) ss += x[i] * x[i];
            ss = sum8(ss);
            const float rstd = rsqrtf(ss * (1.0f / HD) + 1e-6f);
            const float* gain = (pass ? inp(c, I_KGAIN) : inp(c, I_QGAIN)) + (lane & 7) * 16;
            const int s = lane & 7, sub = s & 3, pos = (s >> 2) ? pcol : prow;
            float gv[16], cv[16], sv[16];
#pragma unroll
            for (int q = 0; q < 4; ++q) { const f32x4 g4 = *(const f32x4*)(gain + 4 * q), c4 = *(const f32x4*)(ct + pos * 32 + (sub & 1) * 16 + 4 * q), s4 = *(const f32x4*)(st + pos * 32 + (sub & 1) * 16 + 4 * q);
                gv[4 * q] = g4.x; gv[4 * q + 1] = g4.y; gv[4 * q + 2] = g4.z; gv[4 * q + 3] = g4.w; cv[4 * q] = c4.x; cv[4 * q + 1] = c4.y; cv[4 * q + 2] = c4.z; cv[4 * q + 3] = c4.w;
                sv[4 * q] = s4.x; sv[4 * q + 1] = s4.y; sv[4 * q + 2] = s4.z; sv[4 * q + 3] = s4.w; }
            float o[16];
#pragma unroll
            for (int i = 0; i < 16; ++i) {
                const float xv = x[i] * rstd * gv[i];
                const float pv = dpp_mov<0x4E>(xv);
                if (lat) o[i] = (sub & 2) ? (xv * cv[i] + pv * sv[i]) : (xv * cv[i] - pv * sv[i]);
                else o[i] = xv;
            }
            u32x4 w0, w1;
            w0.x = pk2(o[0], o[1]); w0.y = pk2(o[2], o[3]); w0.z = pk2(o[4], o[5]); w0.w = pk2(o[6], o[7]);
            w1.x = pk2(o[8], o[9]); w1.y = pk2(o[10], o[11]); w1.z = pk2(o[12], o[13]); w1.w = pk2(o[14], o[15]);
            if (pass == 0) { bf16* dst = Q + (size_t)row * ATTN_W + lane * 16; *(u32x4*)dst = w0; *(u32x4*)(dst + 8) = w1; }
            else if (lane < 16) { bf16* dst = Kb + ((size_t)ri.b * KVLEN + kvpos) * KV_W + lane * 16; *(u32x4*)dst = w0; *(u32x4*)(dst + 8) = w1; }
        }
        if (lane >= 16 && lane < 32) {
            const bf16* src = u + ATTN_W + KV_W + (lane - 16) * 16; bf16* dst = Vb + ((size_t)ri.b * KVLEN + kvpos) * KV_W + (lane - 16) * 16;
            *(u32x4*)dst = *(const u32x4*)src; *(u32x4*)(dst + 8) = *(const u32x4*)(src + 8);
        }
        {
            const int c0 = lane * 16, gi = lane >> 4, half = 1 << gi;
            const int lo = ri.t - half < 0 ? 0 : ri.t - half, hi = ri.t + half > ri.n ? ri.n : ri.t + half;
            float acc[16];
#pragma unroll
            for (int i = 0; i < 16; ++i) acc[i] = 0.f;
            u32x4 pr0[16], pr1[16];
#pragma unroll
            for (int q = 0; q < 16; ++q) {
                int tt = ri.t - 8 + q; const bool ok = tt >= lo && tt < hi; tt = ok ? tt : ri.t;
                const bf16* p = U + (size_t)(ri.seq0 + tt) * AB_IN + ATTN_W + 2 * KV_W + c0;
                pr0[q] = *(const u32x4*)p; pr1[q] = *(const u32x4*)(p + 8);
                if (!ok) { pr0[q] = (u32x4){0u, 0u, 0u, 0u}; pr1[q] = (u32x4){0u, 0u, 0u, 0u}; }
            }
#pragma unroll
            for (int q = 0; q < 16; ++q) { const u32x4 r0 = pr0[q], r1 = pr1[q];
                acc[0] += bf2f(r0.x & 0xffffu); acc[1] += bf2f(r0.x >> 16); acc[2] += bf2f(r0.y & 0xffffu); acc[3] += bf2f(r0.y >> 16);
                acc[4] += bf2f(r0.z & 0xffffu); acc[5] += bf2f(r0.z >> 16); acc[6] += bf2f(r0.w & 0xffffu); acc[7] += bf2f(r0.w >> 16);
                acc[8] += bf2f(r1.x & 0xffffu); acc[9] += bf2f(r1.x >> 16); acc[10] += bf2f(r1.y & 0xffffu); acc[11] += bf2f(r1.y >> 16);
                acc[12] += bf2f(r1.z & 0xffffu); acc[13] += bf2f(r1.z >> 16); acc[14] += bf2f(r1.w & 0xffffu); acc[15] += bf2f(r1.w >> 16);
            }
            const float inv = 1.0f / (float)(hi - lo);
            const bf16* p = u + ATTN_W + 2 * KV_W + c0;
            const u32x4 r0 = *(const u32x4*)p, r1 = *(const u32x4*)(p + 8);
            float sv[16];
            sv[0] = bf2f(r0.x & 0xffffu); sv[1] = bf2f(r0.x >> 16); sv[2] = bf2f(r0.y & 0xffffu); sv[3] = bf2f(r0.y >> 16);
            sv[4] = bf2f(r0.z & 0xffffu); sv[5] = bf2f(r0.z >> 16); sv[6] = bf2f(r0.w & 0xffffu); sv[7] = bf2f(r0.w >> 16);
            sv[8] = bf2f(r1.x & 0xffffu); sv[9] = bf2f(r1.x >> 16); sv[10] = bf2f(r1.y & 0xffffu); sv[11] = bf2f(r1.y >> 16);
            sv[12] = bf2f(r1.z & 0xffffu); sv[13] = bf2f(r1.z >> 16); sv[14] = bf2f(r1.w & 0xffffu); sv[15] = bf2f(r1.w >> 16);
            u32x4 w0, w1;
            w0.x = pk2(acc[0] * inv - sv[0], acc[1] * inv - sv[1]); w0.y = pk2(acc[2] * inv - sv[2], acc[3] * inv - sv[3]);
            w0.z = pk2(acc[4] * inv - sv[4], acc[5] * inv - sv[5]); w0.w = pk2(acc[6] * inv - sv[6], acc[7] * inv - sv[7]);
            w1.x = pk2(acc[8] * inv - sv[8], acc[9] * inv - sv[9]); w1.y = pk2(acc[10] * inv - sv[10], acc[11] * inv - sv[11]);
            w1.z = pk2(acc[12] * inv - sv[12], acc[13] * inv - sv[13]); w1.w = pk2(acc[14] * inv - sv[14], acc[15] * inv - sv[15]);
            bf16* dst = MP + (size_t)row * POOL_W + c0; *(u32x4*)dst = w0; *(u32x4*)(dst + 8) = w1;
        }
    }
}


namespace attn {
using bf16 = unsigned short;
constexpr int   D = 128, NW = 8, QBLK = 32, KVBLK = 64;
constexpr float SCALE = 0.088388347648318440f;
constexpr float THR = 8.f;
constexpr int SDEPTH = 2;
constexpr int LDQ = 1024, LDK = 256, LDO = 2048;
constexpr size_t SHM_V = KVBLK * D * 2, SHM_K = KVBLK * D * 2, SHM_ATTN = 2 * SHM_V + 2 * SHM_K + NW * 64 * 4;
using bf16x8 = __attribute__((ext_vector_type(8))) short;
using s16x4  = __attribute__((ext_vector_type(4))) short;
using f32x16 = __attribute__((ext_vector_type(16))) float;
using f32x8  = __attribute__((ext_vector_type(8))) float;
using u32x4  = __attribute__((ext_vector_type(4))) unsigned;
#define KSWZ(row, colB) ((row) * 256 + ((colB) ^ (((row) & 7) << 4)))
#define SBAR() __builtin_amdgcn_sched_barrier(0)
__device__ __forceinline__ int crow(int r, int hi) { return (r & 3) + 8 * (r >> 2) + 4 * hi; }
__device__ __forceinline__ unsigned cvtpk(float lo, float hi) {
  unsigned r; asm volatile("v_cvt_pk_bf16_f32 %0, %1, %2" : "=v"(r) : "v"(lo), "v"(hi)); return r;
}
template <typename TIn> struct Stage;
template <> struct Stage<bf16>  { using T = bf16x8;
  __device__ static __forceinline__ T ld8(const bf16* p) { return *reinterpret_cast<const bf16x8*>(p); }
  __device__ static __forceinline__ bf16x8 tobf(T x) { return x; } };
__device__ __forceinline__ void partialSM(f32x16& p0, f32x16& p1, float& m_reg, float& mn, float& alpha) {
  constexpr float C = SCALE * 1.4426950408889634f;
  float pmax = p0[0]; for (int r = 1; r < 16; ++r) pmax = fmaxf(pmax, p0[r]); for (int r = 0; r < 16; ++r) pmax = fmaxf(pmax, p1[r]);
  { auto rr = __builtin_amdgcn_permlane32_swap(__float_as_uint(pmax), __float_as_uint(pmax), false, false);
    pmax = fmaxf(__uint_as_float(rr[0]), __uint_as_float(rr[1])); }
  if (__builtin_expect(__all(pmax - m_reg <= THR / SCALE), 1)) { mn = m_reg; alpha = 1.f; }
  else { mn = fmaxf(m_reg, pmax); alpha = __builtin_amdgcn_exp2f((m_reg - mn) * C); m_reg = mn; }
  float mnC = -mn * C;
  for (int r = 0; r < 16; ++r) p0[r] = fmaf(p0[r], C, mnC); for (int r = 0; r < 16; ++r) p1[r] = fmaf(p1[r], C, mnC);
  for (int r = 0; r < 16; ++r) p0[r] = __builtin_amdgcn_exp2f(p0[r]);
}
__device__ __forceinline__ void finishSM(f32x16& p0, f32x16& p1, float alpha, float& l_reg, bf16x8& pa0, bf16x8& pa1, bf16x8& pa2, bf16x8& pa3) {
  for (int r = 0; r < 16; ++r) p1[r] = __builtin_amdgcn_exp2f(p1[r]);
  float ps = 0; for (int r = 0; r < 16; ++r) ps += p0[r]; for (int r = 0; r < 16; ++r) ps += p1[r];
  { auto rr = __builtin_amdgcn_permlane32_swap(__float_as_uint(ps), __float_as_uint(ps), false, false);
    ps = __uint_as_float(rr[0]) + __uint_as_float(rr[1]); }
  l_reg = l_reg * alpha + ps;
#define PK4(P, BASE, OUT) do { unsigned a0 = cvtpk(P[BASE + 0], P[BASE + 1]), a1 = cvtpk(P[BASE + 2], P[BASE + 3]);   \
    unsigned b0 = cvtpk(P[BASE + 4], P[BASE + 5]), b1 = cvtpk(P[BASE + 6], P[BASE + 7]);                              \
    auto r0 = __builtin_amdgcn_permlane32_swap(a0, b0, false, false); auto r1 = __builtin_amdgcn_permlane32_swap(a1, b1, false, false); \
    u32x4 w = {r0[0], r1[0], r0[1], r1[1]}; OUT = *reinterpret_cast<bf16x8*>(&w); } while (0)
  PK4(p0, 0, pa0); PK4(p0, 8, pa1); PK4(p1, 0, pa2); PK4(p1, 8, pa3);
#undef PK4
}
__device__ __forceinline__ void qkt(f32x16& p0, f32x16& p1, const bf16* Ks, const bf16x8* qr, int r32, int hi) {
  p0 = f32x16{}; p1 = f32x16{};
  for (int d0 = 0; d0 < 8; ++d0) { int cb = (d0 * 16 + hi * 8) * 2;
    bf16x8 b0 = *reinterpret_cast<const bf16x8*>((const char*)Ks + KSWZ(r32, cb));
    bf16x8 b1 = *reinterpret_cast<const bf16x8*>((const char*)Ks + KSWZ(32 + r32, cb));
    p0 = __builtin_amdgcn_mfma_f32_32x32x16_bf16(b0, qr[d0], p0, 0, 0, 0);
    p1 = __builtin_amdgcn_mfma_f32_32x32x16_bf16(b1, qr[d0], p1, 0, 0, 0); }
}
__device__ __forceinline__ int v_st(int k, int c) { const int kk = (k & ~0xC) | ((k & 4) << 1) | ((k & 8) >> 1); return ((kk >> 3) * 4 + (c >> 5)) * 512 + ((kk & 7) * 32 + (c & 31)) * 2; }
__device__ __forceinline__ int v_rd_base(int lane) { return ((lane & 3) << 3) | (((lane >> 2) & 3) << 6) | (((lane >> 4) & 1) << 5) | (((lane >> 5) & 1) << 8); }
constexpr int v_rd_off(int d0, int ks, int half) { return d0 * 512 + ks * 4096 + half * 2048; }
template <int OFF> __device__ __forceinline__ s16x4 tr_read(int vb) {
  s16x4 r; asm volatile("ds_read_b64_tr_b16 %0, %1 offset:%2" : "=&v"(r) : "v"(vb), "i"(OFF) : "memory"); return r;
}
template <int D0> __device__ __forceinline__ void pv_one(f32x16& od, int vb, bf16x8 pa0, bf16x8 pa1, bf16x8 pa2, bf16x8 pa3) {
  const s16x4 l0 = tr_read<v_rd_off(D0, 0, 0)>(vb), h0 = tr_read<v_rd_off(D0, 0, 1)>(vb), l1 = tr_read<v_rd_off(D0, 1, 0)>(vb), h1 = tr_read<v_rd_off(D0, 1, 1)>(vb);
  const s16x4 l2 = tr_read<v_rd_off(D0, 2, 0)>(vb), h2 = tr_read<v_rd_off(D0, 2, 1)>(vb), l3 = tr_read<v_rd_off(D0, 3, 0)>(vb), h3 = tr_read<v_rd_off(D0, 3, 1)>(vb);
  asm volatile("s_waitcnt lgkmcnt(0)" ::: "memory"); SBAR();
#define PK(L, H) (bf16x8){L[0], L[1], L[2], L[3], H[0], H[1], H[2], H[3]}
  od = __builtin_amdgcn_mfma_f32_32x32x16_bf16(pa0, PK(l0, h0), od, 0, 0, 0);
  od = __builtin_amdgcn_mfma_f32_32x32x16_bf16(pa1, PK(l1, h1), od, 0, 0, 0);
  od = __builtin_amdgcn_mfma_f32_32x32x16_bf16(pa2, PK(l2, h2), od, 0, 0, 0);
  od = __builtin_amdgcn_mfma_f32_32x32x16_bf16(pa3, PK(l3, h3), od, 0, 0, 0);
#undef PK
}
__device__ __forceinline__ void pv_d0(f32x16* o, int vb, bf16x8 pa0, bf16x8 pa1, bf16x8 pa2, bf16x8 pa3) {
  pv_one<0>(o[0], vb, pa0, pa1, pa2, pa3); pv_one<1>(o[1], vb, pa0, pa1, pa2, pa3); pv_one<2>(o[2], vb, pa0, pa1, pa2, pa3); pv_one<3>(o[3], vb, pa0, pa1, pa2, pa3);
}

__device__ __forceinline__ void attn_dense_body(const bf16* __restrict__ Qb, const bf16* __restrict__ Kh, const bf16* __restrict__ Vh,
                                                bf16* __restrict__ Ob, int seq, char* lds) {
  using St = Stage<bf16>; using SQ = Stage<bf16>; using TQ = bf16;
  int tid = threadIdx.x; asm volatile("" : "+v"(tid));
  const int wid = tid >> 6, lane = tid & 63, r32 = lane & 31, hi = lane >> 5;
  bf16* V_lds = (bf16*)lds; bf16* K_lds = (bf16*)(lds + 2 * SHM_V);
  float* ws = (float*)(lds + 2 * SHM_V + 2 * SHM_K) + wid * 64; float* li_l = ws; float* al_l = ws + 32;
  float m_reg = -1e30f, l_reg = 0; f32x16 o[4] = {}; bf16x8 qr[8];
  const TQ* Qw = Qb + (long)(wid * QBLK + r32) * LDQ + hi * 8;
#pragma unroll
  for (int d0 = 0; d0 < 8; ++d0) qr[d0] = SQ::tobf(SQ::ld8(Qw + d0 * 16));
  const int sr = tid >> 4, sc = (tid & 15) * 8, vst0 = v_st(sr, sc), vst1 = v_st(32 + sr, sc);
  const int vb0 = (int)(uintptr_t)V_lds + v_rd_base(lane);
  struct { typename St::T vs0, vs1, ks0, ks1; } sr_[SDEPTH];
#define SLOAD(i, k0) do { sr_[i].vs0 = St::ld8(&Vh[(long)((k0) + sr) * LDK + sc]); sr_[i].vs1 = St::ld8(&Vh[(long)((k0) + 32 + sr) * LDK + sc]); \
    sr_[i].ks0 = St::ld8(&Kh[(long)((k0) + sr) * LDK + sc]); sr_[i].ks1 = St::ld8(&Kh[(long)((k0) + 32 + sr) * LDK + sc]); } while (0)
#define SWRITE(b, i) do { *(bf16x8*)((char*)V_lds + (b) * SHM_V + vst0) = St::tobf(sr_[i].vs0);          \
    *(bf16x8*)((char*)V_lds + (b) * SHM_V + vst1) = St::tobf(sr_[i].vs1); int kc = sc * 2;               \
    *(bf16x8*)((char*)K_lds + (b) * SHM_K + KSWZ(sr, kc)) = St::tobf(sr_[i].ks0);                       \
    *(bf16x8*)((char*)K_lds + (b) * SHM_K + KSWZ(32 + sr, kc)) = St::tobf(sr_[i].ks1); } while (0)
#define SWAIT() do { if constexpr (SDEPTH == 2) asm volatile("s_waitcnt vmcnt(4)" ::: "memory"); else asm volatile("s_waitcnt vmcnt(0)" ::: "memory"); } while (0)
#define RESC(a) do { if (__any((a) < 1.f)) { if (hi == 0) al_l[r32] = (a); asm volatile("s_waitcnt lgkmcnt(0)" ::: "memory"); \
    for (int d = 0; d < 4; ++d) for (int r = 0; r < 16; ++r) o[d][r] *= al_l[crow(r, hi)]; } } while (0)
  f32x16 pA0, pA1, pB0, pB1; float mnA, mnB, alA, alB; bf16x8 pa0, pa1, pa2, pa3; const int NT = seq / KVBLK;
  constexpr int SE = 0, SO = SDEPTH - 1;
  SLOAD(SE, 0); asm volatile("s_waitcnt vmcnt(0)" ::: "memory"); SWRITE(0, SE); __syncthreads();
  qkt(pA0, pA1, K_lds, qr, r32, hi); partialSM(pA0, pA1, m_reg, mnA, alA);
  SLOAD(SO, KVBLK); if constexpr (SDEPTH == 2) { if (2 < NT) SLOAD(SE, 2 * KVBLK); }
  SWAIT(); SWRITE(1, SO); __syncthreads();
  for (int j = 1; j + 1 < NT; j += 2) {
    SBAR(); qkt(pB0, pB1, (bf16*)((char*)K_lds + SHM_K), qr, r32, hi);
    finishSM(pA0, pA1, alA, l_reg, pa0, pa1, pa2, pa3); SBAR();
    SLOAD(SO, (j + SDEPTH) * KVBLK); SBAR();
    pv_d0(o, vb0, pa0, pa1, pa2, pa3); partialSM(pB0, pB1, m_reg, mnB, alB);
    __syncthreads(); SWAIT(); SWRITE(0, SE);
    RESC(alB); __syncthreads();
    SBAR(); qkt(pA0, pA1, K_lds, qr, r32, hi);
    finishSM(pB0, pB1, alB, l_reg, pa0, pa1, pa2, pa3); SBAR();
    if (SDEPTH == 1 || j + 3 < NT) SLOAD(SE, (j + 1 + SDEPTH) * KVBLK); SBAR();
    pv_d0(o, vb0 + (int)SHM_V, pa0, pa1, pa2, pa3); partialSM(pA0, pA1, m_reg, mnA, alA);
    __syncthreads(); SWAIT(); SWRITE(1, SO);
    RESC(alA); __syncthreads();
  }
  SBAR(); qkt(pB0, pB1, (bf16*)((char*)K_lds + SHM_K), qr, r32, hi);
  finishSM(pA0, pA1, alA, l_reg, pa0, pa1, pa2, pa3); SBAR();
  pv_d0(o, vb0, pa0, pa1, pa2, pa3); partialSM(pB0, pB1, m_reg, mnB, alB);
  __syncthreads(); RESC(alB);
  finishSM(pB0, pB1, alB, l_reg, pa0, pa1, pa2, pa3); SBAR();
  pv_d0(o, vb0 + (int)SHM_V, pa0, pa1, pa2, pa3);
  if (hi == 0) li_l[r32] = l_reg; asm volatile("s_waitcnt lgkmcnt(0)" ::: "memory");
  float rli[16];
#pragma unroll
  for (int r = 0; r < 16; ++r) rli[r] = __builtin_amdgcn_rcpf(li_l[crow(r, hi)]);
  bf16* Ow = Ob + (long)(wid * QBLK) * LDO;
#pragma unroll
  for (int r = 0; r < 16; ++r) { int orow = crow(r, hi);
    for (int d0 = 0; d0 < 4; ++d0) Ow[(long)orow * LDO + d0 * 32 + r32] = (bf16)(cvtpk(o[d0][r] * rli[r], 0.f) & 0xffffu); }
#undef SLOAD
#undef SWRITE
#undef SWAIT
#undef RESC
}

}

__device__ __forceinline__ void attn_simple_unit(const Ctx& c, const bf16* Qrows  , const bf16* Kh, const bf16* Vh  ,
                                                 int nkeys, bf16* Orows  ) {
    LAS float* Qs = (LAS float*)c.lds;
    LAS float* Ks = Qs + 64 * 132;
    LAS float* Vs = Ks + 64 * 132;
    LAS float* Ps = Vs + 64 * 128;
    const int tid = c.tid, qi = tid >> 3, g8 = tid & 7;
    __syncthreads();
    for (int i = tid; i < 64 * 16; i += 512) { const int r = i >> 4, cc = (i & 15) * 8; const u32x4 v = *(const u32x4*)(Qrows + (size_t)r * ATTN_W + cc);
        LAS float* d = Qs + r * 132 + cc; d[0] = bf2f(v.x & 0xffffu); d[1] = bf2f(v.x >> 16); d[2] = bf2f(v.y & 0xffffu); d[3] = bf2f(v.y >> 16);
        d[4] = bf2f(v.z & 0xffffu); d[5] = bf2f(v.z >> 16); d[6] = bf2f(v.w & 0xffffu); d[7] = bf2f(v.w >> 16); }
    float m = -1e30f, l = 0.f, o[16];
#pragma unroll
    for (int i = 0; i < 16; ++i) o[i] = 0.f;
    const float scale = 0.08838834764831845f;
    for (int k0 = 0; k0 < nkeys; k0 += 64) {
        __syncthreads();
        for (int i = tid; i < 64 * 16; i += 512) { const int r = i >> 4, cc = (i & 15) * 8;
            const u32x4 v = *(const u32x4*)(Kh + (size_t)(k0 + r) * KV_W + cc); const u32x4 w = *(const u32x4*)(Vh + (size_t)(k0 + r) * KV_W + cc);
            LAS float* d = Ks + r * 132 + cc; d[0] = bf2f(v.x & 0xffffu); d[1] = bf2f(v.x >> 16); d[2] = bf2f(v.y & 0xffffu); d[3] = bf2f(v.y >> 16);
            d[4] = bf2f(v.z & 0xffffu); d[5] = bf2f(v.z >> 16); d[6] = bf2f(v.w & 0xffffu); d[7] = bf2f(v.w >> 16);
            LAS float* e = Vs + r * 128 + cc; e[0] = bf2f(w.x & 0xffffu); e[1] = bf2f(w.x >> 16); e[2] = bf2f(w.y & 0xffffu); e[3] = bf2f(w.y >> 16);
            e[4] = bf2f(w.z & 0xffffu); e[5] = bf2f(w.z >> 16); e[6] = bf2f(w.w & 0xffffu); e[7] = bf2f(w.w >> 16); }
        __syncthreads();
        float s[8];
#pragma unroll
        for (int j = 0; j < 8; ++j) s[j] = 0.f;
        for (int d4 = 0; d4 < 128; d4 += 4) {
            const f32x4 q = *(const LAS f32x4*)(Qs + qi * 132 + d4);
#pragma unroll
            for (int j = 0; j < 8; ++j) { const f32x4 kk = *(const LAS f32x4*)(Ks + (g8 * 8 + j) * 132 + d4); s[j] += q.x * kk.x + q.y * kk.y + q.z * kk.z + q.w * kk.w; }
        }
        float mx = -1e30f;
#pragma unroll
        for (int j = 0; j < 8; ++j) { s[j] *= scale; mx = fmaxf(mx, s[j]); }
        mx = fmaxf(mx, __shfl_xor(mx, 1)); mx = fmaxf(mx, __shfl_xor(mx, 2)); mx = fmaxf(mx, __shfl_xor(mx, 4));
        const float mn = fmaxf(m, mx), alpha = __expf(m - mn);
        float ps = 0.f;
#pragma unroll
        for (int j = 0; j < 8; ++j) { const float p = __expf(s[j] - mn); ps += p; Ps[qi * 68 + g8 * 8 + j] = p; }
        ps += __shfl_xor(ps, 1); ps += __shfl_xor(ps, 2); ps += __shfl_xor(ps, 4);
        l = l * alpha + ps; m = mn;
#pragma unroll
        for (int i = 0; i < 16; ++i) o[i] *= alpha;
        __syncthreads();
        for (int j = 0; j < 64; ++j) {
            const float p = Ps[qi * 68 + j];
#pragma unroll
            for (int i4 = 0; i4 < 4; ++i4) { const f32x4 v = *(const LAS f32x4*)(Vs + j * 128 + g8 * 16 + i4 * 4);
                o[i4 * 4 + 0] += p * v.x; o[i4 * 4 + 1] += p * v.y; o[i4 * 4 + 2] += p * v.z; o[i4 * 4 + 3] += p * v.w; }
        }
    }
    const float il = 1.0f / l;
    u32x4 w0, w1;
    w0.x = pk2(o[0] * il, o[1] * il); w0.y = pk2(o[2] * il, o[3] * il); w0.z = pk2(o[4] * il, o[5] * il); w0.w = pk2(o[6] * il, o[7] * il);
    w1.x = pk2(o[8] * il, o[9] * il); w1.y = pk2(o[10] * il, o[11] * il); w1.z = pk2(o[12] * il, o[13] * il); w1.w = pk2(o[14] * il, o[15] * il);
    bf16* dst = Orows + (size_t)qi * D + g8 * 16; *(u32x4*)dst = w0; *(u32x4*)(dst + 8) = w1;
}
__device__ __forceinline__ void ph_attn_pool(const Ctx& c) {
    const bf16* Q = (const bf16*)(c.ws + WS_Q); const bf16* Kb = (const bf16*)(c.ws + WS_K); const bf16* Vb = (const bf16*)(c.ws + WS_V); bf16* CAT = (bf16*)(c.ws + WS_CAT);
    constexpr int NU_LAT = NB * NHEAD * (SEQ / 256), NU_CTX = NB * NHEAD * (CTXL / 256);
    for (int u = c.bid; u < NU_LAT + NU_CTX; u += c.G) {
        __syncthreads();
        int row0, h, b, koff, seq;
        if (u < NU_LAT) { const int qb = u % (SEQ / 256); h = (u / (SEQ / 256)) % NHEAD; b = u / (SEQ / 256 * NHEAD); row0 = b * SEQ + qb * 256; koff = 0; seq = KVLEN; }
        else { const int v = u - NU_LAT; h = v % NHEAD; b = v / NHEAD; row0 = NLAT + b * CTXL; koff = SEQ; seq = CTXL; }
        const size_t kb = ((size_t)b * KVLEN + koff) * KV_W + (h / 4) * HD;
        attn::attn_dense_body(Q + (size_t)row0 * ATTN_W + h * HD, Kb + kb, Vb + kb, CAT + (size_t)row0 * D + h * HD, seq, (char*)c.lds);
    }
    __syncthreads();
    {   pg8::JobSched<4> S;
#pragma unroll
        for (int g = 0; g < 4; ++g) { S.A[g] = (unsigned)(WS_MP + (size_t)g * 512); S.B[g] = (unsigned)(WB_POOL + (size_t)g * 131072); S.nM[g] = NTOK / 256; S.nN[g] = 1; S.lda2[g] = POOL_W * 2; S.ldb2[g] = 512; S.nt[g] = 4; }
        S.G = c.G; S.c = (c.bid + c.G - 16) % c.G;
        pg8::EpiPoolS e{(bf16*)(c.ws + WS_CAT), inp(c, I_POOLS)};
        pg8::gemm_phase(c.lds, (const char*)c.ws, S, e);
    }
}

__device__ __forceinline__ void ph_rowA(const Ctx& c, int layer) {
    const bf16* Y = (const bf16*)(c.ws + WS_Y); bf16* X = (bf16*)(c.ws + WS_X); bf16* F = (bf16*)(c.ws + WS_F);
    int* SELE = (int*)(c.ws + WS_SELE); int* SELP = (int*)(c.ws + WS_SELP); int* LIST = (int*)(c.ws + WS_LIST); float* LISTG = (float*)(c.ws + WS_LISTG);
    unsigned* CNT = (unsigned*)(c.ws + WS_CTL) + CW_CNT + layer * 64;
    const float* gpost = inp(c, I_NORMG) + (size_t)(layer * 4 + 1) * D; const float* gpre = inp(c, I_NORMG) + (size_t)(layer * 4 + 2) * D;
    const float* RW = inp(c, I_ROUTW) + (size_t)layer * D * NEXP; const float* RB = inp(c, I_ROUTB) + layer * NEXP;
    const int nrows = layer == 0 ? NTOK : NLAT; const int lane = c.lane;
    for (int row = c.gw; row < nrows; row += c.ngw) {
        const RowInfo ri = rowinfo(row);
        const float* xr = row < NLAT ? inp(c, I_X) + (size_t)row * D : inp(c, I_CTX) + (size_t)(row - NLAT) * D;
        const float* m2 = modp(c, layer, ri.who, 2); const float* m3 = modp(c, layer, ri.who, 3); const float* m4 = modp(c, layer, ri.who, 4);
        f32x4 v[8]; float ss = 0.f;
#pragma unroll
        for (int jj = 0; jj < 4; ++jj) { const u32x4 q = *(const u32x4*)(Y + (size_t)row * D + jj * 512 + lane * 8);
            v[2 * jj] = (f32x4){bf2f(q.x & 0xffffu), bf2f(q.x >> 16), bf2f(q.y & 0xffffu), bf2f(q.y >> 16)}; v[2 * jj + 1] = (f32x4){bf2f(q.z & 0xffffu), bf2f(q.z >> 16), bf2f(q.w & 0xffffu), bf2f(q.w >> 16)}; }
#pragma unroll
        for (int j = 0; j < 8; ++j) ss += v[j].x * v[j].x + v[j].y * v[j].y + v[j].z * v[j].z + v[j].w * v[j].w;
        float rstd = rsqrtf(wsum(ss) * (1.0f / D) + 1e-6f);
        ss = 0.f;
        u32x4 xq4 = {0u, 0u, 0u, 0u}; u32x2 xlo = {0u, 0u};
#pragma unroll
        for (int j = 0; j < 8; ++j) { const int idx = ((j >> 1) * 512 + lane * 8 + (j & 1) * 4);
            f32x4 x0;
            if (layer == 0) x0 = *(const f32x4*)(xr + idx);
            else { if (!(j & 1)) xq4 = *(const u32x4*)(X + (size_t)row * D + idx); const unsigned q0 = (j & 1) ? xq4.z : xq4.x, q1 = (j & 1) ? xq4.w : xq4.y; x0 = (f32x4){bf2f(q0 & 0xffffu), bf2f(q0 >> 16), bf2f(q1 & 0xffffu), bf2f(q1 >> 16)}; }
            const f32x4 gg = *(const f32x4*)(gpost + idx), mm = *(const f32x4*)(m2 + idx);
            v[j] = x0 + mm * (v[j] * rstd * gg);
            if (j & 1) { u32x4 xo; xo.x = xlo.x; xo.y = xlo.y; xo.z = pk2(v[j].x, v[j].y); xo.w = pk2(v[j].z, v[j].w); *(u32x4*)(X + (size_t)row * D + idx - 4) = xo; } else { xlo.x = pk2(v[j].x, v[j].y); xlo.y = pk2(v[j].z, v[j].w); }
            ss += v[j].x * v[j].x + v[j].y * v[j].y + v[j].z * v[j].z + v[j].w * v[j].w; }
        rstd = rsqrtf(wsum(ss) * (1.0f / D) + 1e-6f);
        LAS float* fl = (LAS float*)(c.lds + c.wave * 8192);
        unsigned fp8lo = 0u;
#pragma unroll
        for (int j = 0; j < 8; ++j) { const int idx = ((j >> 1) * 512 + lane * 8 + (j & 1) * 4);
            const f32x4 gg = *(const f32x4*)(gpre + idx), s4 = *(const f32x4*)(m3 + idx), c4 = *(const f32x4*)(m4 + idx);
            const f32x4 f = v[j] * rstd * gg * (c4 + 1.0f) + s4;
            if constexpr (MOE8) { const unsigned p8 = pk4_fp8(f.x, f.y, f.z, f.w);
                if (j & 1) { u32x2 o8; o8.x = fp8lo; o8.y = p8; *(u32x2*)((unsigned char*)F + (size_t)row * D + idx - 4) = o8; } else fp8lo = p8; }
            else { u32x2 o; o.x = pk2(f.x, f.y); o.y = pk2(f.z, f.w); *(u32x2*)(F + (size_t)row * D + idx) = o; }
            *(LAS f32x4*)(fl + idx) = f; }
        float mine;
        {
            typedef short bf16x8_t __attribute__((ext_vector_type(8)));
            __syncthreads();
            const int fr = lane & 15, fq = lane >> 4;
            const bf16* wth = (const bf16*)(c.ws + WB_RT) + (size_t)(layer * 2) * NEXP * D; const bf16* wtl = wth + (size_t)NEXP * D;
            const LAS float* fa = (const LAS float*)c.lds + (fr & 7) * 2048 + c.wave * 256 + fq * 8;
            f32x4 acc0 = {0.f, 0.f, 0.f, 0.f}, acc1 = acc0;
#pragma unroll 2
            for (int s8 = 0; s8 < 8; ++s8) {
                const int k0 = c.wave * 256 + s8 * 32 + fq * 8;
                const bf16x8_t bh0 = *(const bf16x8_t*)(wth + (size_t)fr * D + k0), bh1 = *(const bf16x8_t*)(wth + (size_t)(16 + fr) * D + k0);
                const bf16x8_t bl0 = *(const bf16x8_t*)(wtl + (size_t)fr * D + k0), bl1 = *(const bf16x8_t*)(wtl + (size_t)(16 + fr) * D + k0);
                f32x4 f0 = *(const LAS f32x4*)(fa + s8 * 32), f1 = *(const LAS f32x4*)(fa + s8 * 32 + 4);
                if (fr >= 8) { f0 = (f32x4){0.f, 0.f, 0.f, 0.f}; f1 = f0; }
                const float fv[8] = {f0.x, f0.y, f0.z, f0.w, f1.x, f1.y, f1.z, f1.w};
                bf16x8_t ah, al;
#pragma unroll
                for (int j = 0; j < 8; ++j) { const unsigned hb = f2bf(fv[j]); ah[j] = (short)hb; al[j] = (short)f2bf(fv[j] - bf2f(hb)); }
                acc0 = __builtin_amdgcn_mfma_f32_16x16x32_bf16(ah, bh0, acc0, 0, 0, 0); acc1 = __builtin_amdgcn_mfma_f32_16x16x32_bf16(ah, bh1, acc1, 0, 0, 0);
                acc0 = __builtin_amdgcn_mfma_f32_16x16x32_bf16(al, bh0, acc0, 0, 0, 0); acc1 = __builtin_amdgcn_mfma_f32_16x16x32_bf16(al, bh1, acc1, 0, 0, 0);
                acc0 = __builtin_amdgcn_mfma_f32_16x16x32_bf16(ah, bl0, acc0, 0, 0, 0); acc1 = __builtin_amdgcn_mfma_f32_16x16x32_bf16(ah, bl1, acc1, 0, 0, 0);
            }
            LAS float* pb = (LAS float*)(c.lds + 65536);
            if (fq < 2) {
#pragma unroll
                for (int r = 0; r < 4; ++r) { pb[(c.wave * 8 + 4 * fq + r) * 32 + fr] = acc0[r]; pb[(c.wave * 8 + 4 * fq + r) * 32 + 16 + fr] = acc1[r]; } }
            __syncthreads();
            float t = 0.f;
            if (lane < NEXP) {
#pragma unroll
                for (int w8 = 0; w8 < 8; ++w8) t += pb[(w8 * 8 + c.wave) * 32 + lane]; }
            mine = lane < NEXP ? t + RB[lane] : -3.0e38f;
            __syncthreads();
        }
        int sel[4]; float sv[4];
#pragma unroll
        for (int r = 0; r < 4; ++r) {
            const float mx = wmax(mine);
            const unsigned long long bal = __ballot(mine == mx && lane < NEXP);
            const int idx = __ffsll((long long)bal) - 1;
            sel[r] = idx; sv[r] = mx; if (lane == idx) mine = -3.0e38f;
        }
        const float e1 = __expf(sv[1] - sv[0]), e2 = __expf(sv[2] - sv[0]), e3 = __expf(sv[3] - sv[0]);
        const float inv = 1.0f / (1.0f + e1 + e2 + e3);
        if (lane < 4) {
            const int e = lane == 0 ? sel[0] : lane == 1 ? sel[1] : lane == 2 ? sel[2] : sel[3];
            const float gt = (lane == 0 ? 1.0f : lane == 1 ? e1 : lane == 2 ? e2 : e3) * inv;
            const unsigned pos = __hip_atomic_fetch_add(CNT + e, 1u, __ATOMIC_RELAXED, __HIP_MEMORY_SCOPE_AGENT);
            LIST[e * LISTCAP + pos] = row; LISTG[e * LISTCAP + pos] = gt;
            SELE[row * 4 + lane] = e; SELP[row * 4 + lane] = (int)pos;
        }
    }
}

constexpr int TB_OFF = 131072;
__device__ __forceinline__ void moe_tables(const Ctx& c, int layer, LAS int* tb) {
    __syncthreads();
    if (c.tid == 0) { const unsigned* CNT = (const unsigned*)(c.ws + WS_CTL) + CW_CNT + layer * 64; int base = 0, tp = 0;
        for (int e = 0; e < NEXP; ++e) { const int n = (int)__hip_atomic_load(CNT + e, __ATOMIC_RELAXED, __HIP_MEMORY_SCOPE_AGENT); tb[e] = n; tb[32 + e] = base; tb[64 + e] = tp; base += (n + 255) / 256 * 256; tp += (n + 255) / 256; }
        tb[96] = tp; }
    __syncthreads();
}
__device__ __forceinline__ void ph_moe_gu(const Ctx& c, int layer) {
    LAS int* tb = (LAS int*)(c.lds + TB_OFF);
    moe_tables(c, layer, tb);
    pg8::MoeSched S{tb, c.G, c.bid, 8, true, (unsigned)(WB_GU + (size_t)layer * NEXP * 2 * DEXP * D * (MOE8 ? 1 : 2)), layer};
    pg8::EpiSwiglu e{(bf16*)(c.ws + WS_ACT), inp(c, I_BGATE) + (size_t)layer * NEXP * DEXP, inp(c, I_BUP) + (size_t)layer * NEXP * DEXP};
    pg8::gemm_phase_t<MOE8, true>(c.lds, (const char*)c.ws, S, e);
}
__device__ __forceinline__ void ph_moe_down(const Ctx& c, int layer) {
    LAS int* tb = (LAS int*)(c.lds + TB_OFF);
    moe_tables(c, layer, tb);
    pg8::MoeSched S{tb, c.G, c.bid, 8, false, (unsigned)(WB_DN + (size_t)layer * NEXP * D * DEXP * (MOE8 ? 1 : 2)), layer};
    pg8::EpiDownF e{(bf16*)(c.ws + WS_YE), inp(c, I_BDOWN) + (size_t)layer * NEXP * D, (const float*)(c.ws + WS_LISTG)};
    pg8::gemm_phase_t<MOE8, false>(c.lds, (const char*)c.ws, S, e);
}

__device__ __forceinline__ void ph_rowB(const Ctx& c, int layer) {
    bf16* X = (bf16*)(c.ws + WS_X); const bf16* YE = (const bf16*)(c.ws + WS_YE); float* H1 = (float*)(c.ws + WS_H1);
    const int* SELE = (const int*)(c.ws + WS_SELE); const int* SELP = (const int*)(c.ws + WS_SELP);
    const unsigned* CNT = (const unsigned*)(c.ws + WS_CTL) + CW_CNT + layer * 64;
    const float* gpf = inp(c, I_NORMG) + (size_t)(layer * 4 + 3) * D; const float* gpm1 = inp(c, I_NORMG) + (size_t)(1 * 4 + 0) * D;
    const int nrows = layer == 0 ? NTOK : NLAT; const int lane = c.lane;
    int mybase;
    { int n = lane < NEXP ? (int)__hip_atomic_load(CNT + (lane & 31), __ATOMIC_RELAXED, __HIP_MEMORY_SCOPE_AGENT) : 0; n = (n + 255) / 256 * 256; int incl = n;
#pragma unroll
      for (int o = 1; o < 32; o <<= 1) { const int t = shi(incl, (lane - o) & 63); if ((lane & 31) >= o) incl += t; }
      mybase = incl - n; }
    for (int row = c.gw; row < nrows; row += c.ngw) {
        const RowInfo ri = rowinfo(row);
        f32x4 v[8];
#pragma unroll
        for (int j = 0; j < 8; ++j) v[j] = (f32x4){0.f, 0.f, 0.f, 0.f};
#pragma unroll
        for (int r = 0; r < 4; ++r) {
            const int e = SELE[row * 4 + r], pos = SELP[row * 4 + r];
            const int slot = shi(mybase, e) + pos;
            const bf16* yr = YE + (size_t)slot * D;
#pragma unroll
            for (int jj = 0; jj < 4; ++jj) { const u32x4 w = *(const u32x4*)(yr + jj * 512 + lane * 8);
                v[2 * jj].x += bf2f(w.x & 0xffffu); v[2 * jj].y += bf2f(w.x >> 16); v[2 * jj].z += bf2f(w.y & 0xffffu); v[2 * jj].w += bf2f(w.y >> 16);
                v[2 * jj + 1].x += bf2f(w.z & 0xffffu); v[2 * jj + 1].y += bf2f(w.z >> 16); v[2 * jj + 1].z += bf2f(w.w & 0xffffu); v[2 * jj + 1].w += bf2f(w.w >> 16); }
        }
        float ss = 0.f;
#pragma unroll
        for (int j = 0; j < 8; ++j) ss += v[j].x * v[j].x + v[j].y * v[j].y + v[j].z * v[j].z + v[j].w * v[j].w;
        float rstd = rsqrtf(wsum(ss) * (1.0f / D) + 1e-6f);
        const float* m5 = modp(c, layer, ri.who, 5);
        ss = 0.f;
        u32x4 xq4 = {0u, 0u, 0u, 0u}; u32x2 xlo = {0u, 0u};
#pragma unroll
        for (int j = 0; j < 8; ++j) { const int idx = ((j >> 1) * 512 + lane * 8 + (j & 1) * 4);
            if (!(j & 1)) xq4 = *(const u32x4*)(X + (size_t)row * D + idx);
            const unsigned q0 = (j & 1) ? xq4.z : xq4.x, q1 = (j & 1) ? xq4.w : xq4.y; const f32x4 x0 = (f32x4){bf2f(q0 & 0xffffu), bf2f(q0 >> 16), bf2f(q1 & 0xffffu), bf2f(q1 >> 16)};
            const f32x4 gg = *(const f32x4*)(gpf + idx), mm = *(const f32x4*)(m5 + idx);
            v[j] = x0 + mm * (v[j] * rstd * gg);
            ss += v[j].x * v[j].x + v[j].y * v[j].y + v[j].z * v[j].z + v[j].w * v[j].w; }
        if (layer == 1) {
#pragma unroll
            for (int j = 0; j < 8; ++j) *(f32x4*)(c.out + (size_t)row * D + ((j >> 1) * 512 + lane * 8 + (j & 1) * 4)) = v[j];
        } else {
            rstd = rsqrtf(wsum(ss) * (1.0f / D) + 1e-6f);
            const float* sh = modp(c, 1, ri.who, 0); const float* sc = modp(c, 1, ri.who, 1);
            u32x2 hlo = {0u, 0u};
#pragma unroll
            for (int j = 0; j < 8; ++j) { const int idx = ((j >> 1) * 512 + lane * 8 + (j & 1) * 4);
                if (j & 1) { u32x4 xo; xo.x = xlo.x; xo.y = xlo.y; xo.z = pk2(v[j].x, v[j].y); xo.w = pk2(v[j].z, v[j].w); *(u32x4*)(X + (size_t)row * D + idx - 4) = xo; } else { xlo.x = pk2(v[j].x, v[j].y); xlo.y = pk2(v[j].z, v[j].w); }
                const f32x4 gg = *(const f32x4*)(gpm1 + idx), s4 = *(const f32x4*)(sh + idx), c4 = *(const f32x4*)(sc + idx);
                const f32x4 hv = v[j] * rstd * gg * (c4 + 1.0f) + s4; u32x2 hw; hw.x = pk2(hv.x, hv.y); hw.y = pk2(hv.z, hv.w);
                if (j & 1) { u32x4 h4; h4.x = hlo.x; h4.y = hlo.y; h4.z = hw.x; h4.w = hw.y; *(u32x4*)((bf16*)H1 + (size_t)row * D + idx - 4) = h4; } else hlo = hw; }
        }
    }
}

__device__ __forceinline__ void ph_shiftmix(const Ctx& c) {
    const bf16* H1 = (const bf16*)(c.ws + WS_H1); bf16* XS = (bf16*)(c.ws + WS_XS); const float* mix = inp(c, I_MIX);
    const int lane = c.lane;
    constexpr int RPW = 5;
    for (int row0 = c.gw; row0 < NTOK; row0 += RPW * c.ngw) {
#pragma unroll 1
        for (int j = 0; j < 4; ++j) { const int idx = j * 512 + lane * 8;
            f32x4 m0[6], m1[6];
#pragma unroll
            for (int s = 0; s < 6; ++s) { m0[s] = *(const f32x4*)(mix + s * D + idx); m1[s] = *(const f32x4*)(mix + s * D + idx + 4); }
            u32x4 qh[RPW], qp[RPW], qn[RPW];
#pragma unroll
            for (int i = 0; i < RPW; ++i) { const int row = row0 + i * c.ngw; qh[i] = (u32x4){0u, 0u, 0u, 0u}; qp[i] = qh[i]; qn[i] = qh[i];
                if (row < NTOK) { const RowInfo ri = rowinfo(row);
                    qh[i] = *(const u32x4*)(H1 + (size_t)row * D + idx);
                    if (ri.t > 0) qp[i] = *(const u32x4*)(H1 + (size_t)(row - 1) * D + idx);
                    if (ri.t < ri.n - 1) qn[i] = *(const u32x4*)(H1 + (size_t)(row + 1) * D + idx); } }
#define UNP(q_, lo_) ((f32x4){bf2f((lo_ ? q_.x : q_.z) & 0xffffu), bf2f((lo_ ? q_.x : q_.z) >> 16), bf2f((lo_ ? q_.y : q_.w) & 0xffffu), bf2f((lo_ ? q_.y : q_.w) >> 16)})
#pragma unroll
            for (int i = 0; i < RPW; ++i) { const int row = row0 + i * c.ngw;
                if (row < NTOK) {
                    const f32x4 h0 = UNP(qh[i], true), h1 = UNP(qh[i], false);
                    const f32x4 xx0 = (UNP(qp[i], true) + UNP(qn[i], true)) * 0.5f - h0, xx1 = (UNP(qp[i], false) + UNP(qn[i], false)) * 0.5f - h1;
#pragma unroll
                    for (int s = 0; s < 6; ++s) { const f32x4 o0 = h0 + xx0 * m0[s], o1 = h1 + xx1 * m1[s];
                        u32x4 w; w.x = pk2(o0.x, o0.y); w.y = pk2(o0.z, o0.w); w.z = pk2(o1.x, o1.y); w.w = pk2(o1.z, o1.w); *(u32x4*)(XS + ((size_t)s * NTOK + row) * D + idx) = w; } } }
#undef UNP
        }
    }
}

__device__ __forceinline__ void ph_rw_gemm1(const Ctx& c) {
    constexpr size_t XSZ = (size_t)NTOK * D * 2;
    pg8::JobSched<6> S;
    S.A[0] = (unsigned)WS_XS; S.A[1] = (unsigned)(WS_XS + 2 * XSZ); S.A[2] = (unsigned)(WS_XS + 3 * XSZ); S.A[3] = (unsigned)(WS_XS + 1 * XSZ); S.A[4] = (unsigned)(WS_XS + 4 * XSZ); S.A[5] = (unsigned)(WS_XS + 5 * XSZ);
    S.B[0] = (unsigned)WB_WR; S.B[1] = (unsigned)WB_WK; S.B[2] = (unsigned)WB_WV; S.B[3] = (unsigned)WB_W1; S.B[4] = (unsigned)WB_A1; S.B[5] = (unsigned)WB_G1;
    S.nM[0] = NLAT / 256; S.nM[1] = NTOK / 256; S.nM[2] = NTOK / 256; S.nM[3] = NTOK / 256; S.nM[4] = NTOK / 256; S.nM[5] = NLAT / 256;
#pragma unroll
    for (int j = 0; j < 6; ++j) { S.nN[j] = j < 3 ? D / 256 : 1; S.lda2[j] = D * 2; S.ldb2[j] = D * 2; S.nt[j] = D / 64; }
    S.G = c.G; S.c = c.bid;
    static_assert(WS_KK == WS_R + (size_t)NTOK * D * 4 && WS_VV == WS_KK + (size_t)NTOK * D * 4 && WS_LA == WS_LW + (size_t)NTOK * 512 && WS_LG == WS_LA + (size_t)NTOK * 512, "contiguous outputs");
    pg8::EpiRw1 e{(float*)(c.ws + WS_R), (bf16*)(c.ws + WS_LW)};
    pg8::gemm_phase(c.lds, (const char*)c.ws, S, e);
}
__device__ __forceinline__ void ph_rw_gemm2(const Ctx& c) {
    pg8::JobSched<3> S;
    S.A[0] = (unsigned)WS_LW; S.A[1] = (unsigned)WS_LA; S.A[2] = (unsigned)WS_LG;
    S.B[0] = (unsigned)WB_W2; S.B[1] = (unsigned)WB_A2; S.B[2] = (unsigned)WB_G2;
    S.nM[0] = NTOK / 256; S.nM[1] = NTOK / 256; S.nM[2] = NLAT / 256; S.nN[0] = 16; S.nN[1] = 16; S.nN[2] = 8;
#pragma unroll
    for (int j = 0; j < 3; ++j) { S.lda2[j] = 512; S.ldb2[j] = 512; S.nt[j] = 4; }
    S.G = c.G; S.c = c.bid;
    pg8::EpiRw2 e{(float*)(c.ws + WS_DEC), (float*)(c.ws + WS_AS), (float*)(c.ws + WS_G), inp(c, I_W0), inp(c, I_A0)};
    pg8::gemm_phase(c.lds, (const char*)c.ws, S, e);
}

constexpr int SC_T = 32, SC_NCH = (CTXL + SEQ) / SC_T, SC_VS = 6 * RN;
__device__ __forceinline__ int scan_row(int s, int dir, int b) {
    return s < CTXL ? (NLAT + b * CTXL + (dir ? (CTXL - 1 - s) : s)) : (b * SEQ + (dir ? (SEQ - 1 - (s - CTXL)) : (s - CTXL)));
}
struct ScanLd { u32x2 k, v, r, w, a; };
__device__ __forceinline__ f32x4 bf4(const u32x2& q) { return (f32x4){bf2f(q.x & 0xffffu), bf2f(q.x >> 16), bf2f(q.y & 0xffffu), bf2f(q.y >> 16)}; }
__device__ __forceinline__ void scan_issue(ScanLd& L, const bf16* Kp, const bf16* Vp, const bf16* Rp, const bf16* Wp, const bf16* Ap, int row, int col) {
    const size_t o = (size_t)row * D + col;
    L.k = *(const u32x2*)(Kp + o); L.v = *(const u32x2*)(Vp + o); L.w = *(const u32x2*)(Wp + o); L.a = *(const u32x2*)(Ap + o);
    L.r = row < NLAT ? *(const u32x2*)(Rp + o) : (u32x2){0u, 0u};
}
__device__ __forceinline__ void scan_put(const ScanLd& Lb, LAS float* dst  , const f32x4& kk4, const f32x4& ka4) {
    const f32x4 Lk = bf4(Lb.k), Lv = bf4(Lb.v), Lr = bf4(Lb.r), La = bf4(Lb.a), Le = bf4(Lb.w);
    const f32x4 Lw = (f32x4){__expf(-Le.x), __expf(-Le.y), __expf(-Le.z), __expf(-Le.w)};
    const f32x4 kr = Lk * kk4;
    const float ss = sum16(kr.x * kr.x + kr.y * kr.y + kr.z * kr.z + kr.w * kr.w);
    const f32x4 kk = kr * rsqrtf(fmaxf(ss, 1e-24f));
    *(LAS f32x4*)(dst + 0 * RN) = Lw;
    *(LAS f32x4*)(dst + 1 * RN) = Lk * ((La - 1.0f) * ka4 + 1.0f);
    *(LAS f32x4*)(dst + 2 * RN) = -kk;
    *(LAS f32x4*)(dst + 3 * RN) = kk * La;
    *(LAS f32x4*)(dst + 4 * RN) = Lr;
    *(LAS f32x4*)(dst + 5 * RN) = Lv;
}
struct ScanOp { f32x4 w0, w1, k0, k1, a0, a1, b0, b1, r0, r1; float v; };
template <bool WANTY, bool PROBE = false> __device__ __forceinline__ void scan_ld(ScanOp& o, const LAS float* p, const LAS float* pv) {
    if (PROBE) {
        o.w0 = *(const LAS f32x4*)(p); o.w1 = o.w0; o.k0 = *(const LAS f32x4*)(p + RN); o.k1 = o.k0; o.a0 = *(const LAS f32x4*)(p + 2 * RN); o.a1 = o.a0; o.b0 = *(const LAS f32x4*)(p + 3 * RN); o.b1 = o.b0;
        if (WANTY) { o.r0 = *(const LAS f32x4*)(p + 4 * RN); o.r1 = o.r0; }
        o.v = pv[5 * RN]; return; }
    o.w0 = *(const LAS f32x4*)(p); o.w1 = *(const LAS f32x4*)(p + 4); o.k0 = *(const LAS f32x4*)(p + RN); o.k1 = *(const LAS f32x4*)(p + RN + 4);
    o.b0 = *(const LAS f32x4*)(p + 3 * RN); o.b1 = *(const LAS f32x4*)(p + 3 * RN + 4);
    if (WANTY) { o.r0 = *(const LAS f32x4*)(p + 4 * RN); o.r1 = *(const LAS f32x4*)(p + 4 * RN + 4); }
    o.v = pv[5 * RN];
    asm volatile("" ::: "memory");
    o.a0 = *(const LAS f32x4*)(p + 2 * RN); o.a1 = *(const LAS f32x4*)(p + 2 * RN + 4);
}
__device__ __forceinline__ float scan_stepA(const f32x2& S0, const f32x2& S1, const f32x2& S2, const f32x2& S3, const ScanOp& o) {
    const f32x2 t01 = S0 * (f32x2){o.a0.x, o.a0.y} + S1 * (f32x2){o.a0.z, o.a0.w}, t23 = S2 * (f32x2){o.a1.x, o.a1.y} + S3 * (f32x2){o.a1.z, o.a1.w};
    const f32x2 t = t01 + t23;
    return t.x + t.y;
}
template <bool WANTY> __device__ __forceinline__ void scan_stepB(f32x2& S0, f32x2& S1, f32x2& S2, f32x2& S3, const ScanOp& o, float tsum, float& yp) {
    const float v = o.v;
    const f32x2 P0 = S0 * (f32x2){o.w0.x, o.w0.y} + (f32x2){o.k0.x, o.k0.y} * v, P1 = S1 * (f32x2){o.w0.z, o.w0.w} + (f32x2){o.k0.z, o.k0.w} * v;
    const f32x2 P2 = S2 * (f32x2){o.w1.x, o.w1.y} + (f32x2){o.k1.x, o.k1.y} * v, P3 = S3 * (f32x2){o.w1.z, o.w1.w} + (f32x2){o.k1.z, o.k1.w} * v;
    const float sa = sum8(tsum);
    S0 = (f32x2){o.b0.x, o.b0.y} * sa + P0; S1 = (f32x2){o.b0.z, o.b0.w} * sa + P1; S2 = (f32x2){o.b1.x, o.b1.y} * sa + P2; S3 = (f32x2){o.b1.z, o.b1.w} * sa + P3;
    if (WANTY) {
        const f32x2 y01 = S0 * (f32x2){o.r0.x, o.r0.y} + S1 * (f32x2){o.r0.z, o.r0.w}, y23 = S2 * (f32x2){o.r1.x, o.r1.y} + S3 * (f32x2){o.r1.z, o.r1.w};
        const f32x2 y2 = y01 + y23;
        yp = y2.x + y2.y;
    }
}
template <int CTRL> __device__ __forceinline__ float scan_ycomb(float x, float y, bool c) { const float z = c ? y : x, w = c ? x : y; return z + dpp_mov<CTRL>(w); }
#define SCAN_STEP(CUR, NXT, K, LOADNEXT) { const float ts_ = scan_stepA(S0, S1, S2, S3, CUR); __builtin_amdgcn_sched_barrier(0); \
    if (LOADNEXT) scan_ld<WANTY, PROBE>(NXT, q + ((K) + 1) * SC_VS, qv + ((K) + 1) * SC_VS); __builtin_amdgcn_sched_barrier(0); scan_stepB<WANTY>(S0, S1, S2, S3, CUR, ts_, yp##K); }
template <bool WANTY, bool PROBE = false> __device__ __forceinline__ void scan_chunk(f32x2& S0, f32x2& S1, f32x2& S2, f32x2& S3, const LAS float* p, const LAS float* pv, LAS float* yw, int l7) {
    ScanOp cur, nxt; scan_ld<WANTY, PROBE>(cur, p, pv);
    float ysel = 0.f;
    const bool c3 = (l7 & 4) != 0, c2 = (((l7 >> 1) ^ (l7 >> 2)) & 1) != 0, c1 = ((l7 ^ (l7 >> 2)) & 1) != 0;
#pragma unroll 1
    for (int s4 = 0; s4 < SC_T; s4 += 8) {
        const LAS float* q = p + s4 * SC_VS; const LAS float* qv = pv + s4 * SC_VS;
        if (WANTY) { if (s4 > 0) yw[(s4 - 8) * 32] = ysel; asm volatile("" ::: "memory"); }
        float yp0 = 0.f, yp1 = 0.f, yp2 = 0.f, yp3 = 0.f, yp4 = 0.f, yp5 = 0.f, yp6 = 0.f, yp7 = 0.f, ya0 = 0.f, ya1 = 0.f, yb0 = 0.f;
        SCAN_STEP(cur, nxt, 0, true) SCAN_STEP(nxt, cur, 1, true) if (WANTY) ya0 = scan_ycomb<0xB1>(yp0, yp1, c1);
        SCAN_STEP(cur, nxt, 2, true) SCAN_STEP(nxt, cur, 3, true) if (WANTY) { ya1 = scan_ycomb<0xB1>(yp2, yp3, c1); yb0 = scan_ycomb<0x4E>(ya0, ya1, c2); }
        SCAN_STEP(cur, nxt, 4, true) SCAN_STEP(nxt, cur, 5, true) if (WANTY) ya0 = scan_ycomb<0xB1>(yp4, yp5, c1);
        SCAN_STEP(cur, nxt, 6, true) SCAN_STEP(nxt, cur, 7, s4 + 8 < SC_T)
        if (WANTY) { ya1 = scan_ycomb<0xB1>(yp6, yp7, c1); ysel = scan_ycomb<0x141>(yb0, scan_ycomb<0x4E>(ya0, ya1, c2), c3); }
    }
    if (WANTY) yw[(SC_T - 8) * 32] = ysel;
}
template <bool PROBE = false> __device__ __forceinline__ void ph_scan(const Ctx& c) {
    const bf16* R = (const bf16*)(c.ws + WS_R); const bf16* K = (const bf16*)(c.ws + WS_KK); const bf16* V = (const bf16*)(c.ws + WS_VV);
    bf16* YS = (bf16*)(c.ws + (PROBE ? WS_YE : WS_YS));
    LAS float* ops = (LAS float*)c.lds;
    LAS float* yb = ops + 2 * SC_T * SC_VS;
    const int tid = c.tid, lane = c.lane, wave = c.wave;
    static_assert(SC_NCH * 4 * 1 >= 1, "");
    for (int unit = c.bid; unit < 2 * 2 * NB * RH; unit += c.G) {
        const bool firstunit = unit == c.bid && c.G * 4 * SC_NCH >= NEXP * CV_PER;
        const int chain = unit >> 1, half = unit & 1, dir = chain / (NB * RH), b = (chain / RH) % NB, h = chain % RH;
        const bf16* Wp = (const bf16*)(c.ws + WS_DEC + (size_t)dir * NTOK * D * 4); const bf16* Ap = (const bf16*)(c.ws + WS_AS + (size_t)dir * NTOK * D * 4);
        __syncthreads();
        if (wave >= 4) {
            const int lt = tid - 256, st0 = lt >> 4, c4 = (lt & 15) * 4, col = h * RN + c4;
            const f32x4 kk4 = *(const f32x4*)(inp(c, I_KK) + col), ka4 = *(const f32x4*)(inp(c, I_KA) + col);
            ScanLd A0, A1, B0, B1;
            scan_issue(A0, K, V, R, Wp, Ap, scan_row(st0, dir, b), col); scan_issue(A1, K, V, R, Wp, Ap, scan_row(st0 + 16, dir, b), col);
            scan_issue(B0, K, V, R, Wp, Ap, scan_row(SC_T + st0, dir, b), col); scan_issue(B1, K, V, R, Wp, Ap, scan_row(SC_T + st0 + 16, dir, b), col);
            scan_put(A0, ops + st0 * SC_VS + c4, kk4, ka4); scan_put(A1, ops + (st0 + 16) * SC_VS + c4, kk4, ka4);
            __syncthreads();
            f32x4 cvv[8]; int cvp = -1;
            for (int cix = 0; cix < SC_NCH; ++cix) {
                if (cix + 1 < SC_NCH) { LAS float* dstb = ops + ((cix + 1) & 1) * SC_T * SC_VS; scan_put(B0, dstb + st0 * SC_VS + c4, kk4, ka4); scan_put(B1, dstb + (st0 + 16) * SC_VS + c4, kk4, ka4); }
                if (cvp >= 0) { CvItem cvP; cv_decode(c, NEXP + cvp / CV_PER, cvp % CV_PER, cvP); cv_store(cvP, cvv, lane); }
                if (cix >= 1 && (cix - 1) * SC_T >= CTXL && lt < 256) {
                    const int st = lt >> 3, q4 = (lt & 7) * 4; const int row = scan_row((cix - 1) * SC_T + st, dir, b);
                    const f32x4 yv = *(const LAS f32x4*)(yb + ((cix - 1) & 1) * SC_T * 32 + st * 32 + q4); u32x2 yw; yw.x = pk2(yv.x, yv.y); yw.y = pk2(yv.z, yv.w);
                    *(u32x2*)(YS + (size_t)dir * NLAT * D * 2 + (size_t)row * D + h * RN + half * 32 + q4) = yw; }
                asm volatile("" ::: "memory");
                if (cix + 2 < SC_NCH) { const int s2 = (cix + 2) * SC_T + st0; scan_issue(B0, K, V, R, Wp, Ap, scan_row(s2, dir, b), col); scan_issue(B1, K, V, R, Wp, Ap, scan_row(s2 + 16, dir, b), col); }
                const int cvi = cix * (c.G * 4) + c.bid * 4 + (wave - 4);
                cvp = (firstunit && cvi < NEXP * CV_PER) ? cvi : -1;
                if (cvp >= 0) { CvItem cvT; cv_decode(c, NEXP + cvi / CV_PER, cvi % CV_PER, cvT); cv_load(cvT, cvv, lane); }
                __syncthreads();
            }
            if (cvp >= 0) { CvItem cvP; cv_decode(c, NEXP + cvp / CV_PER, cvp % CV_PER, cvP); cv_store(cvP, cvv, lane); }
            { const int st = lt >> 3, q4 = (lt & 7) * 4; const int row = scan_row((SC_NCH - 1) * SC_T + st, dir, b);
              const f32x4 yv = *(const LAS f32x4*)(yb + ((SC_NCH - 1) & 1) * SC_T * 32 + st * 32 + q4); u32x2 yw; yw.x = pk2(yv.x, yv.y); yw.y = pk2(yv.z, yv.w);
              *(u32x2*)(YS + (size_t)dir * NLAT * D * 2 + (size_t)row * D + h * RN + half * 32 + q4) = yw; }
        } else {
            const int rl = wave * 8 + (lane >> 3), row = half * 32 + rl, c0 = (lane & 7) * 8;
            f32x2 S0 = {0.f, 0.f}, S1 = {0.f, 0.f}, S2 = {0.f, 0.f}, S3 = {0.f, 0.f};
            __syncthreads();
            __builtin_amdgcn_s_setprio(3);
            for (int cix = 0; cix < SC_NCH; ++cix) {
                const LAS float* p = ops + (cix & 1) * SC_T * SC_VS + c0; const LAS float* pv = ops + (cix & 1) * SC_T * SC_VS + row; LAS float* yo = yb + (cix & 1) * SC_T * 32 + rl;
                if (cix * SC_T >= CTXL) scan_chunk<true, PROBE>(S0, S1, S2, S3, p, pv, yo + ((lane & 4) + ((((lane >> 1) ^ (lane >> 2)) & 1) << 1) + ((lane ^ (lane >> 2)) & 1)) * 32, lane & 7); else scan_chunk<false, PROBE>(S0, S1, S2, S3, p, pv, yo, 0);
                __syncthreads();
            }
            __builtin_amdgcn_s_setprio(0);
        }
    }
    if (c.G * 4 * SC_NCH < NEXP * CV_PER) {
        __syncthreads();
        for (int it = c.gw; it < NEXP * CV_PER; it += c.ngw) { CvItem T; f32x4 tv[8]; cv_decode(c, NEXP + it / CV_PER, it % CV_PER, T); cv_load(T, tv, lane); cv_store(T, tv, lane); }
    }
}

__device__ __forceinline__ void ph_readout(const Ctx& c) {
    const bf16* R = (const bf16*)(c.ws + WS_R); const bf16* K = (const bf16*)(c.ws + WS_KK); const bf16* V = (const bf16*)(c.ws + WS_VV);
    const bf16* AS = (const bf16*)(c.ws + WS_AS); const bf16* YS = (const bf16*)(c.ws + WS_YS); const bf16* G = (const bf16*)(c.ws + WS_G); bf16* O = (bf16*)(c.ws + WS_O);
    const float* lnw = inp(c, I_LNW); const float* lnb = inp(c, I_LNB); const float* kap = inp(c, I_KA); const float* rkp = inp(c, I_RK);
    const int lane = c.lane;
    for (int row = c.gw; row < NLAT; row += c.ngw) {
#pragma unroll 2
        for (int ps = 0; ps < 4; ++ps) {
            const int col = ps * 512 + lane * 8; const size_t o = (size_t)row * D + col;
            float y[8], r[8], k[8], v[8], a0[8], a1[8], g[8];
#define LD8(dst, p) do { const f32x4 q0_ = *(const f32x4*)(p), q1_ = *(const f32x4*)((p) + 4); dst[0] = q0_.x; dst[1] = q0_.y; dst[2] = q0_.z; dst[3] = q0_.w; dst[4] = q1_.x; dst[5] = q1_.y; dst[6] = q1_.z; dst[7] = q1_.w; } while (0)
#define LB8(dst, p) do { const u32x4 q_ = *(const u32x4*)(p); dst[0] = bf2f(q_.x & 0xffffu); dst[1] = bf2f(q_.x >> 16); dst[2] = bf2f(q_.y & 0xffffu); dst[3] = bf2f(q_.y >> 16); \
                dst[4] = bf2f(q_.z & 0xffffu); dst[5] = bf2f(q_.z >> 16); dst[6] = bf2f(q_.w & 0xffffu); dst[7] = bf2f(q_.w >> 16); } while (0)
            LB8(y, YS + o); LB8(r, YS + (size_t)NLAT * D * 2 + o);
#pragma unroll
            for (int j = 0; j < 8; ++j) y[j] += r[j];
            LB8(r, R + o); LB8(k, K + o); LB8(v, V + o); LB8(a0, AS + o); LB8(a1, AS + (size_t)NTOK * D * 2 + o); LB8(g, G + o);
#undef LB8
            float lw[8], lb[8], ka[8], rk[8];
            LD8(lw, lnw + col); LD8(lb, lnb + col); LD8(ka, kap + col); LD8(rk, rkp + col);
#undef LD8
            float s1 = 0.f;
#pragma unroll
            for (int j = 0; j < 8; ++j) s1 += y[j];
            const float mu = sum8(s1) * (1.0f / RN);
            float s2 = 0.f, s3 = 0.f;
#pragma unroll
            for (int j = 0; j < 8; ++j) { y[j] -= mu; s2 += y[j] * y[j];
                const float rr = r[j] * rk[j]; s3 += rr * (k[j] * (1.0f + (a0[j] - 1.0f) * ka[j]) + k[j] * (1.0f + (a1[j] - 1.0f) * ka[j])); }
            const float rs = rsqrtf(sum8(s2) * (1.0f / RN) + 64e-5f), bon = sum8(s3);
            float ov[8];
#pragma unroll
            for (int j = 0; j < 8; ++j) ov[j] = (y[j] * rs * lw[j] + lb[j] + bon * v[j]) * g[j];
            u32x4 w; w.x = pk2(ov[0], ov[1]); w.y = pk2(ov[2], ov[3]); w.z = pk2(ov[4], ov[5]); w.w = pk2(ov[6], ov[7]);
            *(u32x4*)(O + o) = w;
        }
    }
}

__device__ __forceinline__ bool launder(Ctx& c, unsigned char* ws) {
    unsigned long long wi = (unsigned long long)ws; asm volatile("" : "+s"(wi)); c.ws = (unsigned char*)(GAS unsigned char*)wi;
    int t = threadIdx.x; asm volatile("" : "+v"(t)); c.tid = t; c.lane = t & 63; c.wave = __builtin_amdgcn_readfirstlane(t >> 6);
    int bx = blockIdx.x; asm volatile("" : "+s"(bx)); c.bid = bx; c.gw = bx * 8 + c.wave; return true; }
constexpr int NPH = 20;
__global__ void __launch_bounds__(512, 2) fwd(Args args) {
    extern __shared__ __attribute__((aligned(16))) unsigned char lds_raw[];
    Ctx c; c.out = args.out; c.ws = args.ws; c.lds = (LAS unsigned char*)lds_raw;
    c.tid = threadIdx.x; c.lane = c.tid & 63; c.wave = __builtin_amdgcn_readfirstlane(c.tid >> 6); c.bid = blockIdx.x; c.G = gridDim.x;
    c.gw = c.bid * 8 + c.wave; c.ngw = c.G * 8;
    volatile LAS unsigned* misc = (volatile LAS unsigned*)(c.lds + LDS_BYTES - 64);
    if (c.tid < 16) misc[c.tid] = 0u;
    if (c.tid < 39) ((LAS unsigned long long*)(c.lds + PTAB_OFF))[c.tid] = (unsigned long long)args.in[c.tid];
    __syncthreads();
    constexpr int lo = 0, hi = (DBG_HI);
    (void)xcd_barrier_post((unsigned*)(c.ws + WS_CTL) + CW_BAR, misc);
#ifdef ONLY_PHASE
#define IN(k) ((k) == ONLY_PHASE && lo <= (k) && (k) < hi && launder(c, args.ws))
#else
#define IN(k) (lo <= (k) && (k) < hi && launder(c, args.ws))
#endif
#define SEAM(k) do { if ((lo <= (k) && (k) + 1 < hi)) { unsigned char* w_ = args.ws; asm volatile("" : "+s"(w_)); XcdBarrier b_; b_.bar = (unsigned*)(w_ + WS_CTL) + CW_BAR; b_.x = xb_xcc_id(); \
        b_.st = (volatile LAS unsigned*)((LAS unsigned char*)lds_raw + LDS_BYTES - 64); xcd_barrier(b_); } } while (0)
    if (IN(0)) { ph_mod(c); } SEAM(0);
    for (int layer = 0; layer < 2; ++layer) {
        if (layer == 0) {
            if (IN(1)) { ph_prenorm0(c); if (DUPQ(1)) ph_prenorm0(c); } SEAM(1);
            if (IN(2)) { for (int rp_ = 0; rp_ < 1 + DUPQ(2); ++rp_) { pg8::PlainSched S{(unsigned)WS_H, (unsigned)WB_WIN, D * 2, D * 2, D / 64, NTOK / 256, AB_IN / 256, c.G, c.bid}; pg8::EpiB16 e{(bf16*)(c.ws + WS_U), AB_IN}; pg8::gemm_phase(c.lds, (const char*)c.ws, S, e); }  if (c.G == 256 && c.bid >= 256 - CVF_F2) conv_fill(c, NEXP * CV_PER - CVF_TOTAL + (c.bid - (256 - CVF_F2)) * CVF_Q, CVF_Q); } SEAM(2);
            if (IN(3)) { ph_prep0(c); if (DUPQ(3)) ph_prep0(c); } SEAM(3);
            if (IN(4)) { ph_attn_pool(c); if (DUPQ(4)) ph_attn_pool(c); } SEAM(4);
            if (IN(5)) { for (int rp_ = 0; rp_ < 1 + DUPQ(5); ++rp_) { pg8::PlainSched S{(unsigned)WS_CAT, (unsigned)WB_WOUT, D * 2, D * 2, D / 64, NTOK / 256, D / 256, c.G, c.bid}; pg8::EpiB16 e{(bf16*)(c.ws + WS_Y), D}; pg8::gemm_phase(c.lds, (const char*)c.ws, S, e); }  if (c.G == 256 && c.bid >= 256 - CVF_F5) conv_fill(c, NEXP * CV_PER - CVF_TOTAL + CVF_F2 * CVF_Q + (c.bid - (256 - CVF_F5)) * CVF_Q, CVF_Q); } SEAM(5);
        } else {
            if (IN(10)) { ph_shiftmix(c); if (DUPQ(10)) ph_shiftmix(c); } SEAM(10);
            if (IN(11)) { ph_rw_gemm1(c); if (DUPQ(11)) ph_rw_gemm1(c); } SEAM(11);
            if (IN(12)) { ph_rw_gemm2(c); if (DUPQ(12)) ph_rw_gemm2(c); } SEAM(12);
            if (IN(13)) { ph_scan<false>(c); if (DUPQ(13)) ph_scan<(DBG_SCANPROBE != 0)>(c); } SEAM(13);
            if (IN(14)) { ph_readout(c); if (DUPQ(14)) ph_readout(c); } SEAM(14);
            if (IN(15)) { for (int rp_ = 0; rp_ < 1 + DUPQ(15); ++rp_) { pg8::PlainSched S{(unsigned)WS_O, (unsigned)WB_WO, D * 2, D * 2, D / 64, NLAT / 256, D / 256, c.G, c.bid}; pg8::EpiB16 e{(bf16*)(c.ws + WS_Y), D}; pg8::gemm_phase(c.lds, (const char*)c.ws, S, e); } } SEAM(15);
        }
        const int p0 = layer ? 16 : 6;
        if (IN(p0)) { ph_rowA(c, layer); } SEAM(p0);
        if (IN(p0 + 1)) { ph_moe_gu(c, layer); if (DUPQ(7)) ph_moe_gu(c, layer); } SEAM(p0 + 1);
        if (IN(p0 + 2)) { ph_moe_down(c, layer); if (DUPQ(8)) ph_moe_down(c, layer); } SEAM(p0 + 2);
        if (IN(p0 + 3)) { ph_rowB(c, layer); } SEAM(p0 + 3);
    }
#undef IN
#undef SEAM
}
}

extern "C" void kernel_launch(void* const* d_in, const int* in_sizes, int n_in, void* d_out, int out_size, void* d_ws, size_t ws_size, hipStream_t stream) {
    static int grid = 0;
    if (grid == 0) {
        if (n_in != 39 || out_size != NLAT * D || ws_size < WS_END3) { fprintf(stderr, "kernel_launch: unexpected shapes: n_in %d out %d ws %zu (need %zu)\n", n_in, out_size, ws_size, (size_t)WS_END3); grid = -1; return; }
        int dev = 0, cus = 0;
        if (hipGetDevice(&dev) != hipSuccess || hipDeviceGetAttribute(&cus, hipDeviceAttributeMultiprocessorCount, dev) != hipSuccess) { grid = -1; return; }
        if (hipFuncSetAttribute((const void*)fwd, hipFuncAttributeMaxDynamicSharedMemorySize, LDS_BYTES) != hipSuccess) { fprintf(stderr, "kernel_launch: hipFuncSetAttribute failed\n"); grid = -1; return; }
        int per_cu = 0;
        if (hipOccupancyMaxActiveBlocksPerMultiprocessor(&per_cu, (const void*)fwd, 512, LDS_BYTES) != hipSuccess || per_cu < 1) fprintf(stderr, "kernel_launch: occupancy query says %d\n", per_cu);
        (void)hipGetLastError();
        grid = cus;
    }
    if (grid < 0) return;
    (void)hipMemsetAsync((char*)d_ws + WS_CTL, 0, CTL_BYTES, stream);
    Args a{};
    for (int i = 0; i < 39; ++i) a.in[i] = (const float*)d_in[i];
    a.out = (float*)d_out; a.ws = (unsigned char*)d_ws;
    a.ph_lo = 0; a.ph_hi = NPH;
    hipLaunchKernelGGL(fwd, dim3(grid), dim3(512), LDS_BYTES, stream, a);
}
```

```cpp
#include <hip/hip_runtime.h>
#include <cstdio>
#include <cstdint>

#ifndef DBG_HI
#define DBG_HI NPH
#endif
#ifndef MOE_FP8
#define MOE_FP8 1
#endif
#ifndef DBG_SCANPROBE
#define DBG_SCANPROBE 0
#endif
#ifndef DBG_DUP
#define DBG_DUP 0
#endif
#define DUPQ(k) ((DBG_DUP >> (k)) & 1)
#ifndef DBG_REP0
#define DBG_REP0 1
#endif
#ifndef DBG_SMALL
#define DBG_SMALL 13568
#endif
#ifndef DBG_W2
#define DBG_W2 0
#endif
#ifndef DBG_MOE
#define DBG_MOE 0
#endif
#ifndef FAST_RKV
#define FAST_RKV 0
#endif
namespace {
constexpr int D = 2048, NB = 2, SEQ = 4096, CTXL = 256;
constexpr int NLAT = NB * SEQ, NCTX = NB * CTXL, NTOK = NLAT + NCTX;
constexpr int KVLEN = SEQ + CTXL;
constexpr int NHEAD = 8, NKVH = 2, HD = 128, ATTN_W = 1024, KV_W = 256, POOL_W = 1024, AB_IN = 2560;
constexpr int NEXP = 32, TOPK = 4, DEXP = 1024;
constexpr int RH = 32, RN = 64;
constexpr int LORA = 96, GLORA = 256;
constexpr int NSLOT = NTOK * TOPK + NEXP * 256;
constexpr int LISTCAP = NTOK;
constexpr int NPHASE = 21;

constexpr size_t al256(size_t x) { return (x + 255) / 256 * 256; }
constexpr size_t WS_CTL = 0, CTL_BYTES = 1u << 20;
constexpr int CW_BAR = 4096;
constexpr int CW_CNT = 16384;
constexpr size_t WS_MOD = CTL_BYTES;
constexpr size_t WS_ROPE = WS_MOD + al256((size_t)2 * 3 * 6 * D * 4);
constexpr size_t WS_SELE = WS_ROPE + al256(2 * 64 * 32 * 4);
constexpr size_t WS_SELP = WS_SELE + al256((size_t)NTOK * 4 * 4);
constexpr size_t WS_LIST = WS_SELP + al256((size_t)NTOK * 4 * 4);
constexpr size_t WS_LISTG = WS_LIST + al256((size_t)NEXP * LISTCAP * 4);
constexpr size_t WS_X = WS_LISTG + al256((size_t)NEXP * LISTCAP * 4);
constexpr size_t WS_Y = WS_X + (size_t)NTOK * D * 4;
constexpr size_t WS_F = WS_Y + (size_t)NTOK * D * 4;
constexpr size_t WS_ACT = WS_F + (size_t)NTOK * D * 2;
constexpr size_t WS_YE = WS_ACT + (size_t)NSLOT * DEXP * 2;
constexpr size_t WB_WIN = WS_YE + (size_t)NSLOT * D * 2;
constexpr size_t WB_WOUT = WB_WIN + (size_t)AB_IN * D * 2;
constexpr size_t WB_WR = WB_WOUT + (size_t)D * D * 2;
constexpr size_t WB_WK = WB_WR + (size_t)D * D * 2;
constexpr size_t WB_WV = WB_WK + (size_t)D * D * 2;
constexpr size_t WB_WO = WB_WV + (size_t)D * D * 2;
constexpr size_t WB_POOL = WB_WO + (size_t)D * D * 2;
constexpr size_t WB_W1 = WB_POOL + (size_t)4 * 256 * 256 * 2;
constexpr size_t WB_A1 = WB_W1 + (size_t)256 * D * 2;
constexpr size_t WB_G1 = WB_A1 + (size_t)256 * D * 2;
constexpr size_t WB_W2 = WB_G1 + (size_t)256 * D * 2;
constexpr size_t WB_A2 = WB_W2 + (size_t)2 * D * 256 * 2;
constexpr size_t WB_G2 = WB_A2 + (size_t)2 * D * 256 * 2;
constexpr size_t WB_GU = WB_G2 + (size_t)D * 256 * 2;
constexpr size_t WB_DN = WB_GU + (size_t)2 * NEXP * 2 * DEXP * D * 2;
constexpr size_t WS_L = WB_DN + (size_t)2 * NEXP * D * DEXP * 2;
constexpr size_t WS_H = WS_L;
constexpr size_t WS_U = WS_H + (size_t)NTOK * D * 2;
constexpr size_t WS_Q = WS_U + (size_t)NTOK * AB_IN * 2;
constexpr size_t WS_K = WS_Q + (size_t)NTOK * ATTN_W * 2;
constexpr size_t WS_V = WS_K + (size_t)NB * KVLEN * KV_W * 2;
constexpr size_t WS_MP = WS_V + (size_t)NB * KVLEN * KV_W * 2;
constexpr size_t WS_CAT = WS_MP + (size_t)NTOK * POOL_W * 2;
constexpr size_t WS_L0END = WS_CAT + (size_t)NTOK * D * 2;
constexpr size_t WS_XS = WS_L;
constexpr size_t WS_DEC = WS_L;
constexpr size_t WS_AS = WS_DEC + (size_t)2 * NTOK * D * 4;
constexpr size_t WS_H1 = WS_AS + (size_t)2 * NTOK * D * 4;
constexpr size_t WS_G = WS_H1;
constexpr size_t WS_R = WS_H1 + (size_t)NTOK * D * 4;
constexpr size_t WS_KK = WS_R + (size_t)NTOK * D * 4;
constexpr size_t WS_VV = WS_KK + (size_t)NTOK * D * 4;
constexpr size_t WS_LW = WS_VV + (size_t)NTOK * D * 4;
constexpr size_t WS_LA = WS_LW + (size_t)NTOK * 256 * 2;
constexpr size_t WS_LG = WS_LA + (size_t)NTOK * 256 * 2;
constexpr size_t WS_YS = WS_LG + (size_t)NTOK * 256 * 2;
constexpr size_t WS_O = WS_YS + (size_t)2 * NLAT * D * 4;
constexpr size_t WS_L1END = WS_O + (size_t)NLAT * D * 2;
constexpr size_t WS_END2 = WS_L1END > WS_L0END ? WS_L1END : WS_L0END;
static_assert((size_t)6 * NTOK * D * 2 <= (size_t)4 * NTOK * D * 4, "XS fits under DEC|AS");
constexpr size_t WB_RT = al256(WS_END2);
constexpr size_t WS_END3 = WB_RT + (size_t)2 * 2 * NEXP * D * 2;
static_assert(WS_END3 <= 2147483648ull, "workspace fits the guaranteed 2 GiB and 32-bit offsets");

#ifndef YE_FP8_
#define YE_FP8_ 1
#endif
constexpr bool YE_FP8 = (YE_FP8_ != 0);  constexpr float YE_SCALE = 16.0f;
constexpr bool MOE8 = (MOE_FP8 != 0);
constexpr float MOE8_SW1 = 64.f, MOE8_SW2 = 32.f, MOE8_SACT = 4.f;
constexpr int LDS_BYTES = 147456;

typedef unsigned short bf16;
typedef float f32x4 __attribute__((ext_vector_type(4)));
typedef unsigned u32x2 __attribute__((ext_vector_type(2)));
typedef unsigned u32x4 __attribute__((ext_vector_type(4)));
#define LAS __attribute__((address_space(3)))
#define GAS __attribute__((address_space(1)))

__device__ __forceinline__ float bf2f(unsigned v) { return __uint_as_float(v << 16); }
__device__ __forceinline__ unsigned f2bf(float f) { unsigned u = __float_as_uint(f); return (u + 0x7fffu + ((u >> 16) & 1u)) >> 16; }
__device__ __forceinline__ unsigned pk2(float lo, float hi) { return f2bf(lo) | (f2bf(hi) << 16); }
__device__ __forceinline__ unsigned pk4_fp8(float a, float b, float cc, float d) {
    int w = __builtin_amdgcn_cvt_pk_fp8_f32(a, b, 0, false); w = __builtin_amdgcn_cvt_pk_fp8_f32(cc, d, w, true); return (unsigned)w; }
__device__ __forceinline__ int lane_now() { int t = threadIdx.x; asm volatile("" : "+v"(t)); return t & 63; }
__device__ __forceinline__ float shx(float v, int mask) { return __builtin_bit_cast(float, __builtin_amdgcn_ds_bpermute((lane_now() ^ mask) << 2, __builtin_bit_cast(int, v))); }
__device__ __forceinline__ int shi(int v, int src) { return __builtin_amdgcn_ds_bpermute(src << 2, v); }
typedef float f32x2 __attribute__((ext_vector_type(2)));
__device__ __forceinline__ float dpp_add(float v, float u) { return v + u; }
template <int CTRL> __device__ __forceinline__ float dpp_mov(float v) { return __builtin_bit_cast(float, __builtin_amdgcn_update_dpp(0, __builtin_bit_cast(int, v), CTRL, 0xF, 0xF, true)); }
__device__ __forceinline__ float sum8(float v) { v += dpp_mov<0xB1>(v); v += dpp_mov<0x4E>(v); v += dpp_mov<0x141>(v); return v; }
__device__ __forceinline__ float sum16(float v) { v = sum8(v); v += dpp_mov<0x140>(v); return v; }
__device__ __forceinline__ float rl_f(float v, int l) { return __builtin_bit_cast(float, __builtin_amdgcn_readlane(__builtin_bit_cast(int, v), l)); }
__device__ __forceinline__ float wsum(float v) { v = sum16(v); return (rl_f(v, 0) + rl_f(v, 16)) + (rl_f(v, 32) + rl_f(v, 48)); }
__device__ __forceinline__ float wmax(float v) {
    v = fmaxf(v, dpp_mov<0xB1>(v)); v = fmaxf(v, dpp_mov<0x4E>(v)); v = fmaxf(v, dpp_mov<0x141>(v)); v = fmaxf(v, dpp_mov<0x140>(v));
    return fmaxf(fmaxf(rl_f(v, 0), rl_f(v, 16)), fmaxf(rl_f(v, 32), rl_f(v, 48))); }
__device__ __forceinline__ float sigmoidf_(float x) { return __builtin_amdgcn_rcpf(1.0f + __expf(-x)); }

#define XB_TMO      128
#define XB_XCNT(j)  (256  + 64 * (j))
#define XB_XSUB(j)  (1280 + 64 * (j))
#define XB_XGEN(j)  (2304 + 64 * (j))
#define XB_TOP      3328
#define XB_TOPGEN   3392
#define XCD_BAR_WORDS 3456
#define XB_SPIN_CAP (1u << 18)
__device__ __forceinline__ unsigned xb_ld(unsigned* p)              { return __hip_atomic_load(p, __ATOMIC_RELAXED, __HIP_MEMORY_SCOPE_AGENT); }
__device__ __forceinline__ unsigned xb_add(unsigned* p, unsigned v) { return __hip_atomic_fetch_add(p, v, __ATOMIC_RELAXED, __HIP_MEMORY_SCOPE_AGENT); }
__device__ __forceinline__ unsigned xb_xcc_id() { return (unsigned)__builtin_amdgcn_s_getreg((3 << 11) | 20) & 0xFu; }
#define XB_SPIN(cond, bar) do { unsigned _sp = 0; while (cond) { __builtin_amdgcn_s_sleep(1); \
    if ((++_sp & 255u) == 0u) { if (xb_ld(&(bar)[XB_TMO])) break; if (_sp > XB_SPIN_CAP) { atomicAdd(&(bar)[XB_TMO], 1u); break; } } } } while (0)
struct XcdBarrier { unsigned* bar; unsigned x; volatile LAS unsigned* st; };
__device__ __forceinline__ XcdBarrier xcd_barrier_post(unsigned* bar, volatile LAS unsigned* st) {
    XcdBarrier b; b.bar = bar; b.x = xb_xcc_id(); b.st = st;
    if (threadIdx.x == 0) (void)xb_add(&bar[XB_XCNT(b.x)], 1u);
    return b;
}
__device__ __forceinline__ void xcd_barrier_complete(unsigned* bar, unsigned x, unsigned& nloc, unsigned& nx) {
    const unsigned G = gridDim.x * gridDim.y * gridDim.z;
    unsigned sum, cnt, mine, sp = 0u;
    for (;;) {
        sum = 0u; cnt = 0u; mine = 0u;
#pragma unroll
        for (unsigned j = 0; j < 16; ++j) { const unsigned c = xb_ld(&bar[XB_XCNT(j)]); sum += c; cnt += (c > 0u) ? 1u : 0u; mine = (j == x) ? c : mine; }
        if (sum == G) break;
        __builtin_amdgcn_s_sleep(1);
        if ((++sp & 255u) == 0u) { if (xb_ld(&bar[XB_TMO])) break; if (sp > XB_SPIN_CAP) { atomicAdd(&bar[XB_TMO], 1u); break; } }
    }
    nloc = mine > 0u ? mine : 1u; nx = cnt > 0u ? cnt : 1u;
}
__device__ __forceinline__ void xcd_barrier(const XcdBarrier& b) {
    asm volatile("s_waitcnt vmcnt(0)" ::: "memory");
    __syncthreads();
    if (threadIdx.x == 0) {
        unsigned* bar = b.bar; asm volatile("" : "+s"(bar));
        __builtin_amdgcn_s_waitcnt(0);
        unsigned nloc = b.st[0], nx = b.st[1];
        if (nloc == 0u) { xcd_barrier_complete(bar, b.x, nloc, nx); b.st[0] = nloc; b.st[1] = nx; }
        const unsigned old = xb_add(&bar[XB_XSUB(b.x)], 1u);
        const unsigned gen = old / nloc;
        if (old + 1u == (gen + 1u) * nloc) {
            __builtin_amdgcn_fence(__ATOMIC_RELEASE, "agent");
            asm volatile("s_waitcnt vmcnt(0)" ::: "memory");
            const unsigned og = xb_add(&bar[XB_TOP], 1u);
            const unsigned tg = og / nx;
            if (og + 1u == (tg + 1u) * nx) xb_add(&bar[XB_TOPGEN], 1u);
            else XB_SPIN(xb_ld(&bar[XB_TOPGEN]) == tg, bar);
            __builtin_amdgcn_fence(__ATOMIC_ACQUIRE, "agent");
            xb_add(&bar[XB_XGEN(b.x)], 1u);
            asm volatile("s_waitcnt vmcnt(0)" ::: "memory");
        } else {
            XB_SPIN(xb_ld(&bar[XB_XGEN(b.x)]) == gen, bar);
            __builtin_amdgcn_fence(__ATOMIC_ACQUIRE, "agent");
            asm volatile("s_waitcnt vmcnt(0)" ::: "memory");
        }
    }
    __syncthreads();
}

struct Args { const float* in[39]; float* out; unsigned char* ws; int ph_lo, ph_hi; };
enum { I_X = 0, I_C, I_CTX, I_CCTX, I_WMOD, I_BMOD, I_NORMG, I_WIN, I_QGAIN, I_KGAIN, I_POOLW, I_POOLS, I_WOUT, I_MIX, I_WR, I_WK, I_WV, I_WO,
       I_W0, I_W1, I_W2, I_A0, I_A1, I_A2, I_G1, I_G2, I_KK, I_KA, I_RK, I_LNW, I_LNB, I_ROUTW, I_ROUTB, I_WGATE, I_BGATE, I_WUP, I_BUP, I_WDOWN, I_BDOWN };

struct Ctx {
    float* out; unsigned char* ws; LAS unsigned char* lds; int tid, lane, wave, gw, ngw, bid, G;
};
#if defined(__HIP_DEVICE_COMPILE__)
#define ASSUME_GLOBAL(p) do { __builtin_assume(!__builtin_amdgcn_is_shared((const void*)(p))); __builtin_assume(!__builtin_amdgcn_is_private((const void*)(p))); } while (0)
#else
#define ASSUME_GLOBAL(p) do { } while (0)
#endif
constexpr int PTAB_OFF = LDS_BYTES - 1024;
__device__ __forceinline__ const float* inp(const Ctx& c, int i) {
    const LAS unsigned* t = (const LAS unsigned*)(c.lds + PTAB_OFF) + 2 * i;
    const unsigned lo = __builtin_amdgcn_readfirstlane(t[0]), hi = __builtin_amdgcn_readfirstlane(t[1]);
    return (const float*)(const GAS float*)(((unsigned long long)hi << 32) | lo);
}
__device__ __forceinline__ const float* modp(const Ctx& c, int layer, int who, int part) { return (const float*)(c.ws + WS_MOD) + ((size_t)(layer * 3 + who) * 6 + part) * D; }
struct RowInfo { int b, t, n, who, seq0; };
__device__ __forceinline__ RowInfo rowinfo(int row) {
    RowInfo r;
    if (row < NLAT) { r.b = row / SEQ; r.t = row % SEQ; r.n = SEQ; r.who = r.b; r.seq0 = r.b * SEQ; }
    else { const int rc = row - NLAT; r.b = rc / CTXL; r.t = rc % CTXL; r.n = CTXL; r.who = 2; r.seq0 = NLAT + r.b * CTXL; }
    return r;
}

struct GemmS { const bf16* A; int lda; const int* gather; int M; const float* B; int ldb; int N; int K; };
template <class Epi>
__device__ __forceinline__ void sgemm_unit(const Ctx& c, const GemmS& g, int m0, int n0, const Epi& epi) {
    LAS float* As = (LAS float*)c.lds;
    LAS float* Bs = As + 16 * 132;
    const int tid = c.tid, ty = tid >> 5, tx = tid & 31;
    float acc[8][4];
#pragma unroll
    for (int i = 0; i < 8; ++i)
#pragma unroll
        for (int j = 0; j < 4; ++j) acc[i][j] = 0.f;
    const int ar = tid >> 2, akq = (tid & 3) * 4;
    const int arow_l = m0 + ar;
    long arow = -1;
    if (arow_l < g.M) arow = g.gather ? (long)g.gather[arow_l] : (long)arow_l;
    const int bk = tid >> 5, bn = (tid & 31) * 4;
    const bool bok = (n0 + bn) < g.N;
    for (int k0 = 0; k0 < g.K; k0 += 16) {
        u32x2 av = (u32x2){0u, 0u};
        if (arow >= 0) av = *(const u32x2*)(g.A + arow * g.lda + k0 + akq);
        f32x4 bv = (f32x4){0.f, 0.f, 0.f, 0.f};
        if (bok) bv = *(const f32x4*)(g.B + (size_t)(k0 + bk) * g.ldb + n0 + bn);
        __syncthreads();
        As[(akq + 0) * 132 + ar] = bf2f(av.x & 0xffffu); As[(akq + 1) * 132 + ar] = bf2f(av.x >> 16);
        As[(akq + 2) * 132 + ar] = bf2f(av.y & 0xffffu); As[(akq + 3) * 132 + ar] = bf2f(av.y >> 16);
        *(LAS f32x4*)(Bs + bk * 128 + bn) = bv;
        __syncthreads();
#pragma unroll
        for (int k = 0; k < 16; ++k) {
            const f32x4 a0 = *(const LAS f32x4*)(As + k * 132 + ty * 8), a1 = *(const LAS f32x4*)(As + k * 132 + ty * 8 + 4);
            const f32x4 b = *(const LAS f32x4*)(Bs + k * 128 + tx * 4);
            const float a[8] = {a0.x, a0.y, a0.z, a0.w, a1.x, a1.y, a1.z, a1.w};
#pragma unroll
            for (int i = 0; i < 8; ++i) { acc[i][0] += a[i] * b.x; acc[i][1] += a[i] * b.y; acc[i][2] += a[i] * b.z; acc[i][3] += a[i] * b.w; }
        }
    }
#pragma unroll
    for (int i = 0; i < 8; ++i) {
        const int r = m0 + ty * 8 + i;
        if (r < g.M) {
#pragma unroll
            for (int j = 0; j < 4; ++j) { const int cc = n0 + tx * 4 + j; if (cc < g.N) epi(r, cc, acc[i][j]); }
        }
    }
}
template <class Epi>
__device__ __forceinline__ void sgemm_all(const Ctx& c, const GemmS& g, const Epi& epi, int u0, int ustride) {
    const int nM = (g.M + 127) / 128, nN = (g.N + 127) / 128;
    for (int u = u0; u < nM * nN; u += ustride) sgemm_unit(c, g, (u / nN) * 128, (u % nN) * 128, epi);
}

struct EpiStoreBf16 { bf16* C; int ldc; __device__ __forceinline__ void operator()(int r, int cc, float v) const { C[(size_t)r * ldc + cc] = (bf16)f2bf(v); } };
struct EpiStoreF32 { float* C; int ldc; __device__ __forceinline__ void operator()(int r, int cc, float v) const { C[(size_t)r * ldc + cc] = v; } };
struct EpiPool { bf16* C; const float* scale; __device__ __forceinline__ void operator()(int r, int cc, float v) const { C[(size_t)r * D + cc] = (bf16)f2bf(v * scale[cc]); } };
struct EpiTanhBf16 { bf16* C; int ldc; __device__ __forceinline__ void operator()(int r, int cc, float v) const { C[(size_t)r * ldc + cc] = (bf16)f2bf(tanhf(v)); } };
struct EpiSigBf16 { bf16* C; int ldc; __device__ __forceinline__ void operator()(int r, int cc, float v) const { C[(size_t)r * ldc + cc] = (bf16)f2bf(sigmoidf_(v)); } };
struct EpiDecay { float* C; const float* w0; __device__ __forceinline__ void operator()(int r, int cc, float v) const {
    const float z = -(w0[cc] + v);
    const float sp = (z > 20.f) ? z : log1pf(__expf(z));
    C[(size_t)r * D + cc] = __expf(-__expf(-sp - 0.5f)); } };
struct EpiSigBias { float* C; const float* a0; __device__ __forceinline__ void operator()(int r, int cc, float v) const { C[(size_t)r * D + cc] = sigmoidf_(a0[cc] + v); } };
struct EpiGateTmp { float* GT; const float* bias; int slot0; __device__ __forceinline__ void operator()(int r, int cc, float v) const { GT[(size_t)(slot0 + r) * DEXP + cc] = v + bias[cc]; } };
struct EpiUpAct { const float* GT; bf16* ACT; const float* bias; int slot0; __device__ __forceinline__ void operator()(int r, int cc, float v) const {
    const float glu = fminf(GT[(size_t)(slot0 + r) * DEXP + cc], 7.0f);
    const float lin = fminf(fmaxf(v + bias[cc], -7.0f), 7.0f);
    ACT[(size_t)(slot0 + r) * DEXP + cc] = (bf16)f2bf(glu * sigmoidf_(1.702f * glu) * (lin + 1.0f)); } };
struct EpiDown { bf16* YE; const float* bias; const float* gate; int slot0; __device__ __forceinline__ void operator()(int r, int cc, float v) const {
    YE[(size_t)(slot0 + r) * D + cc] = (bf16)f2bf((v + bias[cc]) * gate[r]); } };


namespace pg8 {
#define PG8_LAS __attribute__((address_space(3)))
typedef short bf16x8 __attribute__((ext_vector_type(8)));
constexpr int BM = 256, BK = 64, HALF = 128, HTB = HALF * BK * 2, STAGE_BYTES = 8 * HTB, NXCD = 8, WGM = 8;
__host__ __device__ __forceinline__ int lds_byte(int r, int c) { const int st = (r >> 4) * 2 + (c >> 5), rr = r & 15, cc = c & 31, ob = rr * 64 + cc * 2; return st * 1024 + (ob ^ (((ob >> 9) & 1) << 5)); }
__host__ __device__ __forceinline__ void stage_rc(int b, int& R, int& C) { const int st = b / 1024, sb = b % 1024, swz = sb ^ (((sb >> 9) & 1) << 5); R = (st >> 1) * 16 + swz / 64; C = (st & 1) * 32 + (swz % 64) / 2; }
__host__ __device__ __forceinline__ int perm32(int rho) { const int n = rho >> 4, i = rho & 15; return 8 * (i >> 2) + 4 * n + (i & 3); }
__device__ __forceinline__ unsigned cvt_pk_bf16(float lo, float hi) { unsigned r; asm volatile("v_cvt_pk_bf16_f32 %0, %1, %2" : "=v"(r) : "v"(lo), "v"(hi)); return r; }

struct UnitD {
    unsigned A;
    unsigned B;
    unsigned gather;
    int lda2, ldb2;
    int nt;
    int row0, col0;
    int nvalid;
    int aux, aux2;
};
__device__ __forceinline__ bool static_tile(int nM, int nN, int G, int c, int i, int& pm, int& pn) {
    const int nwg = nM * nN; const long L = (long)i * G + c; if (L >= nwg) return false;
    int wgid = (int)L; { const int q = nwg / NXCD, r = nwg % NXCD, xcd = wgid % NXCD, off = wgid / NXCD; wgid = (xcd < r ? xcd * (q + 1) : r * (q + 1) + (xcd - r) * q) + off; }
    const int nig = WGM * nN, gid = wgid / nig, fm = gid * WGM, gsz = (nM - fm) < WGM ? (nM - fm) : WGM;
    pm = fm + ((wgid % nig) % gsz); pn = (wgid % nig) / gsz; return true;
}
typedef int v8i32 __attribute__((ext_vector_type(8)));
template <bool F8, bool GATHER, class Epi, class Sched>
__device__ __forceinline__ void gemm_phase_t(PG8_LAS unsigned char* lds, const char* wsb, const Sched& S, const Epi& E) {
    int tid = threadIdx.x; asm volatile("" : "+v"(tid));
    const int wid = __builtin_amdgcn_readfirstlane(tid >> 6), lane = tid & 63, wr = wid >> 2, wc = wid & 3, fr = lane & 15, fq = lane >> 4;
#define PG8_RC(tv) int R0, C0, R1, C1; stage_rc((tv) * 16, R0, C0); stage_rc((tv) * 16 + 8192, R1, C1); const int Rb0 = (R0 & ~31) + perm32(R0 & 31), Rb1 = (R1 & ~31) + perm32(R1 & 31)
    const unsigned kstep = (unsigned)(BK * 2);
    const unsigned ldsw = (unsigned)wid * 1024u;
    const int aoff = F8 ? lds_byte(wr * 64 + fr, fq * 16) : lds_byte(wr * 64 + fr, fq * 8), boff = F8 ? lds_byte(wc * 32 + fr, fq * 16) : lds_byte(wc * 32 + fr, fq * 8);
#define PG8_SA(b, h) (((b) * 2 + (h)) * HTB)
#define PG8_SB(b, h) ((4 + (b) * 2 + (h)) * HTB)
#define PG8_STAGE(bufoff, gbase, v0, v1) do { \
        __builtin_amdgcn_global_load_lds((const unsigned*)(wsb + (size_t)(unsigned)((gbase) + (v0))), (PG8_LAS unsigned*)(lds + (bufoff) + ldsw), 16, 0, 0); \
        __builtin_amdgcn_global_load_lds((const unsigned*)(wsb + (size_t)(unsigned)((gbase) + (v1))), (PG8_LAS unsigned*)(lds + (bufoff) + ldsw + 8192), 16, 0, 0); } while (0)
#define PG8_LD8(addr_) ({ const u32x4 l_ = *(const PG8_LAS u32x4*)(addr_), h_ = *(const PG8_LAS u32x4*)((addr_) + 16); (v8i32){(int)l_.x, (int)l_.y, (int)l_.z, (int)l_.w, (int)h_.x, (int)h_.y, (int)h_.z, (int)h_.w}; })
#define PG8_LDA(dst, b, h) do { if constexpr (F8) { _Pragma("unroll") for (int m = 0; m < 4; ++m) dst##8[m] = PG8_LD8(lds + PG8_SA(b, h) + aoff + m * 2048); } \
        else { _Pragma("unroll") for (int m = 0; m < 4; ++m) _Pragma("unroll") for (int k = 0; k < 2; ++k) dst[m][k] = *(const PG8_LAS bf16x8*)(lds + PG8_SA(b, h) + aoff + m * 2048 + k * 1024); } } while (0)
#define PG8_LDB(dst, b, h) do { if constexpr (F8) { _Pragma("unroll") for (int n = 0; n < 2; ++n) dst##8[n] = PG8_LD8(lds + PG8_SB(b, h) + boff + n * 2048); } \
        else { _Pragma("unroll") for (int n = 0; n < 2; ++n) _Pragma("unroll") for (int k = 0; k < 2; ++k) dst[n][k] = *(const PG8_LAS bf16x8*)(lds + PG8_SB(b, h) + boff + n * 2048 + k * 1024); } } while (0)
#define PG8_MMA(ai, bj, At, Bt) do { __builtin_amdgcn_s_setprio(1); _Pragma("unroll") for (int m = 0; m < 4; ++m) _Pragma("unroll") for (int n = 0; n < 2; ++n) { \
        if constexpr (F8) { acc[ai][bj][m][n] = __builtin_amdgcn_mfma_scale_f32_16x16x128_f8f6f4(Bt##8[n], At##8[m], acc[ai][bj][m][n], 0, 0, 0, 0x7f7f7f7f, 0, 0x7f7f7f7f); } \
        else { _Pragma("unroll") for (int k = 0; k < 2; ++k) acc[ai][bj][m][n] = __builtin_amdgcn_mfma_f32_16x16x32_bf16(Bt[n][k], At[m][k], acc[ai][bj][m][n], 0, 0, 0); } } \
        __builtin_amdgcn_s_setprio(0); } while (0)
#define PG8_WAIT_V(n) asm volatile("s_waitcnt vmcnt(" #n ")" ::: "memory")
#define PG8_WAIT_L(n) asm volatile("s_waitcnt lgkmcnt(" #n ")" ::: "memory")
#define PG8_BAR __builtin_amdgcn_s_barrier()
#define PG8_SCHED __builtin_amdgcn_sched_barrier(0)
#define PG8_RFL(x) x = __builtin_amdgcn_readfirstlane(x)
#define PG8_OPAQUE(u) do { PG8_RFL((u).A); PG8_RFL((u).B); PG8_RFL((u).gather); PG8_RFL((u).lda2); PG8_RFL((u).ldb2); PG8_RFL((u).nt); PG8_RFL((u).row0); PG8_RFL((u).col0); PG8_RFL((u).nvalid); PG8_RFL((u).aux); PG8_RFL((u).aux2); \
        asm volatile("" : "+s"((u).A), "+s"((u).B), "+s"((u).gather), "+s"((u).lda2), "+s"((u).ldb2), "+s"((u).nt)); \
        asm volatile("" : "+s"((u).row0), "+s"((u).col0), "+s"((u).nvalid), "+s"((u).aux), "+s"((u).aux2)); } while (0)
#define PG8_SETV(u, vA00, vA01, vA10, vA11, vB0, vB1) do { \
        int r00 = R0, r01 = R1, r10 = R0 + HALF, r11 = R1 + HALF; \
        if (GATHER && (u).gather) { const int* gp_ = (const int*)(wsb + (u).gather); r00 = gp_[r00]; r01 = gp_[r01]; r10 = gp_[r10]; r11 = gp_[r11]; \
            r00 = (unsigned)r00 < (unsigned)NTOK ? r00 : 0; r01 = (unsigned)r01 < (unsigned)NTOK ? r01 : 0; r10 = (unsigned)r10 < (unsigned)NTOK ? r10 : 0; r11 = (unsigned)r11 < (unsigned)NTOK ? r11 : 0; } \
        vA00 = (unsigned)(r00 * (u).lda2 + C0 * 2); vA01 = (unsigned)(r01 * (u).lda2 + C1 * 2); vA10 = (unsigned)(r10 * (u).lda2 + C0 * 2); vA11 = (unsigned)(r11 * (u).lda2 + C1 * 2); \
        vB0 = (unsigned)(Rb0 * (u).ldb2 + C0 * 2); vB1 = (unsigned)(Rb1 * (u).ldb2 + C1 * 2); } while (0)
    UnitD cur, nxt; int ui = 0;
    if (!S.next(0, cur)) return;
    PG8_OPAQUE(cur);
    f32x4 acc[2][2][4][2];
#pragma unroll
    for (int a = 0; a < 2; ++a)
#pragma unroll
        for (int b = 0; b < 2; ++b)
#pragma unroll
            for (int m = 0; m < 4; ++m)
#pragma unroll
                for (int n = 0; n < 2; ++n) acc[a][b][m][n] = (f32x4){0.f, 0.f, 0.f, 0.f};
    bf16x8 At[F8 ? 1 : 4][2], B0[F8 ? 1 : 2][2], B1[F8 ? 1 : 2][2];
    v8i32 At8[F8 ? 4 : 1], B08[F8 ? 2 : 1], B18[F8 ? 2 : 1];
    (void)At; (void)B0; (void)B1; (void)At8; (void)B08; (void)B18;
    unsigned vA00, vA01, vA10, vA11, vB0, vB1;
    { PG8_RC(tid); PG8_SETV(cur, vA00, vA01, vA10, vA11, vB0, vB1); }
    unsigned cA = cur.A, cB = cur.B, chB = (unsigned)HALF * cur.ldb2;
    PG8_STAGE(PG8_SB(0, 0), cB, vB0, vB1); PG8_STAGE(PG8_SB(0, 1), cB + chB, vB0, vB1); PG8_STAGE(PG8_SA(0, 0), cA, vA00, vA01); PG8_STAGE(PG8_SA(0, 1), cA, vA10, vA11);
    if (wr == 1) PG8_BAR;
    PG8_WAIT_V(2); PG8_BAR;
    PG8_STAGE(PG8_SB(1, 0), cB + kstep, vB0, vB1); PG8_STAGE(PG8_SA(1, 0), cA + kstep, vA00, vA01); PG8_STAGE(PG8_SB(1, 1), cB + chB + kstep, vB0, vB1);
    PG8_WAIT_V(6); PG8_BAR;
    for (;;) {
        bool has_next = S.next(ui + 1, nxt);
        if (!has_next) { nxt = cur; }
        PG8_OPAQUE(nxt);
        { int hn = __builtin_amdgcn_readfirstlane(has_next ? 1 : 0); asm volatile("" : "+s"(hn)); has_next = hn != 0; }
        const int nt = cur.nt;
        const unsigned nAp = has_next ? nxt.A : cA, nBp = has_next ? nxt.B : cB, nhB = has_next ? (unsigned)HALF * nxt.ldb2 : chB;
        for (int t = 0; t < nt; t += 2) {
            const bool last = (t == nt - 2);
            const unsigned a1 = cA + (unsigned)(t + 1) * kstep;
            const unsigned a2 = last ? nAp : cA + (unsigned)(t + 2) * kstep, b2 = last ? nBp : cB + (unsigned)(t + 2) * kstep, hb2 = last ? nhB : chB;
            const unsigned a3 = a2 + kstep, b3 = b2 + kstep;
            int g00 = 0, g01 = 0, g10 = 0, g11 = 0;
            const bool sw = last && has_next;
            if (GATHER && sw && nxt.gather) {
                int t2 = threadIdx.x; asm volatile("" : "+v"(t2)); PG8_RC(t2); (void)Rb0; (void)Rb1; (void)C0; (void)C1;
                const int* gp_ = (const int*)(wsb + nxt.gather); const int o0 = R0 * 4, o1 = R1 * 4, o2 = (R0 + HALF) * 4, o3 = (R1 + HALF) * 4;
                asm volatile("global_load_dword %0, %1, %2" : "=v"(g00) : "v"(o0), "s"(gp_) : "memory");
                asm volatile("global_load_dword %0, %1, %2" : "=v"(g01) : "v"(o1), "s"(gp_) : "memory");
                asm volatile("global_load_dword %0, %1, %2" : "=v"(g10) : "v"(o2), "s"(gp_) : "memory");
                asm volatile("global_load_dword %0, %1, %2" : "=v"(g11) : "v"(o3), "s"(gp_) : "memory"); }
            PG8_LDB(B0, 0, 0); PG8_LDB(B1, 0, 1); PG8_SCHED; PG8_LDA(At, 0, 0); PG8_STAGE(PG8_SA(1, 1), a1, vA10, vA11);
            PG8_WAIT_V(8); PG8_WAIT_L(0); PG8_BAR; PG8_MMA(0, 0, At, B0); PG8_MMA(0, 1, At, B1); PG8_BAR; PG8_SCHED;
            if (sw) {
                int t3 = threadIdx.x; asm volatile("" : "+v"(t3)); PG8_RC(t3);
                if (!GATHER || !nxt.gather) { g00 = R0; g01 = R1; g10 = R0 + HALF; g11 = R1 + HALF; }
                else { asm volatile("s_waitcnt vmcnt(2)" : "+v"(g00), "+v"(g01), "+v"(g10), "+v"(g11) :: "memory");
                    g00 = (unsigned)g00 < (unsigned)NTOK ? g00 : 0; g01 = (unsigned)g01 < (unsigned)NTOK ? g01 : 0; g10 = (unsigned)g10 < (unsigned)NTOK ? g10 : 0; g11 = (unsigned)g11 < (unsigned)NTOK ? g11 : 0; }
                vA00 = (unsigned)(g00 * nxt.lda2 + C0 * 2); vA01 = (unsigned)(g01 * nxt.lda2 + C1 * 2); vA10 = (unsigned)(g10 * nxt.lda2 + C0 * 2); vA11 = (unsigned)(g11 * nxt.lda2 + C1 * 2);
                vB0 = (unsigned)(Rb0 * nxt.ldb2 + C0 * 2); vB1 = (unsigned)(Rb1 * nxt.ldb2 + C1 * 2); }
            PG8_LDA(At, 0, 1); PG8_STAGE(PG8_SB(0, 0), b2, vB0, vB1); PG8_STAGE(PG8_SB(0, 1), b2 + hb2, vB0, vB1); PG8_STAGE(PG8_SA(0, 0), a2, vA00, vA01);
            PG8_WAIT_V(8); PG8_WAIT_L(0); PG8_BAR; PG8_MMA(1, 0, At, B0); PG8_MMA(1, 1, At, B1); PG8_BAR; PG8_SCHED;
            PG8_LDB(B0, 1, 0); PG8_LDB(B1, 1, 1); PG8_SCHED; PG8_LDA(At, 1, 0); PG8_STAGE(PG8_SA(0, 1), a2, vA10, vA11);
            PG8_WAIT_V(8); PG8_WAIT_L(0); PG8_BAR; PG8_MMA(0, 0, At, B0); PG8_MMA(0, 1, At, B1); PG8_BAR; PG8_SCHED;
            PG8_LDA(At, 1, 1); PG8_STAGE(PG8_SB(1, 0), b3, vB0, vB1); PG8_STAGE(PG8_SB(1, 1), b3 + hb2, vB0, vB1); PG8_STAGE(PG8_SA(1, 0), a3, vA00, vA01);
            PG8_WAIT_V(8); PG8_WAIT_L(0); PG8_BAR; PG8_MMA(1, 0, At, B0); PG8_MMA(1, 1, At, B1); PG8_BAR; PG8_SCHED;
        }
        if (wr == 0) PG8_BAR;
        { int fr_ = fr, fq_ = fq; asm volatile("" : "+v"(fr_), "+v"(fq_));
          E(acc, cur, wr, wc, fr_, fq_); }
        if (!has_next) break;
#pragma unroll
        for (int a = 0; a < 2; ++a)
#pragma unroll
            for (int b = 0; b < 2; ++b)
#pragma unroll
                for (int m = 0; m < 4; ++m)
#pragma unroll
                    for (int n = 0; n < 2; ++n) acc[a][b][m][n] = (f32x4){0.f, 0.f, 0.f, 0.f};
        cur = nxt; cA = nAp; cB = nBp; chB = nhB; ++ui;
        if (wr == 1) PG8_BAR;
    }
    PG8_WAIT_V(0);
    PG8_BAR;
#undef PG8_SA
#undef PG8_SB
#undef PG8_STAGE
#undef PG8_LDA
#undef PG8_LDB
#undef PG8_MMA
#undef PG8_LD8
#undef PG8_WAIT_V
#undef PG8_WAIT_L
#undef PG8_BAR
#undef PG8_SCHED
#undef PG8_SETV
#undef PG8_RC
#undef PG8_OPAQUE
#undef PG8_RFL
}
template <class Epi, class Sched> __device__ __forceinline__ void gemm_phase(PG8_LAS unsigned char* lds, const char* wsb, const Sched& S, const Epi& E) { gemm_phase_t<false, false>(lds, wsb, S, E); }
struct PlainSched {
    unsigned A, B; int lda2, ldb2, nt, nM, nN, G, c;
    __device__ __forceinline__ bool next(int i, UnitD& u) const {
        int pm, pn; if (!static_tile(nM, nN, G, c, i, pm, pn)) return false;
        u.A = A + (unsigned)(pm * BM * lda2); u.B = B + (unsigned)(pn * BM * ldb2); u.gather = 0u; u.lda2 = lda2; u.ldb2 = ldb2; u.nt = nt; u.row0 = pm * BM; u.col0 = pn * BM; u.nvalid = BM; u.aux = 0; u.aux2 = 0; return true; }
};
struct EpiF32 { float* C; int ldc;
    __device__ __forceinline__ void operator()(const f32x4 (&acc)[2][2][4][2], const UnitD& u, int wr, int wc, int fr, int fq) const {
#pragma unroll
        for (int ai = 0; ai < 2; ++ai)
#pragma unroll
            for (int m = 0; m < 4; ++m) { const int r = ai * HALF + wr * 64 + m * 16 + fr; float* rowp = C + (size_t)(u.row0 + r) * ldc + u.col0 + wc * 32 + 8 * fq;
                if (r < u.nvalid) {
#pragma unroll
                    for (int bj = 0; bj < 2; ++bj) { *(f32x4*)(rowp + bj * HALF) = acc[ai][bj][m][0]; *(f32x4*)(rowp + bj * HALF + 4) = acc[ai][bj][m][1]; } } }
    }
};
struct EpiB16 { bf16* C; int ldc;
    __device__ __forceinline__ void operator()(const f32x4 (&acc)[2][2][4][2], const UnitD& u, int wr, int wc, int fr, int fq) const {
#pragma unroll
        for (int ai = 0; ai < 2; ++ai)
#pragma unroll
            for (int m = 0; m < 4; ++m) { const int r = ai * HALF + wr * 64 + m * 16 + fr; bf16* rowp = C + (size_t)(u.row0 + r) * ldc + u.col0 + wc * 32 + 8 * fq;
                if (r < u.nvalid) {
#pragma unroll
                    for (int bj = 0; bj < 2; ++bj) { const f32x4 v0 = acc[ai][bj][m][0], v1 = acc[ai][bj][m][1];
                        u32x4 w; w.x = cvt_pk_bf16(v0[0], v0[1]); w.y = cvt_pk_bf16(v0[2], v0[3]); w.z = cvt_pk_bf16(v1[0], v1[1]); w.w = cvt_pk_bf16(v1[2], v1[3]);
                        *(u32x4*)(rowp + bj * HALF) = w; } } }
    }
};
template <int NJ> struct JobSched {
    unsigned A[NJ], B[NJ]; int nM[NJ], nN[NJ], lda2[NJ], ldb2[NJ], nt[NJ]; int G, c;
    template <int J> __device__ __forceinline__ bool nextj(int L, UnitD& u) const {
        if constexpr (J >= NJ) { return false; }
        else { const int nw = nM[J] * nN[J];
            if (L < nw) { const int pm = L / nN[J], pn = L % nN[J];
                u.A = A[J] + (unsigned)(pm * BM * lda2[J]); u.B = B[J] + (unsigned)(pn * BM * ldb2[J]); u.gather = 0u; u.lda2 = lda2[J]; u.ldb2 = ldb2[J]; u.nt = nt[J];
                u.row0 = pm * BM; u.col0 = pn * BM; u.nvalid = BM; u.aux = J; u.aux2 = 0; return true; }
            return nextj<J + 1>(L - nw, u); } }
    __device__ __forceinline__ bool next(int i, UnitD& u) const { return nextj<0>(i * G + ((G & 7) == 0 ? (c & 7) * (G >> 3) + (c >> 3) : c), u); }
};
template <int NJ> struct EpiF32J { float* C[NJ]; int ldc;
    __device__ __forceinline__ void operator()(const f32x4 (&acc)[2][2][4][2], const UnitD& u, int wr, int wc, int fr, int fq) const {
        float* Cb = C[0];
#pragma unroll
        for (int j = 1; j < NJ; ++j) if (u.aux == j) Cb = C[j];
        EpiF32 e{Cb, ldc}; e(acc, u, wr, wc, fr, fq); }
};

struct MoeSched {
    const PG8_LAS int* tb; int G, c, NP; bool gu;
    unsigned wB; int layer;
    __device__ __forceinline__ bool next(int i, UnitD& u) const {
        const int L = i * G + ((G & 7) == 0 ? (c & 7) * (G >> 3) + (c >> 3) : c), tix = L / NP, pn = L % NP;
        if (tix >= tb[96]) return false;
        int e = 0;
        for (int q = 1; q < NEXP; ++q) if (tb[64 + q] <= tix) e = q;
        e = __builtin_amdgcn_readfirstlane(e);
        const int mt = tix - __builtin_amdgcn_readfirstlane(tb[64 + e]), cnt = __builtin_amdgcn_readfirstlane(tb[e]), base = __builtin_amdgcn_readfirstlane(tb[32 + e]);
        u.nvalid = cnt - mt * BM < BM ? cnt - mt * BM : BM; u.row0 = base + mt * BM; u.aux = e; u.aux2 = mt * BM;
        constexpr int EB = MOE8 ? 1 : 2;
        if (gu) { u.A = (unsigned)WS_F; u.gather = (unsigned)(WS_LIST + ((size_t)e * LISTCAP + (size_t)mt * BM) * 4); u.lda2 = D * EB; u.ldb2 = D * EB; u.nt = D * EB / 128;
                  u.B = wB + (unsigned)e * (unsigned)(2 * DEXP * D * EB) + (unsigned)pn * (unsigned)(BM * D * EB); u.col0 = pn * 128; }
        else { u.A = (unsigned)(WS_ACT + (size_t)(base + mt * BM) * DEXP * EB); u.gather = 0u; u.lda2 = DEXP * EB; u.ldb2 = DEXP * EB; u.nt = DEXP * EB / 128;
               u.B = wB + (unsigned)e * (unsigned)(D * DEXP * EB) + (unsigned)pn * (unsigned)(BM * DEXP * EB); u.col0 = pn * BM; }
        return true; }
};
__device__ __forceinline__ void st8_bf16(bf16* p, const f32x4& v0, const f32x4& v1) { u32x4 w; w.x = cvt_pk_bf16(v0[0], v0[1]); w.y = cvt_pk_bf16(v0[2], v0[3]); w.z = cvt_pk_bf16(v1[0], v1[1]); w.w = cvt_pk_bf16(v1[2], v1[3]); *(u32x4*)p = w; }
__device__ __forceinline__ float sigm(float x) { return __builtin_amdgcn_rcpf(1.0f + __expf(-x)); }
__device__ __forceinline__ float rate1(float x) { return 0.60653066f * sigm(x); }
struct EpiPoolS { bf16* CAT; const float* scale;
    __device__ __forceinline__ void operator()(const f32x4 (&acc)[2][2][4][2], const UnitD& u, int wr, int wc, int fr, int fq) const {
        const int cb = u.aux * 256 + wc * 32 + 8 * fq;
        f32x4 sv[2][2];
#pragma unroll
        for (int bj = 0; bj < 2; ++bj) { sv[bj][0] = *(const f32x4*)(scale + cb + bj * HALF); sv[bj][1] = *(const f32x4*)(scale + cb + bj * HALF + 4); }
#pragma unroll
        for (int ai = 0; ai < 2; ++ai)
#pragma unroll
            for (int m = 0; m < 4; ++m) { const int r = ai * HALF + wr * 64 + m * 16 + fr; bf16* rowp = CAT + (size_t)(u.row0 + r) * D + ATTN_W + cb;
#pragma unroll
                for (int bj = 0; bj < 2; ++bj) st8_bf16(rowp + bj * HALF, acc[ai][bj][m][0] * sv[bj][0], acc[ai][bj][m][1] * sv[bj][1]); }
    }
};
struct EpiSwiglu { bf16* ACT; const float* bg; const float* bu;
    __device__ __forceinline__ void operator()(const f32x4 (&acc)[2][2][4][2], const UnitD& u, int wr, int wc, int fr, int fq) const {
        const int cb = u.col0 + wc * 32 + 8 * fq; const float* pg = bg + u.aux * DEXP + cb; const float* pu = bu + u.aux * DEXP + cb;
        f32x4 g0 = *(const f32x4*)pg, g1 = *(const f32x4*)(pg + 4), u0 = *(const f32x4*)pu, u1 = *(const f32x4*)(pu + 4);
        asm volatile("" : "+v"(g0), "+v"(g1), "+v"(u0), "+v"(u1));
#pragma unroll
        for (int ai = 0; ai < 2; ++ai)
#pragma unroll
            for (int m = 0; m < 4; ++m) { const int r = ai * HALF + wr * 64 + m * 16 + fr;
                constexpr float dq = MOE8 ? 1.0f / MOE8_SW1 : 1.0f;
                f32x4 a0 = acc[ai][0][m][0] * dq + g0, a1 = acc[ai][0][m][1] * dq + g1, l0 = acc[ai][1][m][0] * dq + u0, l1 = acc[ai][1][m][1] * dq + u1;
#pragma unroll
                for (int j = 0; j < 4; ++j) { const float x0 = fminf(a0[j], 7.0f), x1 = fminf(a1[j], 7.0f); const float y0 = fminf(fmaxf(l0[j], -7.0f), 7.0f), y1 = fminf(fmaxf(l1[j], -7.0f), 7.0f);
                    a0[j] = x0 * sigm(1.702f * x0) * (y0 + 1.0f); a1[j] = x1 * sigm(1.702f * x1) * (y1 + 1.0f); }
                if (r < u.nvalid) {
                    if constexpr (MOE8) { u32x2 w8; w8.x = pk4_fp8(a0[0] * MOE8_SACT, a0[1] * MOE8_SACT, a0[2] * MOE8_SACT, a0[3] * MOE8_SACT); w8.y = pk4_fp8(a1[0] * MOE8_SACT, a1[1] * MOE8_SACT, a1[2] * MOE8_SACT, a1[3] * MOE8_SACT);
                        *(u32x2*)((unsigned char*)ACT + (size_t)(u.row0 + r) * DEXP + cb) = w8; }
                    else st8_bf16(ACT + (size_t)(u.row0 + r) * DEXP + cb, a0, a1); } }
    }
};
struct EpiDownF { bf16* YE; const float* bd; const float* listg;
    __device__ __forceinline__ void operator()(const f32x4 (&acc)[2][2][4][2], const UnitD& u, int wr, int wc, int fr, int fq) const {
        const int cb = u.col0 + wc * 32 + 8 * fq; const float* pb = bd + u.aux * D + cb; const float* gl = listg + (size_t)u.aux * LISTCAP + u.aux2;
        f32x4 bv[2][2];
#pragma unroll
        for (int bj = 0; bj < 2; ++bj) { bv[bj][0] = *(const f32x4*)(pb + bj * HALF); bv[bj][1] = *(const f32x4*)(pb + bj * HALF + 4); }
        float gts[2][4];
#pragma unroll
        for (int ai = 0; ai < 2; ++ai)
#pragma unroll
            for (int m = 0; m < 4; ++m) { const int r = ai * HALF + wr * 64 + m * 16 + fr; gts[ai][m] = r < u.nvalid ? gl[r] : 0.f; }
        asm volatile("" : "+v"(gts[0][0]), "+v"(gts[0][1]), "+v"(gts[0][2]), "+v"(gts[0][3]), "+v"(gts[1][0]), "+v"(gts[1][1]), "+v"(gts[1][2]), "+v"(gts[1][3]), "+v"(bv[0][0]), "+v"(bv[0][1]), "+v"(bv[1][0]), "+v"(bv[1][1]));
#pragma unroll
        for (int ai = 0; ai < 2; ++ai)
#pragma unroll
            for (int m = 0; m < 4; ++m) { const int r = ai * HALF + wr * 64 + m * 16 + fr;
                if (r < u.nvalid) { const float gt = gts[ai][m]; bf16* rowp = YE + (size_t)(u.row0 + r) * D + cb;
#pragma unroll
                    for (int bj = 0; bj < 2; ++bj) { constexpr float dq = MOE8 ? 1.0f / (MOE8_SW2 * MOE8_SACT) : 1.0f;
                        if constexpr (YE_FP8) { const f32x4 o0 = (acc[ai][bj][m][0] * dq + bv[bj][0]) * (gt * YE_SCALE), o1 = (acc[ai][bj][m][1] * dq + bv[bj][1]) * (gt * YE_SCALE);
                            u32x2 w8; w8.x = pk4_fp8(o0.x, o0.y, o0.z, o0.w); w8.y = pk4_fp8(o1.x, o1.y, o1.z, o1.w);
                            *(u32x2*)((unsigned char*)YE + (size_t)(u.row0 + r) * D + cb + bj * HALF) = w8; }
                        else st8_bf16(rowp + bj * HALF, (acc[ai][bj][m][0] * dq + bv[bj][0]) * gt, (acc[ai][bj][m][1] * dq + bv[bj][1]) * gt); } } }
    }
};
struct EpiRw1 { float* C0; bf16* L0;
    __device__ __forceinline__ void operator()(const f32x4 (&acc)[2][2][4][2], const UnitD& u, int wr, int wc, int fr, int fq) const {
        if (u.aux < 3) { EpiB16 e{(bf16*)(C0 + (size_t)u.aux * NTOK * D), D}; e(acc, u, wr, wc, fr, fq); return; }
        bf16* Lb = L0 + (size_t)(u.aux - 3) * NTOK * 256; const int mode = u.aux;
#pragma unroll
        for (int ai = 0; ai < 2; ++ai)
#pragma unroll
            for (int m = 0; m < 4; ++m) { const int r = ai * HALF + wr * 64 + m * 16 + fr; bf16* rowp = Lb + (size_t)(u.row0 + r) * 256 + u.col0 + wc * 32 + 8 * fq;
#pragma unroll
                for (int bj = 0; bj < 2; ++bj) { f32x4 v0 = acc[ai][bj][m][0], v1 = acc[ai][bj][m][1];
                    if (mode == 3) {
#pragma unroll
                        for (int j = 0; j < 4; ++j) { v0[j] = 1.0f - 2.0f * __builtin_amdgcn_rcpf(__expf(2.0f * v0[j]) + 1.0f); v1[j] = 1.0f - 2.0f * __builtin_amdgcn_rcpf(__expf(2.0f * v1[j]) + 1.0f); } }
                    else if (mode == 5) {
#pragma unroll
                        for (int j = 0; j < 4; ++j) { v0[j] = sigm(v0[j]); v1[j] = sigm(v1[j]); } }
                    st8_bf16(rowp + bj * HALF, v0, v1); } }
    }
};
struct EpiRw2 { float* DEC; float* AS; float* G; const float* w0; const float* a0;
    __device__ __forceinline__ void operator()(const f32x4 (&acc)[2][2][4][2], const UnitD& u, int wr, int wc, int fr, int fq) const {
        if (u.aux == 2) { EpiB16 e{(bf16*)G, D}; e(acc, u, wr, wc, fr, fq); return; }
        const int d = u.col0 >> 11, cb = (u.col0 & 2047) + wc * 32 + 8 * fq; const bool dec = u.aux == 0;
        bf16* Cb = (bf16*)((dec ? DEC : AS) + (size_t)d * NTOK * D); const float* bp = (dec ? w0 : a0) + d * D + cb;
        f32x4 bv[2][2];
#pragma unroll
        for (int bj = 0; bj < 2; ++bj) { bv[bj][0] = *(const f32x4*)(bp + bj * HALF); bv[bj][1] = *(const f32x4*)(bp + bj * HALF + 4); }
#pragma unroll
        for (int ai = 0; ai < 2; ++ai)
#pragma unroll
            for (int m = 0; m < 4; ++m) { const int r = ai * HALF + wr * 64 + m * 16 + fr; bf16* rowp = Cb + (size_t)(u.row0 + r) * D + cb;
#pragma unroll
                for (int bj = 0; bj < 2; ++bj) { f32x4 v0 = acc[ai][bj][m][0] + bv[bj][0], v1 = acc[ai][bj][m][1] + bv[bj][1];
                    if (dec) { v0 = (f32x4){rate1(v0.x), rate1(v0.y), rate1(v0.z), rate1(v0.w)}; v1 = (f32x4){rate1(v1.x), rate1(v1.y), rate1(v1.z), rate1(v1.w)}; }
                    else { v0 = (f32x4){sigm(v0.x), sigm(v0.y), sigm(v0.z), sigm(v0.w)}; v1 = (f32x4){sigm(v1.x), sigm(v1.y), sigm(v1.z), sigm(v1.w)}; }
                    st8_bf16(rowp + bj * HALF, v0, v1); } }
    }
};
}

__device__ __forceinline__ void transpose_item(const float* W, int N, bf16* WT, int ldt, int k0, int n0, int drow0, int dk0, LAS float* scr, int lane) {
    float tv[32];
#pragma unroll
    for (int i = 0; i < 32; ++i) { const int kk = 2 * i + (lane >> 5); tv[i] = W[(size_t)(k0 + kk) * N + n0 + (lane & 31)]; }
#pragma unroll
    for (int i = 0; i < 32; ++i) { const int kk = 2 * i + (lane >> 5); scr[kk * 33 + (lane & 31)] = tv[i]; }
    asm volatile("s_waitcnt lgkmcnt(0)" ::: "memory");
    const int cch = lane & 7;
#pragma unroll
    for (int j = 0; j < 4; ++j) { const int n = (lane >> 3) + 8 * j; const LAS float* sp = scr + (8 * cch) * 33 + n;
        u32x4 o; o.x = pk2(sp[0 * 33], sp[1 * 33]); o.y = pk2(sp[2 * 33], sp[3 * 33]); o.z = pk2(sp[4 * 33], sp[5 * 33]); o.w = pk2(sp[6 * 33], sp[7 * 33]);
        *(u32x4*)(WT + (size_t)(drow0 + n) * ldt + dk0 + k0 + 8 * cch) = o; }
    asm volatile("s_waitcnt lgkmcnt(0)" ::: "memory");
}

constexpr int CV_GATE = (D / 64) * (DEXP / 32), CV_DOWN = (DEXP / 64) * (D / 32), CV_PER = 2 * CV_GATE + CV_DOWN;
struct CvItem { const float* W; unsigned char* WT; int N, ldt, k0, n0, drow0, esz; float scale; };
__device__ __forceinline__ void cv_decode(const Ctx& c, int le, int r, CvItem& T) {
    T.esz = MOE8 ? 1 : 2;
    if (r < 2 * CV_GATE) { const int up = r / CV_GATE; r %= CV_GATE; const int nb = DEXP / 32, n0 = (r % nb) * 32;
        T.W = (up ? inp(c, I_WUP) : inp(c, I_WGATE)) + (size_t)le * D * DEXP; T.N = DEXP; T.WT = c.ws + WB_GU + (size_t)le * 2 * DEXP * D * T.esz; T.ldt = D; T.k0 = (r / nb) * 64; T.n0 = n0; T.drow0 = (n0 / 128) * 256 + up * 128 + (n0 % 128); T.scale = MOE8 ? MOE8_SW1 : 1.f; }
    else { r -= 2 * CV_GATE; const int nb = D / 32;
        T.W = inp(c, I_WDOWN) + (size_t)le * DEXP * D; T.N = D; T.WT = c.ws + WB_DN + (size_t)le * D * DEXP * T.esz; T.ldt = DEXP; T.k0 = (r / nb) * 64; T.n0 = (r % nb) * 32; T.drow0 = T.n0; T.scale = MOE8 ? MOE8_SW2 : 1.f; }
}
__device__ __forceinline__ void cv_load(const CvItem& T, f32x4 (&tv)[8], int lane) {
    const float* p = T.W + (size_t)(T.k0 + 8 * (lane >> 3)) * T.N + T.n0 + 4 * (lane & 7);
#pragma unroll
    for (int i = 0; i < 8; ++i) tv[i] = *(const f32x4*)(p + (size_t)i * T.N);
}
__device__ __forceinline__ void cv_store(const CvItem& T, const f32x4 (&tv)[8], int lane) {
    const size_t eo = (size_t)(T.drow0 + 4 * (lane & 7)) * T.ldt + T.k0 + 8 * (lane >> 3);
#pragma unroll
    for (int j = 0; j < 4; ++j) {
        if (T.esz == 2) { u32x4 o; o.x = pk2(tv[0][j], tv[1][j]); o.y = pk2(tv[2][j], tv[3][j]); o.z = pk2(tv[4][j], tv[5][j]); o.w = pk2(tv[6][j], tv[7][j]);
            *(u32x4*)(T.WT + (eo + (size_t)j * T.ldt) * 2) = o; }
        else { const float sc = T.scale; u32x2 o; o.x = pk4_fp8(tv[0][j] * sc, tv[1][j] * sc, tv[2][j] * sc, tv[3][j] * sc); o.y = pk4_fp8(tv[4][j] * sc, tv[5][j] * sc, tv[6][j] * sc, tv[7][j] * sc);
            *(u32x2*)(T.WT + eo + (size_t)j * T.ldt) = o; } }
}
constexpr int CVF_Q = 48, CVF_F2 = 256 - (NTOK / 256 * (AB_IN / 256) - 256), CVF_F5 = 256 - (NTOK / 256 * (D / 256) - 256);
constexpr int CVF_TOTAL = (CVF_F2 + CVF_F5) * CVF_Q;
__device__ __forceinline__ void conv_fill(const Ctx& c, int first, int count) {
    __syncthreads();
    LAS float* scr = (LAS float*)(c.lds + c.wave * 8448);
    int k = c.wave;
    if (k < count) {
        CvItem cur; f32x4 tv[8]; cv_decode(c, (first + k) / CV_PER, (first + k) % CV_PER, cur); cv_load(cur, tv, c.lane);
        for (; k < count; k += 8) {
            CvItem nxt = cur; f32x4 tn[8]; const bool more = k + 8 < count;
            if (more) { cv_decode(c, (first + k + 8) / CV_PER, (first + k + 8) % CV_PER, nxt); cv_load(nxt, tn, c.lane); }
            cv_store(cur, tv, c.lane);
            if (more) { cur = nxt;
#pragma unroll
                for (int i = 0; i < 8; ++i) tv[i] = tn[i]; }
        }
    }
    __syncthreads();
}

__device__ __forceinline__ void ph_mod(const Ctx& c) {
    LAS float* s = (LAS float*)c.lds;
    LAS float* red = s + 3 * D;
    for (int i = c.tid; i < 3 * D; i += 512) { const int who = i / D, k = i % D; const float v = who < 2 ? inp(c, I_C)[who * D + k] : inp(c, I_CCTX)[k]; s[i] = v / (1.0f + __expf(-v)); }
    __syncthreads();
    const int kq = c.tid >> 5, c4 = (c.tid & 31) * 4;
    LAS float* red2 = red;
    for (int u = c.bid; u < 2 * (6 * D / 128); u += c.G) {
        const int layer = u / (6 * D / 128), col0 = (u % (6 * D / 128)) * 128;
        const float* w = inp(c, I_WMOD) + (size_t)layer * D * 6 * D + col0 + c4;
        f32x4 a0 = {0.f, 0.f, 0.f, 0.f}, a1 = a0, a2 = a0;
#pragma unroll 8
        for (int k = kq * 128; k < kq * 128 + 128; ++k) { const f32x4 wv = *(const f32x4*)(w + (size_t)k * 6 * D); a0 += wv * s[k]; a1 += wv * s[D + k]; a2 += wv * s[2 * D + k]; }
        *(LAS f32x4*)(red2 + (kq * 3 + 0) * 128 + c4) = a0; *(LAS f32x4*)(red2 + (kq * 3 + 1) * 128 + c4) = a1; *(LAS f32x4*)(red2 + (kq * 3 + 2) * 128 + c4) = a2;
        __syncthreads();
        if (c.tid < 384) { const int who = c.tid / 128, cc = c.tid % 128; float t = 0.f;
            for (int q = 0; q < 16; ++q) t += red2[(q * 3 + who) * 128 + cc];
            const int colg = col0 + cc;
            ((float*)(c.ws + WS_MOD))[((size_t)(layer * 3 + who) * 6) * D + colg] = t + inp(c, I_BMOD)[layer * 6 * D + colg]; }
        __syncthreads();
    }
    {
        __syncthreads();
        LAS float* scr = (LAS float*)(c.lds + c.wave * 8448);
        constexpr int N_WINI = (D / 64) * (AB_IN / 32), N_SQ = (D / 64) * (D / 32), N_POOL = 4 * (256 / 64) * (256 / 32), N_L1 = 2 * (D / 64) * 3, N_G1 = (D / 64) * (GLORA / 32), N_G2 = (GLORA / 64) * (D / 32);
        constexpr int N_SMALL = N_WINI + 5 * N_SQ + N_POOL + 2 * N_L1 + N_G1 + N_G2;
        constexpr int N_GATE = (D / 64) * (DEXP / 32), N_DOWN = (DEXP / 64) * (D / 32);
        constexpr int N_MOE = NEXP * (2 * N_GATE + N_DOWN);
        const int N_ALL = N_SMALL + N_MOE - (c.G == 256 ? CVF_TOTAL : 0);
#define TDEC(it_, T_) do { int r = (it_); T_.esz = 2; T_.scale = 1.f; \
            if (r >= N_SMALL) { r -= N_SMALL; cv_decode(c, r / CV_PER, r % CV_PER, T_); } \
            else if (r < N_WINI) { const int nb = AB_IN / 32; T_.W = inp(c, I_WIN); T_.N = AB_IN; T_.WT = c.ws + WB_WIN; T_.ldt = D; T_.k0 = (r / nb) * 64; T_.n0 = (r % nb) * 32; T_.drow0 = T_.n0; } \
            else if (r < N_WINI + 5 * N_SQ) { r -= N_WINI; const int which = r / N_SQ; r %= N_SQ; const int nb = D / 32; \
                T_.W = which == 0 ? inp(c, I_WOUT) : which == 1 ? inp(c, I_WR) : which == 2 ? inp(c, I_WK) : which == 3 ? inp(c, I_WV) : inp(c, I_WO); \
                T_.WT = c.ws + (which == 0 ? WB_WOUT : which == 1 ? WB_WR : which == 2 ? WB_WK : which == 3 ? WB_WV : WB_WO); T_.N = D; T_.ldt = D; T_.k0 = (r / nb) * 64; T_.n0 = (r % nb) * 32; T_.drow0 = T_.n0; } \
            else if (r < N_WINI + 5 * N_SQ + N_POOL) { r -= N_WINI + 5 * N_SQ; const int g = r / 32; r %= 32; \
                T_.W = inp(c, I_POOLW) + (size_t)g * 65536; T_.N = 256; T_.WT = c.ws + WB_POOL + (size_t)g * 65536 * 2; T_.ldt = 256; T_.k0 = (r / 8) * 64; T_.n0 = (r % 8) * 32; T_.drow0 = T_.n0; } \
            else if (r < N_WINI + 5 * N_SQ + N_POOL + 2 * N_L1) { r -= N_WINI + 5 * N_SQ + N_POOL; const int isa = r / N_L1; r %= N_L1; const int d = r / (N_L1 / 2); r %= (N_L1 / 2); \
                T_.W = (isa ? inp(c, I_A1) : inp(c, I_W1)) + (size_t)d * D * LORA; T_.N = LORA; T_.WT = c.ws + (isa ? WB_A1 : WB_W1); T_.ldt = D; T_.k0 = (r / 3) * 64; T_.n0 = (r % 3) * 32; T_.drow0 = d * 128 + (r % 3) * 32; } \
            else if (r < N_WINI + 5 * N_SQ + N_POOL + 2 * N_L1 + N_G1) { r -= N_WINI + 5 * N_SQ + N_POOL + 2 * N_L1; \
                T_.W = inp(c, I_G1); T_.N = GLORA; T_.WT = c.ws + WB_G1; T_.ldt = D; T_.k0 = (r / 8) * 64; T_.n0 = (r % 8) * 32; T_.drow0 = T_.n0; } \
            else { r -= N_WINI + 5 * N_SQ + N_POOL + 2 * N_L1 + N_G1; const int nb = D / 32; \
                T_.W = inp(c, I_G2); T_.N = D; T_.WT = c.ws + WB_G2; T_.ldt = GLORA; T_.k0 = (r / nb) * 64; T_.n0 = (r % nb) * 32; T_.drow0 = T_.n0; } } while (0)
        for (int rep = 0; rep < DBG_REP0; ++rep) {
        int it = c.gw;
        if (it < N_ALL) {
            CvItem cur; f32x4 tv[8]; TDEC(it, cur); cv_load(cur, tv, c.lane);
            for (; it < N_ALL; it += c.ngw) {
                CvItem nxt = cur; f32x4 tn[8]; const bool more = it + c.ngw < N_ALL;
                if (more) { TDEC(it + c.ngw, nxt); cv_load(nxt, tn, c.lane); }
                cv_store(cur, tv, c.lane);
                if (more) { cur = nxt;
#pragma unroll
                    for (int i = 0; i < 8; ++i) tv[i] = tn[i]; }
            }
        }
        }
#undef TDEC
        {
            const int gt0 = c.bid * 512 + c.tid, ngt0 = c.G * 512;
            for (int i = gt0; i < 2 * NEXP * (D / 8); i += ngt0) {
                const int ch = i & 255, e = (i >> 8) & 31, l = i >> 13; const float* src = inp(c, I_ROUTW) + (size_t)l * D * NEXP + (size_t)(ch * 8) * NEXP + e;
                float h[8], lo[8];
#pragma unroll
                for (int j = 0; j < 8; ++j) { const float w = src[(size_t)j * NEXP]; h[j] = bf2f(f2bf(w)); lo[j] = w - h[j]; }
                u32x4 oh, ol; oh.x = pk2(h[0], h[1]); oh.y = pk2(h[2], h[3]); oh.z = pk2(h[4], h[5]); oh.w = pk2(h[6], h[7]);
                ol.x = pk2(lo[0], lo[1]); ol.y = pk2(lo[2], lo[3]); ol.z = pk2(lo[4], lo[5]); ol.w = pk2(lo[6], lo[7]);
                bf16* dst = (bf16*)(c.ws + WB_RT) + ((size_t)(l * 2) * NEXP + e) * D + ch * 8;
                *(u32x4*)dst = oh; *(u32x4*)(dst + (size_t)NEXP * D) = ol;
            }
        }
        const int gt = c.bid * 512 + c.tid, ngt = c.G * 512;
        for (int i = gt; i < 2 * 2 * D * 32; i += ngt) {
            const int ch = i & 31, n = (i >> 5) & (D - 1), d = (i >> 16) & 1, isa = i >> 17;
            const float* src = (isa ? inp(c, I_A2) : inp(c, I_W2)) + (size_t)d * LORA * D + n;
            float v[8];
#pragma unroll
            for (int j = 0; j < 8; ++j) { const int kk = ch * 8 + j - d * 128; v[j] = (kk >= 0 && kk < LORA) ? src[(size_t)kk * D] : 0.f; }
            u32x4 o; o.x = pk2(v[0], v[1]); o.y = pk2(v[2], v[3]); o.z = pk2(v[4], v[5]); o.w = pk2(v[6], v[7]);
            *(u32x4*)((bf16*)(c.ws + (isa ? WB_A2 : WB_W2)) + ((size_t)d * D + n) * 256 + ch * 8) = o;
        }
        for (int i = gt; i < 2 * 2 * 32 * (D / 8); i += ngt) {
            const int ch = i & 255, rr = (i >> 8) & 31, d = (i >> 13) & 1, isa = i >> 14;
            *(u32x4*)((bf16*)(c.ws + (isa ? WB_A1 : WB_W1)) + (size_t)(d * 128 + 96 + rr) * D + ch * 8) = (u32x4){0u, 0u, 0u, 0u};
        }
    }
    if (c.bid == 0 && c.tid < 32) {
        const int d = c.tid; double inv = 1.0; for (int i = 0; i < d; ++i) inv *= 0.7498942093324559;
        double sn = 0.0, cs = 0.0, term = 1.0;
        for (int n = 0; n < 24; ++n) { if ((n & 1) == 0) cs += ((n & 2) ? -term : term); else sn += ((n & 2) ? -term : term); term *= inv / (double)(n + 1); }
        double cp = 1.0, sp = 0.0; float* ct = (float*)(c.ws + WS_ROPE); float* st = ct + 64 * 32;
        for (int p = 0; p < 64; ++p) { ct[p * 32 + d] = (float)cp; st[p * 32 + d] = (float)sp; const double nc = cp * cs - sp * sn, ns = sp * cs + cp * sn; cp = nc; sp = ns; }
    }
}

__device__ __forceinline__ void ph_prenorm0(const Ctx& c) {
    bf16* H = (bf16*)(c.ws + WS_H);
    const float* g = inp(c, I_NORMG);
    for (int row = c.gw; row < NTOK; row += c.ngw) {
        const RowInfo ri = rowinfo(row);
        const float* xr = row < NLAT ? inp(c, I_X) + (size_t)row * D : inp(c, I_CTX) + (size_t)(row - NLAT) * D;
        const float* sh = modp(c, 0, ri.who, 0); const float* sc = modp(c, 0, ri.who, 1);
        f32x4 v[8]; float ss = 0.f;
#pragma unroll
        for (int j = 0; j < 8; ++j) { v[j] = ((const f32x4*)xr)[j * 64 + c.lane]; ss += v[j].x * v[j].x + v[j].y * v[j].y + v[j].z * v[j].z + v[j].w * v[j].w; }
        const float rstd = rsqrtf(wsum(ss) * (1.0f / D) + 1e-6f);
#pragma unroll
        for (int j = 0; j < 8; ++j) { const int idx = j * 256 + c.lane * 4;
            const f32x4 gg = *(const f32x4*)(g + idx), s4 = *(const f32x4*)(sh + idx), c4 = *(const f32x4*)(sc + idx);
            const f32x4 h = v[j] * rstd * gg * (c4 + 1.0f) + s4;
            u32x2 o; o.x = pk2(h.x, h.y); o.y = pk2(h.z, h.w); *(u32x2*)(H + (size_t)row * D + idx) = o; }
    }
}

__device__ __forceinline__ void ph_prep0(const Ctx& c) {
    const bf16* U = (const bf16*)(c.ws + WS_U); bf16* Q = (bf16*)(c.ws + WS_Q); bf16* Kb = (bf16*)(c.ws + WS_K); bf16* Vb = (bf16*)(c.ws + WS_V); bf16* MP = (bf16*)(c.ws + WS_MP);
    const float* ct = (const float*)(c.ws + WS_ROPE); const float* st = ct + 64 * 32;
    const int lane = c.lane;
    for (int row = c.gw; row < NTOK; row += c.ngw) {
        const RowInfo ri = rowinfo(row); const bool lat = row < NLAT;
        const bf16* u = U + (size_t)row * AB_IN;
        const int kvpos = lat ? ri.t : SEQ + ri.t;
        const int prow = ri.t >> 6, pcol = ri.t & 63;
#pragma unroll
        for (int pass = 0; pass < 2; ++pass) {
            const int e0 = (pass ? ATTN_W : 0) + lane * 16;
            const u32x4 r0 = *(const u32x4*)(u + e0), r1 = *(const u32x4*)(u + e0 + 8);
            float x[16];
            x[0] = bf2f(r0.x & 0xffffu); x[1] = bf2f(r0.x >> 16); x[2] = bf2f(r0.y & 0xffffu); x[3] = bf2f(r0.y >> 16);
            x[4] = bf2f(r0.z & 0xffffu); x[5] = bf2f(r0.z >> 16); x[6] = bf2f(r0.w & 0xffffu); x[7] = bf2f(r0.w >> 16);
            x[8] = bf2f(r1.x & 0xffffu); x[9] = bf2f(r1.x >> 16); x[10] = bf2f(r1.y & 0xffffu); x[11] = bf2f(r1.y >> 16);
            x[12] = bf2f(r1.z & 0xffffu); x[13] = bf2f(r1.z >> 16); x[14] = bf2f(r1.w & 0xffffu); x[15] = bf2f(r1.w >> 16);
            float ss = 0.f;
#pragma unroll
            for (int i = 0; i < 16; ++i) ss += x[i] * x[i];
            ss = sum8(ss);
            const float rstd = rsqrtf(ss * (1.0f / HD) + 1e-6f);
            const float* gain = (pass ? inp(c, I_KGAIN) : inp(c, I_QGAIN)) + (lane & 7) * 16;
            const int s = lane & 7, sub = s & 3, pos = (s >> 2) ? pcol : prow;
            float gv[16], cv[16], sv[16];
#pragma unroll
            for (int q = 0; q < 4; ++q) { const f32x4 g4 = *(const f32x4*)(gain + 4 * q), c4 = *(const f32x4*)(ct + pos * 32 + (sub & 1) * 16 + 4 * q), s4 = *(const f32x4*)(st + pos * 32 + (sub & 1) * 16 + 4 * q);
                gv[4 * q] = g4.x; gv[4 * q + 1] = g4.y; gv[4 * q + 2] = g4.z; gv[4 * q + 3] = g4.w; cv[4 * q] = c4.x; cv[4 * q + 1] = c4.y; cv[4 * q + 2] = c4.z; cv[4 * q + 3] = c4.w;
                sv[4 * q] = s4.x; sv[4 * q + 1] = s4.y; sv[4 * q + 2] = s4.z; sv[4 * q + 3] = s4.w; }
            float o[16];
#pragma unroll
            for (int i = 0; i < 16; ++i) {
                const float xv = x[i] * rstd * gv[i];
                const float pv = dpp_mov<0x4E>(xv);
                if (lat) o[i] = (sub & 2) ? (xv * cv[i] + pv * sv[i]) : (xv * cv[i] - pv * sv[i]);
                else o[i] = xv;
            }
            u32x4 w0, w1;
            w0.x = pk2(o[0], o[1]); w0.y = pk2(o[2], o[3]); w0.z = pk2(o[4], o[5]); w0.w = pk2(o[6], o[7]);
            w1.x = pk2(o[8], o[9]); w1.y = pk2(o[10], o[11]); w1.z = pk2(o[12], o[13]); w1.w = pk2(o[14], o[15]);
            if (pass == 0) { bf16* dst = Q + (size_t)row * ATTN_W + lane * 16; *(u32x4*)dst = w0; *(u32x4*)(dst + 8) = w1; }
            else if (lane < 16) { bf16* dst = Kb + ((size_t)ri.b * KVLEN + kvpos) * KV_W + lane * 16; *(u32x4*)dst = w0; *(u32x4*)(dst + 8) = w1; }
        }
        if (lane >= 16 && lane < 32) {
            const bf16* src = u + ATTN_W + KV_W + (lane - 16) * 16; bf16* dst = Vb + ((size_t)ri.b * KVLEN + kvpos) * KV_W + (lane - 16) * 16;
            *(u32x4*)dst = *(const u32x4*)src; *(u32x4*)(dst + 8) = *(const u32x4*)(src + 8);
        }
        {
            const int c0 = lane * 16, gi = lane >> 4, half = 1 << gi;
            const int lo = ri.t - half < 0 ? 0 : ri.t - half, hi = ri.t + half > ri.n ? ri.n : ri.t + half;
            float acc[16];
#pragma unroll
            for (int i = 0; i < 16; ++i) acc[i] = 0.f;
            u32x4 pr0[16], pr1[16];
#pragma unroll
            for (int q = 0; q < 16; ++q) {
                int tt = ri.t - 8 + q; const bool ok = tt >= lo && tt < hi; tt = ok ? tt : ri.t;
                const bf16* p = U + (size_t)(ri.seq0 + tt) * AB_IN + ATTN_W + 2 * KV_W + c0;
                pr0[q] = *(const u32x4*)p; pr1[q] = *(const u32x4*)(p + 8);
                if (!ok) { pr0[q] = (u32x4){0u, 0u, 0u, 0u}; pr1[q] = (u32x4){0u, 0u, 0u, 0u}; }
            }
#pragma unroll
            for (int q = 0; q < 16; ++q) { const u32x4 r0 = pr0[q], r1 = pr1[q];
                acc[0] += bf2f(r0.x & 0xffffu); acc[1] += bf2f(r0.x >> 16); acc[2] += bf2f(r0.y & 0xffffu); acc[3] += bf2f(r0.y >> 16);
                acc[4] += bf2f(r0.z & 0xffffu); acc[5] += bf2f(r0.z >> 16); acc[6] += bf2f(r0.w & 0xffffu); acc[7] += bf2f(r0.w >> 16);
                acc[8] += bf2f(r1.x & 0xffffu); acc[9] += bf2f(r1.x >> 16); acc[10] += bf2f(r1.y & 0xffffu); acc[11] += bf2f(r1.y >> 16);
                acc[12] += bf2f(r1.z & 0xffffu); acc[13] += bf2f(r1.z >> 16); acc[14] += bf2f(r1.w & 0xffffu); acc[15] += bf2f(r1.w >> 16);
            }
            const float inv = 1.0f / (float)(hi - lo);
            const bf16* p = u + ATTN_W + 2 * KV_W + c0;
            const u32x4 r0 = *(const u32x4*)p, r1 = *(const u32x4*)(p + 8);
            float sv[16];
            sv[0] = bf2f(r0.x & 0xffffu); sv[1] = bf2f(r0.x >> 16); sv[2] = bf2f(r0.y & 0xffffu); sv[3] = bf2f(r0.y >> 16);
            sv[4] = bf2f(r0.z & 0xffffu); sv[5] = bf2f(r0.z >> 16); sv[6] = bf2f(r0.w & 0xffffu); sv[7] = bf2f(r0.w >> 16);
            sv[8] = bf2f(r1.x & 0xffffu); sv[9] = bf2f(r1.x >> 16); sv[10] = bf2f(r1.y & 0xffffu); sv[11] = bf2f(r1.y >> 16);
            sv[12] = bf2f(r1.z & 0xffffu); sv[13] = bf2f(r1.z >> 16); sv[14] = bf2f(r1.w & 0xffffu); sv[15] = bf2f(r1.w >> 16);
            u32x4 w0, w1;
            w0.x = pk2(acc[0] * inv - sv[0], acc[1] * inv - sv[1]); w0.y = pk2(acc[2] * inv - sv[2], acc[3] * inv - sv[3]);
            w0.z = pk2(acc[4] * inv - sv[4], acc[5] * inv - sv[5]); w0.w = pk2(acc[6] * inv - sv[6], acc[7] * inv - sv[7]);
            w1.x = pk2(acc[8] * inv - sv[8], acc[9] * inv - sv[9]); w1.y = pk2(acc[10] * inv - sv[10], acc[11] * inv - sv[11]);
            w1.z = pk2(acc[12] * inv - sv[12], acc[13] * inv - sv[13]); w1.w = pk2(acc[14] * inv - sv[14], acc[15] * inv - sv[15]);
            bf16* dst = MP + (size_t)row * POOL_W + c0; *(u32x4*)dst = w0; *(u32x4*)(dst + 8) = w1;
        }
    }
}


namespace attn {
using bf16 = unsigned short;
constexpr int   D = 128, NW = 8, QBLK = 32, KVBLK = 64;
constexpr float SCALE = 0.088388347648318440f;
constexpr float THR = 8.f;
constexpr int SDEPTH = 2;
constexpr int LDQ = 1024, LDK = 256, LDO = 2048;
constexpr size_t SHM_V = KVBLK * D * 2, SHM_K = KVBLK * D * 2, SHM_ATTN = 2 * SHM_V + 2 * SHM_K + NW * 64 * 4;
using bf16x8 = __attribute__((ext_vector_type(8))) short;
using s16x4  = __attribute__((ext_vector_type(4))) short;
using f32x16 = __attribute__((ext_vector_type(16))) float;
using f32x8  = __attribute__((ext_vector_type(8))) float;
using u32x4  = __attribute__((ext_vector_type(4))) unsigned;
#define KSWZ(row, colB) ((row) * 256 + ((colB) ^ (((row) & 7) << 4)))
#define SBAR() __builtin_amdgcn_sched_barrier(0)
__device__ __forceinline__ int crow(int r, int hi) { return (r & 3) + 8 * (r >> 2) + 4 * hi; }
__device__ __forceinline__ unsigned cvtpk(float lo, float hi) {
  unsigned r; asm volatile("v_cvt_pk_bf16_f32 %0, %1, %2" : "=v"(r) : "v"(lo), "v"(hi)); return r;
}
template <typename TIn> struct Stage;
template <> struct Stage<bf16>  { using T = bf16x8;
  __device__ static __forceinline__ T ld8(const bf16* p) { return *reinterpret_cast<const bf16x8*>(p); }
  __device__ static __forceinline__ bf16x8 tobf(T x) { return x; } };
__device__ __forceinline__ void partialSM(f32x16& p0, f32x16& p1, float& m_reg, float& mn, float& alpha) {
  constexpr float C = SCALE * 1.4426950408889634f;
  float pmax = p0[0]; for (int r = 1; r < 16; ++r) pmax = fmaxf(pmax, p0[r]); for (int r = 0; r < 16; ++r) pmax = fmaxf(pmax, p1[r]);
  { auto rr = __builtin_amdgcn_permlane32_swap(__float_as_uint(pmax), __float_as_uint(pmax), false, false);
    pmax = fmaxf(__uint_as_float(rr[0]), __uint_as_float(rr[1])); }
  if (__builtin_expect(__all(pmax - m_reg <= THR / SCALE), 1)) { mn = m_reg; alpha = 1.f; }
  else { mn = fmaxf(m_reg, pmax); alpha = __builtin_amdgcn_exp2f((m_reg - mn) * C); m_reg = mn; }
  float mnC = -mn * C;
  for (int r = 0; r < 16; ++r) p0[r] = fmaf(p0[r], C, mnC); for (int r = 0; r < 16; ++r) p1[r] = fmaf(p1[r], C, mnC);
  for (int r = 0; r < 16; ++r) p0[r] = __builtin_amdgcn_exp2f(p0[r]);
}
__device__ __forceinline__ void finishSM(f32x16& p0, f32x16& p1, float alpha, float& l_reg, bf16x8& pa0, bf16x8& pa1, bf16x8& pa2, bf16x8& pa3) {
  for (int r = 0; r < 16; ++r) p1[r] = __builtin_amdgcn_exp2f(p1[r]);
  float ps = 0; for (int r = 0; r < 16; ++r) ps += p0[r]; for (int r = 0; r < 16; ++r) ps += p1[r];
  { auto rr = __builtin_amdgcn_permlane32_swap(__float_as_uint(ps), __float_as_uint(ps), false, false);
    ps = __uint_as_float(rr[0]) + __uint_as_float(rr[1]); }
  l_reg = l_reg * alpha + ps;
#define PK4(P, BASE, OUT) do { unsigned a0 = cvtpk(P[BASE + 0], P[BASE + 1]), a1 = cvtpk(P[BASE + 2], P[BASE + 3]);   \
    unsigned b0 = cvtpk(P[BASE + 4], P[BASE + 5]), b1 = cvtpk(P[BASE + 6], P[BASE + 7]);                              \
    auto r0 = __builtin_amdgcn_permlane32_swap(a0, b0, false, false); auto r1 = __builtin_amdgcn_permlane32_swap(a1, b1, false, false); \
    u32x4 w = {r0[0], r1[0], r0[1], r1[1]}; OUT = *reinterpret_cast<bf16x8*>(&w); } while (0)
  PK4(p0, 0, pa0); PK4(p0, 8, pa1); PK4(p1, 0, pa2); PK4(p1, 8, pa3);
#undef PK4
}
__device__ __forceinline__ void qkt(f32x16& p0, f32x16& p1, const bf16* Ks, const bf16x8* qr, int r32, int hi) {
  p0 = f32x16{}; p1 = f32x16{};
  for (int d0 = 0; d0 < 8; ++d0) { int cb = (d0 * 16 + hi * 8) * 2;
    bf16x8 b0 = *reinterpret_cast<const bf16x8*>((const char*)Ks + KSWZ(r32, cb));
    bf16x8 b1 = *reinterpret_cast<const bf16x8*>((const char*)Ks + KSWZ(32 + r32, cb));
    p0 = __builtin_amdgcn_mfma_f32_32x32x16_bf16(b0, qr[d0], p0, 0, 0, 0);
    p1 = __builtin_amdgcn_mfma_f32_32x32x16_bf16(b1, qr[d0], p1, 0, 0, 0); }
}
__device__ __forceinline__ int v_st(int k, int c) { const int kk = (k & ~0xC) | ((k & 4) << 1) | ((k & 8) >> 1); return ((kk >> 3) * 4 + (c >> 5)) * 512 + ((kk & 7) * 32 + (c & 31)) * 2; }
__device__ __forceinline__ int v_rd_base(int lane) { return ((lane & 3) << 3) | (((lane >> 2) & 3) << 6) | (((lane >> 4) & 1) << 5) | (((lane >> 5) & 1) << 8); }
constexpr int v_rd_off(int d0, int ks, int half) { return d0 * 512 + ks * 4096 + half * 2048; }
template <int OFF> __device__ __forceinline__ s16x4 tr_read(int vb) {
  s16x4 r; asm volatile("ds_read_b64_tr_b16 %0, %1 offset:%2" : "=&v"(r) : "v"(vb), "i"(OFF) : "memory"); return r;
}
template <int D0> __device__ __forceinline__ void pv_one(f32x16& od, int vb, bf16x8 pa0, bf16x8 pa1, bf16x8 pa2, bf16x8 pa3) {
  const s16x4 l0 = tr_read<v_rd_off(D0, 0, 0)>(vb), h0 = tr_read<v_rd_off(D0, 0, 1)>(vb), l1 = tr_read<v_rd_off(D0, 1, 0)>(vb), h1 = tr_read<v_rd_off(D0, 1, 1)>(vb);
  const s16x4 l2 = tr_read<v_rd_off(D0, 2, 0)>(vb), h2 = tr_read<v_rd_off(D0, 2, 1)>(vb), l3 = tr_read<v_rd_off(D0, 3, 0)>(vb), h3 = tr_read<v_rd_off(D0, 3, 1)>(vb);
  asm volatile("s_waitcnt lgkmcnt(0)" ::: "memory"); SBAR();
#define PK(L, H) (bf16x8){L[0], L[1], L[2], L[3], H[0], H[1], H[2], H[3]}
  od = __builtin_amdgcn_mfma_f32_32x32x16_bf16(pa0, PK(l0, h0), od, 0, 0, 0);
  od = __builtin_amdgcn_mfma_f32_32x32x16_bf16(pa1, PK(l1, h1), od, 0, 0, 0);
  od = __builtin_amdgcn_mfma_f32_32x32x16_bf16(pa2, PK(l2, h2), od, 0, 0, 0);
  od = __builtin_amdgcn_mfma_f32_32x32x16_bf16(pa3, PK(l3, h3), od, 0, 0, 0);
#undef PK
}
__device__ __forceinline__ void pv_d0(f32x16* o, int vb, bf16x8 pa0, bf16x8 pa1, bf16x8 pa2, bf16x8 pa3) {
  pv_one<0>(o[0], vb, pa0, pa1, pa2, pa3); pv_one<1>(o[1], vb, pa0, pa1, pa2, pa3); pv_one<2>(o[2], vb, pa0, pa1, pa2, pa3); pv_one<3>(o[3], vb, pa0, pa1, pa2, pa3);
}

__device__ __forceinline__ void attn_dense_body(const bf16* __restrict__ Qb, const bf16* __restrict__ Kh, const bf16* __restrict__ Vh,
                                                bf16* __restrict__ Ob, int seq, char* lds) {
  using St = Stage<bf16>; using SQ = Stage<bf16>; using TQ = bf16;
  int tid = threadIdx.x; asm volatile("" : "+v"(tid));
  const int wid = tid >> 6, lane = tid & 63, r32 = lane & 31, hi = lane >> 5;
  bf16* V_lds = (bf16*)lds; bf16* K_lds = (bf16*)(lds + 2 * SHM_V);
  float* ws = (float*)(lds + 2 * SHM_V + 2 * SHM_K) + wid * 64; float* li_l = ws; float* al_l = ws + 32;
  float m_reg = -1e30f, l_reg = 0; f32x16 o[4] = {}; bf16x8 qr[8];
  const TQ* Qw = Qb + (long)(wid * QBLK + r32) * LDQ + hi * 8;
#pragma unroll
  for (int d0 = 0; d0 < 8; ++d0) qr[d0] = SQ::tobf(SQ::ld8(Qw + d0 * 16));
  const int sr = tid >> 4, sc = (tid & 15) * 8, vst0 = v_st(sr, sc), vst1 = v_st(32 + sr, sc);
  const int vb0 = (int)(uintptr_t)V_lds + v_rd_base(lane);
  struct { typename St::T vs0, vs1, ks0, ks1; } sr_[SDEPTH];
#define SLOAD(i, k0) do { sr_[i].vs0 = St::ld8(&Vh[(long)((k0) + sr) * LDK + sc]); sr_[i].vs1 = St::ld8(&Vh[(long)((k0) + 32 + sr) * LDK + sc]); \
    sr_[i].ks0 = St::ld8(&Kh[(long)((k0) + sr) * LDK + sc]); sr_[i].ks1 = St::ld8(&Kh[(long)((k0) + 32 + sr) * LDK + sc]); } while (0)
#define SWRITE(b, i) do { *(bf16x8*)((char*)V_lds + (b) * SHM_V + vst0) = St::tobf(sr_[i].vs0);          \
    *(bf16x8*)((char*)V_lds + (b) * SHM_V + vst1) = St::tobf(sr_[i].vs1); int kc = sc * 2;               \
    *(bf16x8*)((char*)K_lds + (b) * SHM_K + KSWZ(sr, kc)) = St::tobf(sr_[i].ks0);                       \
    *(bf16x8*)((char*)K_lds + (b) * SHM_K + KSWZ(32 + sr, kc)) = St::tobf(sr_[i].ks1); } while (0)
#define SWAIT() do { if constexpr (SDEPTH == 2) asm volatile("s_waitcnt vmcnt(4)" ::: "memory"); else asm volatile("s_waitcnt vmcnt(0)" ::: "memory"); } while (0)
#define RESC(a) do { if (__any((a) < 1.f)) { if (hi == 0) al_l[r32] = (a); asm volatile("s_waitcnt lgkmcnt(0)" ::: "memory"); \
    for (int d = 0; d < 4; ++d) for (int r = 0; r < 16; ++r) o[d][r] *= al_l[crow(r, hi)]; } } while (0)
  f32x16 pA0, pA1, pB0, pB1; float mnA, mnB, alA, alB; bf16x8 pa0, pa1, pa2, pa3; const int NT = seq / KVBLK;
  constexpr int SE = 0, SO = SDEPTH - 1;
  SLOAD(SE, 0); asm volatile("s_waitcnt vmcnt(0)" ::: "memory"); SWRITE(0, SE); __syncthreads();
  qkt(pA0, pA1, K_lds, qr, r32, hi); partialSM(pA0, pA1, m_reg, mnA, alA);
  SLOAD(SO, KVBLK); if constexpr (SDEPTH == 2) { if (2 < NT) SLOAD(SE, 2 * KVBLK); }
  SWAIT(); SWRITE(1, SO); __syncthreads();
  for (int j = 1; j + 1 < NT; j += 2) {
    SBAR(); qkt(pB0, pB1, (bf16*)((char*)K_lds + SHM_K), qr, r32, hi);
    finishSM(pA0, pA1, alA, l_reg, pa0, pa1, pa2, pa3); SBAR();
    SLOAD(SO, (j + SDEPTH) * KVBLK); SBAR();
    pv_d0(o, vb0, pa0, pa1, pa2, pa3); partialSM(pB0, pB1, m_reg, mnB, alB);
    __syncthreads(); SWAIT(); SWRITE(0, SE);
    RESC(alB); __syncthreads();
    SBAR(); qkt(pA0, pA1, K_lds, qr, r32, hi);
    finishSM(pB0, pB1, alB, l_reg, pa0, pa1, pa2, pa3); SBAR();
    if (SDEPTH == 1 || j + 3 < NT) SLOAD(SE, (j + 1 + SDEPTH) * KVBLK); SBAR();
    pv_d0(o, vb0 + (int)SHM_V, pa0, pa1, pa2, pa3); partialSM(pA0, pA1, m_reg, mnA, alA);
    __syncthreads(); SWAIT(); SWRITE(1, SO);
    RESC(alA); __syncthreads();
  }
  SBAR(); qkt(pB0, pB1, (bf16*)((char*)K_lds + SHM_K), qr, r32, hi);
  finishSM(pA0, pA1, alA, l_reg, pa0, pa1, pa2, pa3); SBAR();
  pv_d0(o, vb0, pa0, pa1, pa2, pa3); partialSM(pB0, pB1, m_reg, mnB, alB);
  __syncthreads(); RESC(alB);
  finishSM(pB0, pB1, alB, l_reg, pa0, pa1, pa2, pa3); SBAR();
  pv_d0(o, vb0 + (int)SHM_V, pa0, pa1, pa2, pa3);
  if (hi == 0) li_l[r32] = l_reg; asm volatile("s_waitcnt lgkmcnt(0)" ::: "memory");
  float rli[16];
#pragma unroll
  for (int r = 0; r < 16; ++r) rli[r] = __builtin_amdgcn_rcpf(li_l[crow(r, hi)]);
  bf16* Ow = Ob + (long)(wid * QBLK) * LDO;
#pragma unroll
  for (int r = 0; r < 16; ++r) { int orow = crow(r, hi);
    for (int d0 = 0; d0 < 4; ++d0) Ow[(long)orow * LDO + d0 * 32 + r32] = (bf16)(cvtpk(o[d0][r] * rli[r], 0.f) & 0xffffu); }
#undef SLOAD
#undef SWRITE
#undef SWAIT
#undef RESC
}

}

__device__ __forceinline__ void attn_simple_unit(const Ctx& c, const bf16* Qrows  , const bf16* Kh, const bf16* Vh  ,
                                                 int nkeys, bf16* Orows  ) {
    LAS float* Qs = (LAS float*)c.lds;
    LAS float* Ks = Qs + 64 * 132;
    LAS float* Vs = Ks + 64 * 132;
    LAS float* Ps = Vs + 64 * 128;
    const int tid = c.tid, qi = tid >> 3, g8 = tid & 7;
    __syncthreads();
    for (int i = tid; i < 64 * 16; i += 512) { const int r = i >> 4, cc = (i & 15) * 8; const u32x4 v = *(const u32x4*)(Qrows + (size_t)r * ATTN_W + cc);
        LAS float* d = Qs + r * 132 + cc; d[0] = bf2f(v.x & 0xffffu); d[1] = bf2f(v.x >> 16); d[2] = bf2f(v.y & 0xffffu); d[3] = bf2f(v.y >> 16);
        d[4] = bf2f(v.z & 0xffffu); d[5] = bf2f(v.z >> 16); d[6] = bf2f(v.w & 0xffffu); d[7] = bf2f(v.w >> 16); }
    float m = -1e30f, l = 0.f, o[16];
#pragma unroll
    for (int i = 0; i < 16; ++i) o[i] = 0.f;
    const float scale = 0.08838834764831845f;
    for (int k0 = 0; k0 < nkeys; k0 += 64) {
        __syncthreads();
        for (int i = tid; i < 64 * 16; i += 512) { const int r = i >> 4, cc = (i & 15) * 8;
            const u32x4 v = *(const u32x4*)(Kh + (size_t)(k0 + r) * KV_W + cc); const u32x4 w = *(const u32x4*)(Vh + (size_t)(k0 + r) * KV_W + cc);
            LAS float* d = Ks + r * 132 + cc; d[0] = bf2f(v.x & 0xffffu); d[1] = bf2f(v.x >> 16); d[2] = bf2f(v.y & 0xffffu); d[3] = bf2f(v.y >> 16);
            d[4] = bf2f(v.z & 0xffffu); d[5] = bf2f(v.z >> 16); d[6] = bf2f(v.w & 0xffffu); d[7] = bf2f(v.w >> 16);
            LAS float* e = Vs + r * 128 + cc; e[0] = bf2f(w.x & 0xffffu); e[1] = bf2f(w.x >> 16); e[2] = bf2f(w.y & 0xffffu); e[3] = bf2f(w.y >> 16);
            e[4] = bf2f(w.z & 0xffffu); e[5] = bf2f(w.z >> 16); e[6] = bf2f(w.w & 0xffffu); e[7] = bf2f(w.w >> 16); }
        __syncthreads();
        float s[8];
#pragma unroll
        for (int j = 0; j < 8; ++j) s[j] = 0.f;
        for (int d4 = 0; d4 < 128; d4 += 4) {
            const f32x4 q = *(const LAS f32x4*)(Qs + qi * 132 + d4);
#pragma unroll
            for (int j = 0; j < 8; ++j) { const f32x4 kk = *(const LAS f32x4*)(Ks + (g8 * 8 + j) * 132 + d4); s[j] += q.x * kk.x + q.y * kk.y + q.z * kk.z + q.w * kk.w; }
        }
        float mx = -1e30f;
#pragma unroll
        for (int j = 0; j < 8; ++j) { s[j] *= scale; mx = fmaxf(mx, s[j]); }
        mx = fmaxf(mx, __shfl_xor(mx, 1)); mx = fmaxf(mx, __shfl_xor(mx, 2)); mx = fmaxf(mx, __shfl_xor(mx, 4));
        const float mn = fmaxf(m, mx), alpha = __expf(m - mn);
        float ps = 0.f;
#pragma unroll
        for (int j = 0; j < 8; ++j) { const float p = __expf(s[j] - mn); ps += p; Ps[qi * 68 + g8 * 8 + j] = p; }
        ps += __shfl_xor(ps, 1); ps += __shfl_xor(ps, 2); ps += __shfl_xor(ps, 4);
        l = l * alpha + ps; m = mn;
#pragma unroll
        for (int i = 0; i < 16; ++i) o[i] *= alpha;
        __syncthreads();
        for (int j = 0; j < 64; ++j) {
            const float p = Ps[qi * 68 + j];
#pragma unroll
            for (int i4 = 0; i4 < 4; ++i4) { const f32x4 v = *(const LAS f32x4*)(Vs + j * 128 + g8 * 16 + i4 * 4);
                o[i4 * 4 + 0] += p * v.x; o[i4 * 4 + 1] += p * v.y; o[i4 * 4 + 2] += p * v.z; o[i4 * 4 + 3] += p * v.w; }
        }
    }
    const float il = 1.0f / l;
    u32x4 w0, w1;
    w0.x = pk2(o[0] * il, o[1] * il); w0.y = pk2(o[2] * il, o[3] * il); w0.z = pk2(o[4] * il, o[5] * il); w0.w = pk2(o[6] * il, o[7] * il);
    w1.x = pk2(o[8] * il, o[9] * il); w1.y = pk2(o[10] * il, o[11] * il); w1.z = pk2(o[12] * il, o[13] * il); w1.w = pk2(o[14] * il, o[15] * il);
    bf16* dst = Orows + (size_t)qi * D + g8 * 16; *(u32x4*)dst = w0; *(u32x4*)(dst + 8) = w1;
}
__device__ __forceinline__ void ph_attn_pool(const Ctx& c) {
    const bf16* Q = (const bf16*)(c.ws + WS_Q); const bf16* Kb = (const bf16*)(c.ws + WS_K); const bf16* Vb = (const bf16*)(c.ws + WS_V); bf16* CAT = (bf16*)(c.ws + WS_CAT);
    constexpr int NU_LAT = NB * NHEAD * (SEQ / 256), NU_CTX = NB * NHEAD * (CTXL / 256);
    for (int u = c.bid; u < NU_LAT + NU_CTX; u += c.G) {
        __syncthreads();
        int row0, h, b, koff, seq;
        if (u < NU_LAT) { const int qb = u % (SEQ / 256); h = (u / (SEQ / 256)) % NHEAD; b = u / (SEQ / 256 * NHEAD); row0 = b * SEQ + qb * 256; koff = 0; seq = KVLEN; }
        else { const int v = u - NU_LAT; h = v % NHEAD; b = v / NHEAD; row0 = NLAT + b * CTXL; koff = SEQ; seq = CTXL; }
        const size_t kb = ((size_t)b * KVLEN + koff) * KV_W + (h / 4) * HD;
        attn::attn_dense_body(Q + (size_t)row0 * ATTN_W + h * HD, Kb + kb, Vb + kb, CAT + (size_t)row0 * D + h * HD, seq, (char*)c.lds);
    }
    __syncthreads();
    {   pg8::JobSched<4> S;
#pragma unroll
        for (int g = 0; g < 4; ++g) { S.A[g] = (unsigned)(WS_MP + (size_t)g * 512); S.B[g] = (unsigned)(WB_POOL + (size_t)g * 131072); S.nM[g] = NTOK / 256; S.nN[g] = 1; S.lda2[g] = POOL_W * 2; S.ldb2[g] = 512; S.nt[g] = 4; }
        S.G = c.G; S.c = (c.bid + c.G - 16) % c.G;
        pg8::EpiPoolS e{(bf16*)(c.ws + WS_CAT), inp(c, I_POOLS)};
        pg8::gemm_phase(c.lds, (const char*)c.ws, S, e);
    }
}

__device__ __forceinline__ void ph_rowA(const Ctx& c, int layer) {
    const bf16* Y = (const bf16*)(c.ws + WS_Y); bf16* X = (bf16*)(c.ws + WS_X); bf16* F = (bf16*)(c.ws + WS_F);
    int* SELE = (int*)(c.ws + WS_SELE); int* SELP = (int*)(c.ws + WS_SELP); int* LIST = (int*)(c.ws + WS_LIST); float* LISTG = (float*)(c.ws + WS_LISTG);
    unsigned* CNT = (unsigned*)(c.ws + WS_CTL) + CW_CNT + layer * 64;
    const float* gpost = inp(c, I_NORMG) + (size_t)(layer * 4 + 1) * D; const float* gpre = inp(c, I_NORMG) + (size_t)(layer * 4 + 2) * D;
    const float* RW = inp(c, I_ROUTW) + (size_t)layer * D * NEXP; const float* RB = inp(c, I_ROUTB) + layer * NEXP;
    const int nrows = layer == 0 ? NTOK : NLAT; const int lane = c.lane;
    for (int row = c.gw; row < nrows; row += c.ngw) {
        const RowInfo ri = rowinfo(row);
        const float* xr = row < NLAT ? inp(c, I_X) + (size_t)row * D : inp(c, I_CTX) + (size_t)(row - NLAT) * D;
        const float* m2 = modp(c, layer, ri.who, 2); const float* m3 = modp(c, layer, ri.who, 3); const float* m4 = modp(c, layer, ri.who, 4);
        f32x4 v[8]; float ss = 0.f;
#pragma unroll
        for (int jj = 0; jj < 4; ++jj) { const u32x4 q = *(const u32x4*)(Y + (size_t)row * D + jj * 512 + lane * 8);
            v[2 * jj] = (f32x4){bf2f(q.x & 0xffffu), bf2f(q.x >> 16), bf2f(q.y & 0xffffu), bf2f(q.y >> 16)}; v[2 * jj + 1] = (f32x4){bf2f(q.z & 0xffffu), bf2f(q.z >> 16), bf2f(q.w & 0xffffu), bf2f(q.w >> 16)}; }
#pragma unroll
        for (int j = 0; j < 8; ++j) ss += v[j].x * v[j].x + v[j].y * v[j].y + v[j].z * v[j].z + v[j].w * v[j].w;
        float rstd = rsqrtf(wsum(ss) * (1.0f / D) + 1e-6f);
        ss = 0.f;
        u32x4 xq4 = {0u, 0u, 0u, 0u}; u32x2 xlo = {0u, 0u};
#pragma unroll
        for (int j = 0; j < 8; ++j) { const int idx = ((j >> 1) * 512 + lane * 8 + (j & 1) * 4);
            f32x4 x0;
            if (layer == 0) x0 = *(const f32x4*)(xr + idx);
            else { if (!(j & 1)) xq4 = *(const u32x4*)(X + (size_t)row * D + idx); const unsigned q0 = (j & 1) ? xq4.z : xq4.x, q1 = (j & 1) ? xq4.w : xq4.y; x0 = (f32x4){bf2f(q0 & 0xffffu), bf2f(q0 >> 16), bf2f(q1 & 0xffffu), bf2f(q1 >> 16)}; }
            const f32x4 gg = *(const f32x4*)(gpost + idx), mm = *(const f32x4*)(m2 + idx);
            v[j] = x0 + mm * (v[j] * rstd * gg);
            if (j & 1) { u32x4 xo; xo.x = xlo.x; xo.y = xlo.y; xo.z = pk2(v[j].x, v[j].y); xo.w = pk2(v[j].z, v[j].w); *(u32x4*)(X + (size_t)row * D + idx - 4) = xo; } else { xlo.x = pk2(v[j].x, v[j].y); xlo.y = pk2(v[j].z, v[j].w); }
            ss += v[j].x * v[j].x + v[j].y * v[j].y + v[j].z * v[j].z + v[j].w * v[j].w; }
        rstd = rsqrtf(wsum(ss) * (1.0f / D) + 1e-6f);
        LAS float* fl = (LAS float*)(c.lds + c.wave * 8192);
        unsigned fp8lo = 0u;
#pragma unroll
        for (int j = 0; j < 8; ++j) { const int idx = ((j >> 1) * 512 + lane * 8 + (j & 1) * 4);
            const f32x4 gg = *(const f32x4*)(gpre + idx), s4 = *(const f32x4*)(m3 + idx), c4 = *(const f32x4*)(m4 + idx);
            const f32x4 f = v[j] * rstd * gg * (c4 + 1.0f) + s4;
            if constexpr (MOE8) { const unsigned p8 = pk4_fp8(f.x, f.y, f.z, f.w);
                if (j & 1) { u32x2 o8; o8.x = fp8lo; o8.y = p8; *(u32x2*)((unsigned char*)F + (size_t)row * D + idx - 4) = o8; } else fp8lo = p8; }
            else { u32x2 o; o.x = pk2(f.x, f.y); o.y = pk2(f.z, f.w); *(u32x2*)(F + (size_t)row * D + idx) = o; }
            *(LAS f32x4*)(fl + idx) = f; }
        float mine;
        {
            typedef short bf16x8_t __attribute__((ext_vector_type(8)));
            __syncthreads();
            const int fr = lane & 15, fq = lane >> 4;
            const bf16* wth = (const bf16*)(c.ws + WB_RT) + (size_t)(layer * 2) * NEXP * D; const bf16* wtl = wth + (size_t)NEXP * D;
            const LAS float* fa = (const LAS float*)c.lds + (fr & 7) * 2048 + c.wave * 256 + fq * 8;
            f32x4 acc0 = {0.f, 0.f, 0.f, 0.f}, acc1 = acc0;
#pragma unroll 2
            for (int s8 = 0; s8 < 8; ++s8) {
                const int k0 = c.wave * 256 + s8 * 32 + fq * 8;
                const bf16x8_t bh0 = *(const bf16x8_t*)(wth + (size_t)fr * D + k0), bh1 = *(const bf16x8_t*)(wth + (size_t)(16 + fr) * D + k0);
                const bf16x8_t bl0 = *(const bf16x8_t*)(wtl + (size_t)fr * D + k0), bl1 = *(const bf16x8_t*)(wtl + (size_t)(16 + fr) * D + k0);
                f32x4 f0 = *(const LAS f32x4*)(fa + s8 * 32), f1 = *(const LAS f32x4*)(fa + s8 * 32 + 4);
                if (fr >= 8) { f0 = (f32x4){0.f, 0.f, 0.f, 0.f}; f1 = f0; }
                const float fv[8] = {f0.x, f0.y, f0.z, f0.w, f1.x, f1.y, f1.z, f1.w};
                bf16x8_t ah, al;
#pragma unroll
                for (int j = 0; j < 8; ++j) { const unsigned hb = f2bf(fv[j]); ah[j] = (short)hb; al[j] = (short)f2bf(fv[j] - bf2f(hb)); }
                acc0 = __builtin_amdgcn_mfma_f32_16x16x32_bf16(ah, bh0, acc0, 0, 0, 0); acc1 = __builtin_amdgcn_mfma_f32_16x16x32_bf16(ah, bh1, acc1, 0, 0, 0);
                acc0 = __builtin_amdgcn_mfma_f32_16x16x32_bf16(al, bh0, acc0, 0, 0, 0); acc1 = __builtin_amdgcn_mfma_f32_16x16x32_bf16(al, bh1, acc1, 0, 0, 0);
                acc0 = __builtin_amdgcn_mfma_f32_16x16x32_bf16(ah, bl0, acc0, 0, 0, 0); acc1 = __builtin_amdgcn_mfma_f32_16x16x32_bf16(ah, bl1, acc1, 0, 0, 0);
            }
            LAS float* pb = (LAS float*)(c.lds + 65536);
            if (fq < 2) {
#pragma unroll
                for (int r = 0; r < 4; ++r) { pb[(c.wave * 8 + 4 * fq + r) * 32 + fr] = acc0[r]; pb[(c.wave * 8 + 4 * fq + r) * 32 + 16 + fr] = acc1[r]; } }
            __syncthreads();
            float t = 0.f;
            if (lane < NEXP) {
#pragma unroll
                for (int w8 = 0; w8 < 8; ++w8) t += pb[(w8 * 8 + c.wave) * 32 + lane]; }
            mine = lane < NEXP ? t + RB[lane] : -3.0e38f;
            __syncthreads();
        }
        int sel[4]; float sv[4];
#pragma unroll
        for (int r = 0; r < 4; ++r) {
            const float mx = wmax(mine);
            const unsigned long long bal = __ballot(mine == mx && lane < NEXP);
            const int idx = __ffsll((long long)bal) - 1;
            sel[r] = idx; sv[r] = mx; if (lane == idx) mine = -3.0e38f;
        }
        const float e1 = __expf(sv[1] - sv[0]), e2 = __expf(sv[2] - sv[0]), e3 = __expf(sv[3] - sv[0]);
        const float inv = 1.0f / (1.0f + e1 + e2 + e3);
        if (lane < 4) {
            const int e = lane == 0 ? sel[0] : lane == 1 ? sel[1] : lane == 2 ? sel[2] : sel[3];
            const float gt = (lane == 0 ? 1.0f : lane == 1 ? e1 : lane == 2 ? e2 : e3) * inv;
            const unsigned pos = __hip_atomic_fetch_add(CNT + e, 1u, __ATOMIC_RELAXED, __HIP_MEMORY_SCOPE_AGENT);
            LIST[e * LISTCAP + pos] = row; LISTG[e * LISTCAP + pos] = gt;
            SELE[row * 4 + lane] = e; SELP[row * 4 + lane] = (int)pos;
        }
    }
}

constexpr int TB_OFF = 131072;
__device__ __forceinline__ void moe_tables(const Ctx& c, int layer, LAS int* tb) {
    __syncthreads();
    if (c.tid == 0) { const unsigned* CNT = (const unsigned*)(c.ws + WS_CTL) + CW_CNT + layer * 64; int base = 0, tp = 0;
        for (int e = 0; e < NEXP; ++e) { const int n = (int)__hip_atomic_load(CNT + e, __ATOMIC_RELAXED, __HIP_MEMORY_SCOPE_AGENT); tb[e] = n; tb[32 + e] = base; tb[64 + e] = tp; base += (n + 255) / 256 * 256; tp += (n + 255) / 256; }
        tb[96] = tp; }
    __syncthreads();
}
__device__ __forceinline__ void ph_moe_gu(const Ctx& c, int layer) {
    LAS int* tb = (LAS int*)(c.lds + TB_OFF);
    moe_tables(c, layer, tb);
    pg8::MoeSched S{tb, c.G, c.bid, 8, true, (unsigned)(WB_GU + (size_t)layer * NEXP * 2 * DEXP * D * (MOE8 ? 1 : 2)), layer};
    pg8::EpiSwiglu e{(bf16*)(c.ws + WS_ACT), inp(c, I_BGATE) + (size_t)layer * NEXP * DEXP, inp(c, I_BUP) + (size_t)layer * NEXP * DEXP};
    pg8::gemm_phase_t<MOE8, true>(c.lds, (const char*)c.ws, S, e);
}
__device__ __forceinline__ void ph_moe_down(const Ctx& c, int layer) {
    LAS int* tb = (LAS int*)(c.lds + TB_OFF);
    moe_tables(c, layer, tb);
    pg8::MoeSched S{tb, c.G, c.bid, 8, false, (unsigned)(WB_DN + (size_t)layer * NEXP * D * DEXP * (MOE8 ? 1 : 2)), layer};
    pg8::EpiDownF e{(bf16*)(c.ws + WS_YE), inp(c, I_BDOWN) + (size_t)layer * NEXP * D, (const float*)(c.ws + WS_LISTG)};
    pg8::gemm_phase_t<MOE8, false>(c.lds, (const char*)c.ws, S, e);
}

__device__ __forceinline__ void ph_rowB(const Ctx& c, int layer) {
    bf16* X = (bf16*)(c.ws + WS_X); const bf16* YE = (const bf16*)(c.ws + WS_YE); float* H1 = (float*)(c.ws + WS_H1);
    const int* SELE = (const int*)(c.ws + WS_SELE); const int* SELP = (const int*)(c.ws + WS_SELP);
    const unsigned* CNT = (const unsigned*)(c.ws + WS_CTL) + CW_CNT + layer * 64;
    const float* gpf = inp(c, I_NORMG) + (size_t)(layer * 4 + 3) * D; const float* gpm1 = inp(c, I_NORMG) + (size_t)(1 * 4 + 0) * D;
    const int nrows = layer == 0 ? NTOK : NLAT; const int lane = c.lane;
    int mybase;
    { int n = lane < NEXP ? (int)__hip_atomic_load(CNT + (lane & 31), __ATOMIC_RELAXED, __HIP_MEMORY_SCOPE_AGENT) : 0; n = (n + 255) / 256 * 256; int incl = n;
#pragma unroll
      for (int o = 1; o < 32; o <<= 1) { const int t = shi(incl, (lane - o) & 63); if ((lane & 31) >= o) incl += t; }
      mybase = incl - n; }
    for (int row = c.gw; row < nrows; row += c.ngw) {
        const RowInfo ri = rowinfo(row);
        f32x4 v[8];
#pragma unroll
        for (int j = 0; j < 8; ++j) v[j] = (f32x4){0.f, 0.f, 0.f, 0.f};
#pragma unroll
        for (int r = 0; r < 4; ++r) {
            const int e = SELE[row * 4 + r], pos = SELP[row * 4 + r];
            const int slot = shi(mybase, e) + pos;
            const bf16* yr = YE + (size_t)slot * D;
            if constexpr (YE_FP8) {
                const unsigned char* y8 = (const unsigned char*)YE + (size_t)slot * D;
#pragma unroll
                for (int jj = 0; jj < 4; ++jj) { const u32x2 w = *(const u32x2*)(y8 + jj * 512 + lane * 8);
                    typedef float f2_ __attribute__((ext_vector_type(2)));
                    const f2_ a0 = __builtin_amdgcn_cvt_pk_f32_fp8((int)w.x, false), a1 = __builtin_amdgcn_cvt_pk_f32_fp8((int)w.x, true), b0 = __builtin_amdgcn_cvt_pk_f32_fp8((int)w.y, false), b1 = __builtin_amdgcn_cvt_pk_f32_fp8((int)w.y, true);
                    v[2 * jj].x += a0.x; v[2 * jj].y += a0.y; v[2 * jj].z += a1.x; v[2 * jj].w += a1.y; v[2 * jj + 1].x += b0.x; v[2 * jj + 1].y += b0.y; v[2 * jj + 1].z += b1.x; v[2 * jj + 1].w += b1.y; }
            } else
#pragma unroll
            for (int jj = 0; jj < 4; ++jj) { const u32x4 w = *(const u32x4*)(yr + jj * 512 + lane * 8);
                v[2 * jj].x += bf2f(w.x & 0xffffu); v[2 * jj].y += bf2f(w.x >> 16); v[2 * jj].z += bf2f(w.y & 0xffffu); v[2 * jj].w += bf2f(w.y >> 16);
                v[2 * jj + 1].x += bf2f(w.z & 0xffffu); v[2 * jj + 1].y += bf2f(w.z >> 16); v[2 * jj + 1].z += bf2f(w.w & 0xffffu); v[2 * jj + 1].w += bf2f(w.w >> 16); }
        }
        if constexpr (YE_FP8) {
#pragma unroll
            for (int j = 0; j < 8; ++j) v[j] *= (1.0f / YE_SCALE); }
        float ss = 0.f;
#pragma unroll
        for (int j = 0; j < 8; ++j) ss += v[j].x * v[j].x + v[j].y * v[j].y + v[j].z * v[j].z + v[j].w * v[j].w;
        float rstd = rsqrtf(wsum(ss) * (1.0f / D) + 1e-6f);
        const float* m5 = modp(c, layer, ri.who, 5);
        ss = 0.f;
        u32x4 xq4 = {0u, 0u, 0u, 0u}; u32x2 xlo = {0u, 0u};
#pragma unroll
        for (int j = 0; j < 8; ++j) { const int idx = ((j >> 1) * 512 + lane * 8 + (j & 1) * 4);
            if (!(j & 1)) xq4 = *(const u32x4*)(X + (size_t)row * D + idx);
            const unsigned q0 = (j & 1) ? xq4.z : xq4.x, q1 = (j & 1) ? xq4.w : xq4.y; const f32x4 x0 = (f32x4){bf2f(q0 & 0xffffu), bf2f(q0 >> 16), bf2f(q1 & 0xffffu), bf2f(q1 >> 16)};
            const f32x4 gg = *(const f32x4*)(gpf + idx), mm = *(const f32x4*)(m5 + idx);
            v[j] = x0 + mm * (v[j] * rstd * gg);
            ss += v[j].x * v[j].x + v[j].y * v[j].y + v[j].z * v[j].z + v[j].w * v[j].w; }
        if (layer == 1) {
#pragma unroll
            for (int j = 0; j < 8; ++j) *(f32x4*)(c.out + (size_t)row * D + ((j >> 1) * 512 + lane * 8 + (j & 1) * 4)) = v[j];
        } else {
            rstd = rsqrtf(wsum(ss) * (1.0f / D) + 1e-6f);
            const float* sh = modp(c, 1, ri.who, 0); const float* sc = modp(c, 1, ri.who, 1);
            u32x2 hlo = {0u, 0u};
#pragma unroll
            for (int j = 0; j < 8; ++j) { const int idx = ((j >> 1) * 512 + lane * 8 + (j & 1) * 4);
                if (j & 1) { u32x4 xo; xo.x = xlo.x; xo.y = xlo.y; xo.z = pk2(v[j].x, v[j].y); xo.w = pk2(v[j].z, v[j].w); *(u32x4*)(X + (size_t)row * D + idx - 4) = xo; } else { xlo.x = pk2(v[j].x, v[j].y); xlo.y = pk2(v[j].z, v[j].w); }
                const f32x4 gg = *(const f32x4*)(gpm1 + idx), s4 = *(const f32x4*)(sh + idx), c4 = *(const f32x4*)(sc + idx);
                const f32x4 hv = v[j] * rstd * gg * (c4 + 1.0f) + s4; u32x2 hw; hw.x = pk2(hv.x, hv.y); hw.y = pk2(hv.z, hv.w);
                if (j & 1) { u32x4 h4; h4.x = hlo.x; h4.y = hlo.y; h4.z = hw.x; h4.w = hw.y; *(u32x4*)((bf16*)H1 + (size_t)row * D + idx - 4) = h4; } else hlo = hw; }
        }
    }
}

__device__ __forceinline__ void ph_shiftmix(const Ctx& c) {
    const bf16* H1 = (const bf16*)(c.ws + WS_H1); bf16* XS = (bf16*)(c.ws + WS_XS); const float* mix = inp(c, I_MIX);
    const int lane = c.lane;
    constexpr int RPW = 5;
    for (int row0 = c.gw; row0 < NTOK; row0 += RPW * c.ngw) {
#pragma unroll 1
        for (int j = 0; j < 4; ++j) { const int idx = j * 512 + lane * 8;
            f32x4 m0[6], m1[6];
#pragma unroll
            for (int s = 0; s < 6; ++s) { m0[s] = *(const f32x4*)(mix + s * D + idx); m1[s] = *(const f32x4*)(mix + s * D + idx + 4); }
            u32x4 qh[RPW], qp[RPW], qn[RPW];
#pragma unroll
            for (int i = 0; i < RPW; ++i) { const int row = row0 + i * c.ngw; qh[i] = (u32x4){0u, 0u, 0u, 0u}; qp[i] = qh[i]; qn[i] = qh[i];
                if (row < NTOK) { const RowInfo ri = rowinfo(row);
                    qh[i] = *(const u32x4*)(H1 + (size_t)row * D + idx);
                    if (ri.t > 0) qp[i] = *(const u32x4*)(H1 + (size_t)(row - 1) * D + idx);
                    if (ri.t < ri.n - 1) qn[i] = *(const u32x4*)(H1 + (size_t)(row + 1) * D + idx); } }
#define UNP(q_, lo_) ((f32x4){bf2f((lo_ ? q_.x : q_.z) & 0xffffu), bf2f((lo_ ? q_.x : q_.z) >> 16), bf2f((lo_ ? q_.y : q_.w) & 0xffffu), bf2f((lo_ ? q_.y : q_.w) >> 16)})
#pragma unroll
            for (int i = 0; i < RPW; ++i) { const int row = row0 + i * c.ngw;
                if (row < NTOK) {
                    const f32x4 h0 = UNP(qh[i], true), h1 = UNP(qh[i], false);
                    const f32x4 xx0 = (UNP(qp[i], true) + UNP(qn[i], true)) * 0.5f - h0, xx1 = (UNP(qp[i], false) + UNP(qn[i], false)) * 0.5f - h1;
#pragma unroll
                    for (int s = 0; s < 6; ++s) { const f32x4 o0 = h0 + xx0 * m0[s], o1 = h1 + xx1 * m1[s];
                        u32x4 w; w.x = pk2(o0.x, o0.y); w.y = pk2(o0.z, o0.w); w.z = pk2(o1.x, o1.y); w.w = pk2(o1.z, o1.w); *(u32x4*)(XS + ((size_t)s * NTOK + row) * D + idx) = w; } } }
#undef UNP
        }
    }
}

__device__ __forceinline__ void ph_rw_gemm1(const Ctx& c) {
    constexpr size_t XSZ = (size_t)NTOK * D * 2;
    pg8::JobSched<6> S;
    S.A[0] = (unsigned)WS_XS; S.A[1] = (unsigned)(WS_XS + 2 * XSZ); S.A[2] = (unsigned)(WS_XS + 3 * XSZ); S.A[3] = (unsigned)(WS_XS + 1 * XSZ); S.A[4] = (unsigned)(WS_XS + 4 * XSZ); S.A[5] = (unsigned)(WS_XS + 5 * XSZ);
    S.B[0] = (unsigned)WB_WR; S.B[1] = (unsigned)WB_WK; S.B[2] = (unsigned)WB_WV; S.B[3] = (unsigned)WB_W1; S.B[4] = (unsigned)WB_A1; S.B[5] = (unsigned)WB_G1;
    S.nM[0] = NLAT / 256; S.nM[1] = NTOK / 256; S.nM[2] = NTOK / 256; S.nM[3] = NTOK / 256; S.nM[4] = NTOK / 256; S.nM[5] = NLAT / 256;
#pragma unroll
    for (int j = 0; j < 6; ++j) { S.nN[j] = j < 3 ? D / 256 : 1; S.lda2[j] = D * 2; S.ldb2[j] = D * 2; S.nt[j] = D / 64; }
    S.G = c.G; S.c = c.bid;
    static_assert(WS_KK == WS_R + (size_t)NTOK * D * 4 && WS_VV == WS_KK + (size_t)NTOK * D * 4 && WS_LA == WS_LW + (size_t)NTOK * 512 && WS_LG == WS_LA + (size_t)NTOK * 512, "contiguous outputs");
    pg8::EpiRw1 e{(float*)(c.ws + WS_R), (bf16*)(c.ws + WS_LW)};
    pg8::gemm_phase(c.lds, (const char*)c.ws, S, e);
}
__device__ __forceinline__ void ph_rw_gemm2(const Ctx& c) {
    pg8::JobSched<3> S;
    S.A[0] = (unsigned)WS_LW; S.A[1] = (unsigned)WS_LA; S.A[2] = (unsigned)WS_LG;
    S.B[0] = (unsigned)WB_W2; S.B[1] = (unsigned)WB_A2; S.B[2] = (unsigned)WB_G2;
    S.nM[0] = NTOK / 256; S.nM[1] = NTOK / 256; S.nM[2] = NLAT / 256; S.nN[0] = 16; S.nN[1] = 16; S.nN[2] = 8;
#pragma unroll
    for (int j = 0; j < 3; ++j) { S.lda2[j] = 512; S.ldb2[j] = 512; S.nt[j] = 4; }
    S.G = c.G; S.c = c.bid;
    pg8::EpiRw2 e{(float*)(c.ws + WS_DEC), (float*)(c.ws + WS_AS), (float*)(c.ws + WS_G), inp(c, I_W0), inp(c, I_A0)};
    pg8::gemm_phase(c.lds, (const char*)c.ws, S, e);
}

constexpr int SC_T = 32, SC_NCH = (CTXL + SEQ) / SC_T, SC_VS = 6 * RN;
__device__ __forceinline__ int scan_row(int s, int dir, int b) {
    return s < CTXL ? (NLAT + b * CTXL + (dir ? (CTXL - 1 - s) : s)) : (b * SEQ + (dir ? (SEQ - 1 - (s - CTXL)) : (s - CTXL)));
}
struct ScanLd { u32x2 k, v, r, w, a; };
__device__ __forceinline__ f32x4 bf4(const u32x2& q) { return (f32x4){bf2f(q.x & 0xffffu), bf2f(q.x >> 16), bf2f(q.y & 0xffffu), bf2f(q.y >> 16)}; }
__device__ __forceinline__ void scan_issue(ScanLd& L, const bf16* Kp, const bf16* Vp, const bf16* Rp, const bf16* Wp, const bf16* Ap, int row, int col) {
    const size_t o = (size_t)row * D + col;
    L.k = *(const u32x2*)(Kp + o); L.v = *(const u32x2*)(Vp + o); L.w = *(const u32x2*)(Wp + o); L.a = *(const u32x2*)(Ap + o);
    L.r = row < NLAT ? *(const u32x2*)(Rp + o) : (u32x2){0u, 0u};
}
__device__ __forceinline__ void scan_put(const ScanLd& Lb, LAS float* dst  , const f32x4& kk4, const f32x4& ka4) {
    const f32x4 Lk = bf4(Lb.k), Lv = bf4(Lb.v), Lr = bf4(Lb.r), La = bf4(Lb.a), Le = bf4(Lb.w);
    const f32x4 Lw = (f32x4){__expf(-Le.x), __expf(-Le.y), __expf(-Le.z), __expf(-Le.w)};
    const f32x4 kr = Lk * kk4;
    const float ss = sum16(kr.x * kr.x + kr.y * kr.y + kr.z * kr.z + kr.w * kr.w);
    const f32x4 kk = kr * rsqrtf(fmaxf(ss, 1e-24f));
    *(LAS f32x4*)(dst + 0 * RN) = Lw;
    *(LAS f32x4*)(dst + 1 * RN) = Lk * ((La - 1.0f) * ka4 + 1.0f);
    *(LAS f32x4*)(dst + 2 * RN) = -kk;
    *(LAS f32x4*)(dst + 3 * RN) = kk * La;
    *(LAS f32x4*)(dst + 4 * RN) = Lr;
    *(LAS f32x4*)(dst + 5 * RN) = Lv;
}
struct ScanOp { f32x4 w0, w1, k0, k1, a0, a1, b0, b1, r0, r1; float v; };
template <bool WANTY, bool PROBE = false> __device__ __forceinline__ void scan_ld(ScanOp& o, const LAS float* p, const LAS float* pv) {
    if (PROBE) {
        o.w0 = *(const LAS f32x4*)(p); o.w1 = o.w0; o.k0 = *(const LAS f32x4*)(p + RN); o.k1 = o.k0; o.a0 = *(const LAS f32x4*)(p + 2 * RN); o.a1 = o.a0; o.b0 = *(const LAS f32x4*)(p + 3 * RN); o.b1 = o.b0;
        if (WANTY) { o.r0 = *(const LAS f32x4*)(p + 4 * RN); o.r1 = o.r0; }
        o.v = pv[5 * RN]; return; }
    o.w0 = *(const LAS f32x4*)(p); o.w1 = *(const LAS f32x4*)(p + 4); o.k0 = *(const LAS f32x4*)(p + RN); o.k1 = *(const LAS f32x4*)(p + RN + 4);
    o.b0 = *(const LAS f32x4*)(p + 3 * RN); o.b1 = *(const LAS f32x4*)(p + 3 * RN + 4);
    if (WANTY) { o.r0 = *(const LAS f32x4*)(p + 4 * RN); o.r1 = *(const LAS f32x4*)(p + 4 * RN + 4); }
    o.v = pv[5 * RN];
    asm volatile("" ::: "memory");
    o.a0 = *(const LAS f32x4*)(p + 2 * RN); o.a1 = *(const LAS f32x4*)(p + 2 * RN + 4);
}
__device__ __forceinline__ float scan_stepA(const f32x2& S0, const f32x2& S1, const f32x2& S2, const f32x2& S3, const ScanOp& o) {
    const f32x2 t01 = S0 * (f32x2){o.a0.x, o.a0.y} + S1 * (f32x2){o.a0.z, o.a0.w}, t23 = S2 * (f32x2){o.a1.x, o.a1.y} + S3 * (f32x2){o.a1.z, o.a1.w};
    const f32x2 t = t01 + t23;
    return t.x + t.y;
}
template <bool WANTY> __device__ __forceinline__ void scan_stepB(f32x2& S0, f32x2& S1, f32x2& S2, f32x2& S3, const ScanOp& o, float tsum, float& yp) {
    const float v = o.v;
    const f32x2 P0 = S0 * (f32x2){o.w0.x, o.w0.y} + (f32x2){o.k0.x, o.k0.y} * v, P1 = S1 * (f32x2){o.w0.z, o.w0.w} + (f32x2){o.k0.z, o.k0.w} * v;
    const f32x2 P2 = S2 * (f32x2){o.w1.x, o.w1.y} + (f32x2){o.k1.x, o.k1.y} * v, P3 = S3 * (f32x2){o.w1.z, o.w1.w} + (f32x2){o.k1.z, o.k1.w} * v;
    const float sa = sum8(tsum);
    S0 = (f32x2){o.b0.x, o.b0.y} * sa + P0; S1 = (f32x2){o.b0.z, o.b0.w} * sa + P1; S2 = (f32x2){o.b1.x, o.b1.y} * sa + P2; S3 = (f32x2){o.b1.z, o.b1.w} * sa + P3;
    if (WANTY) {
        const f32x2 y01 = S0 * (f32x2){o.r0.x, o.r0.y} + S1 * (f32x2){o.r0.z, o.r0.w}, y23 = S2 * (f32x2){o.r1.x, o.r1.y} + S3 * (f32x2){o.r1.z, o.r1.w};
        const f32x2 y2 = y01 + y23;
        yp = y2.x + y2.y;
    }
}
template <int CTRL> __device__ __forceinline__ float scan_ycomb(float x, float y, bool c) { const float z = c ? y : x, w = c ? x : y; return z + dpp_mov<CTRL>(w); }
#define SCAN_STEP(CUR, NXT, K, LOADNEXT) { const float ts_ = scan_stepA(S0, S1, S2, S3, CUR); __builtin_amdgcn_sched_barrier(0); \
    if (LOADNEXT) scan_ld<WANTY, PROBE>(NXT, q + ((K) + 1) * SC_VS, qv + ((K) + 1) * SC_VS); __builtin_amdgcn_sched_barrier(0); scan_stepB<WANTY>(S0, S1, S2, S3, CUR, ts_, yp##K); }
template <bool WANTY, bool PROBE = false> __device__ __forceinline__ void scan_chunk(f32x2& S0, f32x2& S1, f32x2& S2, f32x2& S3, const LAS float* p, const LAS float* pv, LAS float* yw, int l7) {
    ScanOp cur, nxt; scan_ld<WANTY, PROBE>(cur, p, pv);
    float ysel = 0.f;
    const bool c3 = (l7 & 4) != 0, c2 = (((l7 >> 1) ^ (l7 >> 2)) & 1) != 0, c1 = ((l7 ^ (l7 >> 2)) & 1) != 0;
#pragma unroll 1
    for (int s4 = 0; s4 < SC_T; s4 += 8) {
        const LAS float* q = p + s4 * SC_VS; const LAS float* qv = pv + s4 * SC_VS;
        if (WANTY) { if (s4 > 0) yw[(s4 - 8) * 32] = ysel; asm volatile("" ::: "memory"); }
        float yp0 = 0.f, yp1 = 0.f, yp2 = 0.f, yp3 = 0.f, yp4 = 0.f, yp5 = 0.f, yp6 = 0.f, yp7 = 0.f, ya0 = 0.f, ya1 = 0.f, yb0 = 0.f;
        SCAN_STEP(cur, nxt, 0, true) SCAN_STEP(nxt, cur, 1, true) if (WANTY) ya0 = scan_ycomb<0xB1>(yp0, yp1, c1);
        SCAN_STEP(cur, nxt, 2, true) SCAN_STEP(nxt, cur, 3, true) if (WANTY) { ya1 = scan_ycomb<0xB1>(yp2, yp3, c1); yb0 = scan_ycomb<0x4E>(ya0, ya1, c2); }
        SCAN_STEP(cur, nxt, 4, true) SCAN_STEP(nxt, cur, 5, true) if (WANTY) ya0 = scan_ycomb<0xB1>(yp4, yp5, c1);
        SCAN_STEP(cur, nxt, 6, true) SCAN_STEP(nxt, cur, 7, s4 + 8 < SC_T)
        if (WANTY) { ya1 = scan_ycomb<0xB1>(yp6, yp7, c1); ysel = scan_ycomb<0x141>(yb0, scan_ycomb<0x4E>(ya0, ya1, c2), c3); }
    }
    if (WANTY) yw[(SC_T - 8) * 32] = ysel;
}
template <bool PROBE = false> __device__ __forceinline__ void ph_scan(const Ctx& c) {
    const bf16* R = (const bf16*)(c.ws + WS_R); const bf16* K = (const bf16*)(c.ws + WS_KK); const bf16* V = (const bf16*)(c.ws + WS_VV);
    bf16* YS = (bf16*)(c.ws + (PROBE ? WS_YE : WS_YS));
    LAS float* ops = (LAS float*)c.lds;
    LAS float* yb = ops + 2 * SC_T * SC_VS;
    const int tid = c.tid, lane = c.lane, wave = c.wave;
    static_assert(SC_NCH * 4 * 1 >= 1, "");
    for (int unit = c.bid; unit < 2 * 2 * NB * RH; unit += c.G) {
        const bool firstunit = unit == c.bid && c.G * 4 * SC_NCH >= NEXP * CV_PER;
        const int chain = unit >> 1, half = unit & 1, dir = chain / (NB * RH), b = (chain / RH) % NB, h = chain % RH;
        const bf16* Wp = (const bf16*)(c.ws + WS_DEC + (size_t)dir * NTOK * D * 4); const bf16* Ap = (const bf16*)(c.ws + WS_AS + (size_t)dir * NTOK * D * 4);
        __syncthreads();
        if (wave >= 4) {
            const int lt = tid - 256, st0 = lt >> 4, c4 = (lt & 15) * 4, col = h * RN + c4;
            const f32x4 kk4 = *(const f32x4*)(inp(c, I_KK) + col), ka4 = *(const f32x4*)(inp(c, I_KA) + col);
            ScanLd A0, A1, B0, B1;
            scan_issue(A0, K, V, R, Wp, Ap, scan_row(st0, dir, b), col); scan_issue(A1, K, V, R, Wp, Ap, scan_row(st0 + 16, dir, b), col);
            scan_issue(B0, K, V, R, Wp, Ap, scan_row(SC_T + st0, dir, b), col); scan_issue(B1, K, V, R, Wp, Ap, scan_row(SC_T + st0 + 16, dir, b), col);
            scan_put(A0, ops + st0 * SC_VS + c4, kk4, ka4); scan_put(A1, ops + (st0 + 16) * SC_VS + c4, kk4, ka4);
            __syncthreads();
            f32x4 cvv[8]; int cvp = -1;
            for (int cix = 0; cix < SC_NCH; ++cix) {
                if (cix + 1 < SC_NCH) { LAS float* dstb = ops + ((cix + 1) & 1) * SC_T * SC_VS; scan_put(B0, dstb + st0 * SC_VS + c4, kk4, ka4); scan_put(B1, dstb + (st0 + 16) * SC_VS + c4, kk4, ka4); }
                if (cvp >= 0) { CvItem cvP; cv_decode(c, NEXP + cvp / CV_PER, cvp % CV_PER, cvP); cv_store(cvP, cvv, lane); }
                if (cix >= 1 && (cix - 1) * SC_T >= CTXL && lt < 256) {
                    const int st = lt >> 3, q4 = (lt & 7) * 4; const int row = scan_row((cix - 1) * SC_T + st, dir, b);
                    const f32x4 yv = *(const LAS f32x4*)(yb + ((cix - 1) & 1) * SC_T * 32 + st * 32 + q4); u32x2 yw; yw.x = pk2(yv.x, yv.y); yw.y = pk2(yv.z, yv.w);
                    *(u32x2*)(YS + (size_t)dir * NLAT * D * 2 + (size_t)row * D + h * RN + half * 32 + q4) = yw; }
                asm volatile("" ::: "memory");
                if (cix + 2 < SC_NCH) { const int s2 = (cix + 2) * SC_T + st0; scan_issue(B0, K, V, R, Wp, Ap, scan_row(s2, dir, b), col); scan_issue(B1, K, V, R, Wp, Ap, scan_row(s2 + 16, dir, b), col); }
                const int cvi = cix * (c.G * 4) + c.bid * 4 + (wave - 4);
                cvp = (firstunit && cvi < NEXP * CV_PER) ? cvi : -1;
                if (cvp >= 0) { CvItem cvT; cv_decode(c, NEXP + cvi / CV_PER, cvi % CV_PER, cvT); cv_load(cvT, cvv, lane); }
                __syncthreads();
            }
            if (cvp >= 0) { CvItem cvP; cv_decode(c, NEXP + cvp / CV_PER, cvp % CV_PER, cvP); cv_store(cvP, cvv, lane); }
            { const int st = lt >> 3, q4 = (lt & 7) * 4; const int row = scan_row((SC_NCH - 1) * SC_T + st, dir, b);
              const f32x4 yv = *(const LAS f32x4*)(yb + ((SC_NCH - 1) & 1) * SC_T * 32 + st * 32 + q4); u32x2 yw; yw.x = pk2(yv.x, yv.y); yw.y = pk2(yv.z, yv.w);
              *(u32x2*)(YS + (size_t)dir * NLAT * D * 2 + (size_t)row * D + h * RN + half * 32 + q4) = yw; }
        } else {
            const int rl = wave * 8 + (lane >> 3), row = half * 32 + rl, c0 = (lane & 7) * 8;
            f32x2 S0 = {0.f, 0.f}, S1 = {0.f, 0.f}, S2 = {0.f, 0.f}, S3 = {0.f, 0.f};
            __syncthreads();
            __builtin_amdgcn_s_setprio(3);
            for (int cix = 0; cix < SC_NCH; ++cix) {
                const LAS float* p = ops + (cix & 1) * SC_T * SC_VS + c0; const LAS float* pv = ops + (cix & 1) * SC_T * SC_VS + row; LAS float* yo = yb + (cix & 1) * SC_T * 32 + rl;
                if (cix * SC_T >= CTXL) scan_chunk<true, PROBE>(S0, S1, S2, S3, p, pv, yo + ((lane & 4) + ((((lane >> 1) ^ (lane >> 2)) & 1) << 1) + ((lane ^ (lane >> 2)) & 1)) * 32, lane & 7); else scan_chunk<false, PROBE>(S0, S1, S2, S3, p, pv, yo, 0);
                __syncthreads();
            }
            __builtin_amdgcn_s_setprio(0);
        }
    }
    if (c.G * 4 * SC_NCH < NEXP * CV_PER) {
        __syncthreads();
        for (int it = c.gw; it < NEXP * CV_PER; it += c.ngw) { CvItem T; f32x4 tv[8]; cv_decode(c, NEXP + it / CV_PER, it % CV_PER, T); cv_load(T, tv, lane); cv_store(T, tv, lane); }
    }
}

__device__ __forceinline__ void ph_readout(const Ctx& c) {
    const bf16* R = (const bf16*)(c.ws + WS_R); const bf16* K = (const bf16*)(c.ws + WS_KK); const bf16* V = (const bf16*)(c.ws + WS_VV);
    const bf16* AS = (const bf16*)(c.ws + WS_AS); const bf16* YS = (const bf16*)(c.ws + WS_YS); const bf16* G = (const bf16*)(c.ws + WS_G); bf16* O = (bf16*)(c.ws + WS_O);
    const float* lnw = inp(c, I_LNW); const float* lnb = inp(c, I_LNB); const float* kap = inp(c, I_KA); const float* rkp = inp(c, I_RK);
    const int lane = c.lane;
    for (int row = c.gw; row < NLAT; row += c.ngw) {
#pragma unroll 2
        for (int ps = 0; ps < 4; ++ps) {
            const int col = ps * 512 + lane * 8; const size_t o = (size_t)row * D + col;
            float y[8], r[8], k[8], v[8], a0[8], a1[8], g[8];
#define LD8(dst, p) do { const f32x4 q0_ = *(const f32x4*)(p), q1_ = *(const f32x4*)((p) + 4); dst[0] = q0_.x; dst[1] = q0_.y; dst[2] = q0_.z; dst[3] = q0_.w; dst[4] = q1_.x; dst[5] = q1_.y; dst[6] = q1_.z; dst[7] = q1_.w; } while (0)
#define LB8(dst, p) do { const u32x4 q_ = *(const u32x4*)(p); dst[0] = bf2f(q_.x & 0xffffu); dst[1] = bf2f(q_.x >> 16); dst[2] = bf2f(q_.y & 0xffffu); dst[3] = bf2f(q_.y >> 16); \
                dst[4] = bf2f(q_.z & 0xffffu); dst[5] = bf2f(q_.z >> 16); dst[6] = bf2f(q_.w & 0xffffu); dst[7] = bf2f(q_.w >> 16); } while (0)
            LB8(y, YS + o); LB8(r, YS + (size_t)NLAT * D * 2 + o);
#pragma unroll
            for (int j = 0; j < 8; ++j) y[j] += r[j];
            LB8(r, R + o); LB8(k, K + o); LB8(v, V + o); LB8(a0, AS + o); LB8(a1, AS + (size_t)NTOK * D * 2 + o); LB8(g, G + o);
#undef LB8
            float lw[8], lb[8], ka[8], rk[8];
            LD8(lw, lnw + col); LD8(lb, lnb + col); LD8(ka, kap + col); LD8(rk, rkp + col);
#undef LD8
            float s1 = 0.f;
#pragma unroll
            for (int j = 0; j < 8; ++j) s1 += y[j];
            const float mu = sum8(s1) * (1.0f / RN);
            float s2 = 0.f, s3 = 0.f;
#pragma unroll
            for (int j = 0; j < 8; ++j) { y[j] -= mu; s2 += y[j] * y[j];
                const float rr = r[j] * rk[j]; s3 += rr * (k[j] * (1.0f + (a0[j] - 1.0f) * ka[j]) + k[j] * (1.0f + (a1[j] - 1.0f) * ka[j])); }
            const float rs = rsqrtf(sum8(s2) * (1.0f / RN) + 64e-5f), bon = sum8(s3);
            float ov[8];
#pragma unroll
            for (int j = 0; j < 8; ++j) ov[j] = (y[j] * rs * lw[j] + lb[j] + bon * v[j]) * g[j];
            u32x4 w; w.x = pk2(ov[0], ov[1]); w.y = pk2(ov[2], ov[3]); w.z = pk2(ov[4], ov[5]); w.w = pk2(ov[6], ov[7]);
            *(u32x4*)(O + o) = w;
        }
    }
}

__device__ __forceinline__ bool launder(Ctx& c, unsigned char* ws) {
    unsigned long long wi = (unsigned long long)ws; asm volatile("" : "+s"(wi)); c.ws = (unsigned char*)(GAS unsigned char*)wi;
    int t = threadIdx.x; asm volatile("" : "+v"(t)); c.tid = t; c.lane = t & 63; c.wave = __builtin_amdgcn_readfirstlane(t >> 6);
    int bx = blockIdx.x; asm volatile("" : "+s"(bx)); c.bid = bx; c.gw = bx * 8 + c.wave; return true; }
constexpr int NPH = 20;
__global__ void __launch_bounds__(512, 2) fwd(Args args) {
    extern __shared__ __attribute__((aligned(16))) unsigned char lds_raw[];
    Ctx c; c.out = args.out; c.ws = args.ws; c.lds = (LAS unsigned char*)lds_raw;
    c.tid = threadIdx.x; c.lane = c.tid & 63; c.wave = __builtin_amdgcn_readfirstlane(c.tid >> 6); c.bid = blockIdx.x; c.G = gridDim.x;
    c.gw = c.bid * 8 + c.wave; c.ngw = c.G * 8;
    volatile LAS unsigned* misc = (volatile LAS unsigned*)(c.lds + LDS_BYTES - 64);
    if (c.tid < 16) misc[c.tid] = 0u;
    if (c.tid < 39) ((LAS unsigned long long*)(c.lds + PTAB_OFF))[c.tid] = (unsigned long long)args.in[c.tid];
    __syncthreads();
    constexpr int lo = 0, hi = (DBG_HI);
    (void)xcd_barrier_post((unsigned*)(c.ws + WS_CTL) + CW_BAR, misc);
#ifdef ONLY_PHASE
#define IN(k) ((k) == ONLY_PHASE && lo <= (k) && (k) < hi && launder(c, args.ws))
#else
#define IN(k) (lo <= (k) && (k) < hi && launder(c, args.ws))
#endif
#define SEAM(k) do { if ((lo <= (k) && (k) + 1 < hi)) { unsigned char* w_ = args.ws; asm volatile("" : "+s"(w_)); XcdBarrier b_; b_.bar = (unsigned*)(w_ + WS_CTL) + CW_BAR; b_.x = xb_xcc_id(); \
        b_.st = (volatile LAS unsigned*)((LAS unsigned char*)lds_raw + LDS_BYTES - 64); xcd_barrier(b_); } } while (0)
    if (IN(0)) { ph_mod(c); } SEAM(0);
    for (int layer = 0; layer < 2; ++layer) {
        if (layer == 0) {
            if (IN(1)) { ph_prenorm0(c); if (DUPQ(1)) ph_prenorm0(c); } SEAM(1);
            if (IN(2)) { for (int rp_ = 0; rp_ < 1 + DUPQ(2); ++rp_) { pg8::PlainSched S{(unsigned)WS_H, (unsigned)WB_WIN, D * 2, D * 2, D / 64, NTOK / 256, AB_IN / 256, c.G, c.bid}; pg8::EpiB16 e{(bf16*)(c.ws + WS_U), AB_IN}; pg8::gemm_phase(c.lds, (const char*)c.ws, S, e); }  if (c.G == 256 && c.bid >= 256 - CVF_F2) conv_fill(c, NEXP * CV_PER - CVF_TOTAL + (c.bid - (256 - CVF_F2)) * CVF_Q, CVF_Q); } SEAM(2);
            if (IN(3)) { ph_prep0(c); if (DUPQ(3)) ph_prep0(c); } SEAM(3);
            if (IN(4)) { ph_attn_pool(c); if (DUPQ(4)) ph_attn_pool(c); } SEAM(4);
            if (IN(5)) { for (int rp_ = 0; rp_ < 1 + DUPQ(5); ++rp_) { pg8::PlainSched S{(unsigned)WS_CAT, (unsigned)WB_WOUT, D * 2, D * 2, D / 64, NTOK / 256, D / 256, c.G, c.bid}; pg8::EpiB16 e{(bf16*)(c.ws + WS_Y), D}; pg8::gemm_phase(c.lds, (const char*)c.ws, S, e); }  if (c.G == 256 && c.bid >= 256 - CVF_F5) conv_fill(c, NEXP * CV_PER - CVF_TOTAL + CVF_F2 * CVF_Q + (c.bid - (256 - CVF_F5)) * CVF_Q, CVF_Q); } SEAM(5);
        } else {
            if (IN(10)) { ph_shiftmix(c); if (DUPQ(10)) ph_shiftmix(c); } SEAM(10);
            if (IN(11)) { ph_rw_gemm1(c); if (DUPQ(11)) ph_rw_gemm1(c); } SEAM(11);
            if (IN(12)) { ph_rw_gemm2(c); if (DUPQ(12)) ph_rw_gemm2(c); } SEAM(12);
            if (IN(13)) { ph_scan<false>(c); if (DUPQ(13)) ph_scan<(DBG_SCANPROBE != 0)>(c); } SEAM(13);
            if (IN(14)) { ph_readout(c); if (DUPQ(14)) ph_readout(c); } SEAM(14);
            if (IN(15)) { for (int rp_ = 0; rp_ < 1 + DUPQ(15); ++rp_) { pg8::PlainSched S{(unsigned)WS_O, (unsigned)WB_WO, D * 2, D * 2, D / 64, NLAT / 256, D / 256, c.G, c.bid}; pg8::EpiB16 e{(bf16*)(c.ws + WS_Y), D}; pg8::gemm_phase(c.lds, (const char*)c.ws, S, e); } } SEAM(15);
        }
        const int p0 = layer ? 16 : 6;
        if (IN(p0)) { ph_rowA(c, layer); } SEAM(p0);
        if (IN(p0 + 1)) { ph_moe_gu(c, layer); if (DUPQ(7)) ph_moe_gu(c, layer); } SEAM(p0 + 1);
        if (IN(p0 + 2)) { ph_moe_down(c, layer); if (DUPQ(8)) ph_moe_down(c, layer); } SEAM(p0 + 2);
        if (IN(p0 + 3)) { ph_rowB(c, layer); } SEAM(p0 + 3);
    }
#undef IN
#undef SEAM
}
}

extern "C" void kernel_launch(void* const* d_in, const int* in_sizes, int n_in, void* d_out, int out_size, void* d_ws, size_t ws_size, hipStream_t stream) {
    static int grid = 0;
    if (grid == 0) {
        if (n_in != 39 || out_size != NLAT * D || ws_size < WS_END3) { fprintf(stderr, "kernel_launch: unexpected shapes: n_in %d out %d ws %zu (need %zu)\n", n_in, out_size, ws_size, (size_t)WS_END3); grid = -1; return; }
        int dev = 0, cus = 0;
        if (hipGetDevice(&dev) != hipSuccess || hipDeviceGetAttribute(&cus, hipDeviceAttributeMultiprocessorCount, dev) != hipSuccess) { grid = -1; return; }
        if (hipFuncSetAttribute((const void*)fwd, hipFuncAttributeMaxDynamicSharedMemorySize, LDS_BYTES) != hipSuccess) { fprintf(stderr, "kernel_launch: hipFuncSetAttribute failed\n"); grid = -1; return; }
        int per_cu = 0;
        if (hipOccupancyMaxActiveBlocksPerMultiprocessor(&per_cu, (const void*)fwd, 512, LDS_BYTES) != hipSuccess || per_cu < 1) fprintf(stderr, "kernel_launch: occupancy query says %d\n", per_cu);
        (void)hipGetLastError();
        grid = cus;
    }
    if (grid < 0) return;
    (void)hipMemsetAsync((char*)d_ws + WS_CTL, 0, CTL_BYTES, stream);
    Args a{};
    for (int i = 0; i < 39; ++i) a.in[i] = (const float*)d_in[i];
    a.out = (float*)d_out; a.ws = (unsigned char*)d_ws;
    a.ph_lo = 0; a.ph_hi = NPH;
    hipLaunchKernelGGL(fwd, dim3(grid), dim3(512), LDS_BYTES, stream, a);
}
```
